# Optimizing an MI355X kernel written in HIP

```python
import jax, jax.numpy as jnp
from jax import lax
import numpy as np

D_MODEL = 1024
BATCH = 16
SEQ = 2048
DEPTH = 2

CTX_LEN = 256
GRID_W = 64
F32 = jnp.float32
N_REC = (DEPTH + 1) // 2
N_ATT = DEPTH // 2
N_MOD = 6
NORM_EPS = 1e-6
NEG_INF = -1e30

A_HEADS = 8
A_HD = 64
A_W = A_HEADS * A_HD
DECAY_LORA = 64
AAA_LORA = 64
GATE_LORA = 128
RWKV_COLS = 3 * A_W + DECAY_LORA + AAA_LORA + GATE_LORA
RWKV_SPLITS = (A_W, 2 * A_W, 3 * A_W, 3 * A_W + DECAY_LORA, 3 * A_W + DECAY_LORA + AAA_LORA)
GN_EPS = 64e-5

B_HEADS = 4
B_DK = 128
B_DV = 128
B_W = B_HEADS * B_DK
HGRN_COLS = 5 * B_W
HGRN_CHUNK = 64

REC_IN_COLS = RWKV_COLS + HGRN_COLS
D_MIX = A_W + B_HEADS * B_DV

HQ = 16
HKV = 4
GQ = HQ // HKV
HD = 64
WINDOW = 128
ATT_BLOCK = 128
AX_DIM = HD // 2
ROPE_BASE = 10000.0
ATT_COLS = HQ * HD + 2 * HKV * HD

D_FF = 2816
N_EXPERTS = 8
TOP_K = 2
D_FF_E = 2816
MOE_BLOCK = 128

kernel_name = "hybrid_rwkv7_hgrn2_swa_moe_diffusion_trunk"


def rmsnorm(x, g):
    xf = x.astype(F32)
    y = xf * lax.rsqrt(jnp.mean(xf * xf, axis=-1, keepdims=True) + NORM_EPS)
    return (y * g.astype(F32)).astype(x.dtype)


def modulate(x, g, shift, scale):
    return rmsnorm(x, g) * (1 + scale) + shift


def adaln(cvec, w, b):
    return jnp.split(jax.nn.silu(cvec) @ w + b, N_MOD, axis=-1)


def centred_shift(t):
    tp = jnp.pad(t, ((0, 0), (1, 1), (0, 0)))
    return 0.5 * (tp[:, :-2] + tp[:, 2:])


def swiglu(h, wg, wu, wd):
    return (jax.nn.silu(h @ wg) * (h @ wu)) @ wd


def axial_rope(T):
    rows = T // GRID_W
    row = jnp.repeat(jnp.arange(rows, dtype=F32), GRID_W)
    col = jnp.tile(jnp.arange(GRID_W, dtype=F32), rows)
    inv = ROPE_BASE ** (-jnp.arange(0, AX_DIM, 2, dtype=F32) / AX_DIM)
    ang = jnp.stack([row[:, None] * inv, col[:, None] * inv], axis=1)
    return jnp.cos(ang), jnp.sin(ang)


def apply_rope(t, cos, sin):
    B, T, H, _ = t.shape
    tr = t.astype(F32).reshape(B, T, H, 2, 2, AX_DIM // 2)
    t1, t2 = tr[..., 0, :], tr[..., 1, :]
    c, s = cos[None, :, None], sin[None, :, None]
    out = jnp.stack([t1 * c - t2 * s, t2 * c + t1 * s], axis=-2)
    return out.reshape(B, T, H, HD).astype(t.dtype)


def heads_a(t):
    return t.reshape(t.shape[:-1] + (A_HEADS, A_HD))


def rwkv_features(p, mu, w0, w_up, a0, a_up, g_up, k_k, k_a):
    p = p + mu * (centred_shift(p) - p)
    r, k, v, wd, ad, gd = jnp.split(p, RWKV_SPLITS, axis=-1)
    w_log = -jax.nn.softplus(-(w0[:, None, None, :] + jnp.einsum('btr,drc->dbtc', jnp.tanh(wd), w_up))) - 0.5
    decay = heads_a(jnp.exp(-jnp.exp(w_log)))
    a = jax.nn.sigmoid(a0 + ad @ a_up)
    g = jax.nn.sigmoid(gd) @ g_up
    kk = heads_a(k * k_k)
    kk = kk / jnp.maximum(jnp.sqrt(jnp.sum(kk * kk, axis=-1, keepdims=True)), 1e-12)
    k = k * (1 + (a - 1) * k_a)
    return heads_a(r), heads_a(k), heads_a(v), kk, heads_a(a), decay, g


def rwkv_scan(feats, direction, s0, reverse):
    r, k, v, kk, a, decay, _ = feats
    xs = tuple(jnp.moveaxis(t, 1, 0) for t in (r, decay[direction], k, v, kk, kk * a))

    def step(S, inp):
        r_t, w_t, k_t, v_t, kk_t, b_t = inp
        S = (S * w_t[:, :, None, :]
             - jnp.einsum('bhvk,bhk->bhv', S, kk_t)[..., None] * b_t[:, :, None, :]
             + v_t[..., None] * k_t[:, :, None, :])
        return S, jnp.einsum('bhvk,bhk->bhv', S, r_t)

    s_fin, o = lax.scan(step, s0, xs, reverse=reverse)
    return jnp.moveaxis(o, 0, 1), s_fin


def rwkv_post(o, feats, r_k, ln_w, ln_b):
    r, k, v, _, _, _, g = feats
    mean = jnp.mean(o, axis=-1, keepdims=True)
    var = jnp.mean(jnp.square(o - mean), axis=-1, keepdims=True)
    on = (o - mean) * lax.rsqrt(var + GN_EPS)
    bonus = jnp.sum(r * k * r_k, axis=-1, keepdims=True) * v
    B, T = o.shape[:2]
    return (on.reshape(B, T, A_W) * ln_w + ln_b + bonus.reshape(B, T, A_W)) * g


def hgrn_features(p, lb):
    q, i, f_raw, gate = jnp.split(p, (B_W, 2 * B_W, 4 * B_W), axis=-1)
    B, T = p.shape[:2]
    f_raw = jnp.moveaxis(f_raw.reshape(B, T, 2, B_W), 2, 0)
    lbb = lb[:, None, None, :]
    f = lbb + (1 - lbb) * jax.nn.sigmoid(f_raw)
    hk = lambda t: t.reshape(t.shape[:-1] + (B_HEADS, B_DK))
    return hk(jax.nn.silu(q)), i.reshape(B, T, B_HEADS, B_DV), hk(1 - f), hk(jnp.log(f)), gate


def hgrn2_chunked(q, k, v, logf, s0):
    B, T, H, _ = q.shape
    L = HGRN_CHUNK
    n = T // L
    ch = lambda t: t.reshape(B, n, L, H, t.shape[-1])
    q, k, v, logf = ch(q), ch(k), ch(v), ch(logf)
    G = jnp.cumsum(logf, axis=2)
    Gref = G[:, :, L // 2 - 1:L // 2]
    att = jnp.einsum('bnthk,bnshk->bnhts', q * jnp.exp(G - Gref), k * jnp.exp(Gref - G))
    att = jnp.where(jnp.tril(jnp.ones((L, L), bool)), att, 0.0)
    o_intra = jnp.einsum('bnhts,bnshv->bnthv', att, v)
    G_end = G[:, :, -1]
    kv = jnp.einsum('bnshk,bnshv->bnhkv', k * jnp.exp(G_end[:, :, None] - G), v)

    def step(S, inp):
        dec, kv_c = inp
        return dec[..., None] * S + kv_c, S

    s_fin, s_start = lax.scan(step, s0, (jnp.exp(G_end).swapaxes(0, 1), kv.swapaxes(0, 1)))
    o_inter = jnp.einsum('bnthk,nbhkv->bnthv', q * jnp.exp(G), s_start)
    return (o_intra + o_inter).reshape(B, T, H, v.shape[-1]), s_fin


def hgrn_post(o, gate, g_norm):
    B, T = o.shape[:2]
    return rmsnorm(o, g_norm).reshape(B, T, B_HEADS * B_DV) * jax.nn.silu(gate)


def flip(t):
    return t[:, ::-1]


def rec_mixer(h_ctx, h_lat, w_in, w_out, mu, w0, w_up, a0, a_up, g_up, k_k, k_a, r_k, ln_w, ln_b, lb, hg_norm):
    B = h_lat.shape[0]
    pc = (h_ctx @ w_in).astype(F32)
    pl = (h_lat @ w_in).astype(F32)
    fa_c = rwkv_features(pc[..., :RWKV_COLS], mu, w0, w_up, a0, a_up, g_up, k_k, k_a)
    fa_l = rwkv_features(pl[..., :RWKV_COLS], mu, w0, w_up, a0, a_up, g_up, k_k, k_a)
    s0a = jnp.zeros((B, A_HEADS, A_HD, A_HD), F32)
    oac_f, sac_f = rwkv_scan(fa_c, 0, s0a, False)
    oac_b, sac_b = rwkv_scan(fa_c, 1, s0a, True)
    oal_f, _ = rwkv_scan(fa_l, 0, sac_f, False)
    oal_b, _ = rwkv_scan(fa_l, 1, sac_b, True)
    ya_c = rwkv_post(oac_f + oac_b, fa_c, r_k, ln_w, ln_b)
    ya_l = rwkv_post(oal_f + oal_b, fa_l, r_k, ln_w, ln_b)
    qc, ic, kc, lfc, gc = hgrn_features(pc[..., RWKV_COLS:], lb)
    ql, il, kl, lfl, gl = hgrn_features(pl[..., RWKV_COLS:], lb)
    s0b = jnp.zeros((B, B_HEADS, B_DK, B_DV), F32)
    obc_f, sbc_f = hgrn2_chunked(qc, kc[0], ic, lfc[0], s0b)
    obc_b, sbc_b = hgrn2_chunked(flip(qc), flip(kc[1]), flip(ic), flip(lfc[1]), s0b)
    obl_f, _ = hgrn2_chunked(ql, kl[0], il, lfl[0], sbc_f)
    obl_b, _ = hgrn2_chunked(flip(ql), flip(kl[1]), flip(il), flip(lfl[1]), sbc_b)
    yb_c = hgrn_post(obc_f + flip(obc_b), gc, hg_norm)
    yb_l = hgrn_post(obl_f + flip(obl_b), gl, hg_norm)
    y_c = jnp.concatenate([ya_c, yb_c], axis=-1).astype(h_ctx.dtype) @ w_out
    y_l = jnp.concatenate([ya_l, yb_l], axis=-1).astype(h_lat.dtype) @ w_out
    return y_c, y_l


def window_attn_mixer(h_ctx, h_lat, w_in, w_out, sink, cos, sin):
    B, T, _ = h_lat.shape
    q, k, v = jnp.split(h_lat @ w_in, (HQ * HD, HQ * HD + HKV * HD), axis=-1)
    q = apply_rope(q.reshape(B, T, HQ, HD), cos, sin)
    k = apply_rope(k.reshape(B, T, HKV, HD), cos, sin)
    v = v.reshape(B, T, HKV, HD)
    kc, vc = jnp.split(h_ctx @ w_in[:, HQ * HD:], 2, axis=-1)
    C = h_ctx.shape[1]
    kc = kc.reshape(B, C, HKV, HD)
    vc = vc.reshape(B, C, HKV, HD)
    nb = T // ATT_BLOCK
    qb = q.reshape(B, nb, ATT_BLOCK, HKV, GQ, HD).swapaxes(0, 1)

    def band(t):
        tp = jnp.pad(t, ((0, 0), (ATT_BLOCK, ATT_BLOCK), (0, 0), (0, 0))).reshape(B, nb + 2, ATT_BLOCK, HKV, HD)
        return jnp.concatenate([tp[:, :-2], tp[:, 1:-1], tp[:, 2:]], axis=2).swapaxes(0, 1)

    kb, vb = band(k), band(v)
    qpos = jnp.arange(ATT_BLOCK)
    kpos = jnp.arange(3 * ATT_BLOCK) - ATT_BLOCK
    rel_ok = jnp.abs(qpos[:, None] - kpos[None, :]) <= WINDOW
    sink_l = sink.astype(F32).reshape(HKV, GQ)[None, :, :, None, None]
    scale = HD ** -0.5

    def block(args):
        i, qi, ki, vi = args
        kabs = i * ATT_BLOCK + kpos
        valid = rel_ok & ((kabs >= 0) & (kabs < T))[None, :]
        s_lat = jnp.einsum('bqhgd,bkhd->bhgqk', qi, ki).astype(F32) * scale
        s_lat = jnp.where(valid, s_lat, NEG_INF)
        s_ctx = jnp.einsum('bqhgd,bkhd->bhgqk', qi, kc).astype(F32) * scale
        sk = jnp.broadcast_to(sink_l, s_lat.shape[:-1] + (1,))
        pr = jax.nn.softmax(jnp.concatenate([s_ctx, s_lat, sk], axis=-1), axis=-1)
        return (jnp.einsum('bhgqk,bkhd->bqhgd', pr[..., :C].astype(vc.dtype), vc)
                + jnp.einsum('bhgqk,bkhd->bqhgd', pr[..., C:C + 3 * ATT_BLOCK].astype(vi.dtype), vi))

    o = lax.map(block, (jnp.arange(nb), qb, kb, vb))
    return o.swapaxes(0, 1).reshape(B, T, HQ * HD) @ w_out


def moe_swiglu(h, router_w, router_b, w_gate, w_up, w_down):
    B, T, D = h.shape
    hf = h.reshape(B * T, D)
    m = hf.shape[0] * TOP_K
    probs = jax.nn.softmax((hf @ router_w + router_b).astype(F32), axis=-1)
    top_p, top_e = lax.top_k(probs, TOP_K)
    top_p = top_p / jnp.sum(top_p, axis=-1, keepdims=True)
    eid = top_e.reshape(m)
    order = jnp.argsort(eid)
    e_sorted = eid[order]
    tok = order // TOP_K
    wt = top_p.reshape(m)[order]
    counts = jnp.bincount(eid, length=N_EXPERTS)
    padded = (counts + MOE_BLOCK - 1) // MOE_BLOCK * MOE_BLOCK
    pad_end = jnp.cumsum(padded)
    pad_start = pad_end - padded
    start = jnp.cumsum(counts) - counts
    dest = pad_start[e_sorted] + (jnp.arange(m) - start[e_sorted])
    n_blocks = m // MOE_BLOCK + N_EXPERTS
    buf = jnp.zeros((n_blocks * MOE_BLOCK, D), h.dtype).at[dest].set(hf[tok])
    block_e = jnp.minimum(jnp.searchsorted(pad_end, jnp.arange(n_blocks) * MOE_BLOCK, side='right'), N_EXPERTS - 1)

    def expert_block(args):
        e, xb = args
        return (jax.nn.silu(xb @ w_gate[e]) * (xb @ w_up[e])) @ w_down[e]

    yb = lax.map(expert_block, (block_e, buf.reshape(n_blocks, MOE_BLOCK, D)))
    y = yb.reshape(-1, D)[dest] * wt[:, None].astype(h.dtype)
    return jnp.zeros_like(hf).at[tok].add(y).reshape(B, T, D)


def setup_inputs(seed: int = 0) -> dict:
    key = jax.random.key(seed)
    ks = iter(jax.random.split(key, 40))
    D = D_MODEL

    def nrm(shape, scale):
        return jax.random.normal(next(ks), shape, F32) * scale

    def gain(shape):
        return 1.0 + nrm(shape, 0.02)

    inp = {}
    inp["x"] = nrm((BATCH, SEQ, D), 1.0)
    inp["c"] = nrm((BATCH, D), 1.0)
    inp["ctx"] = nrm((BATCH, CTX_LEN, D), 1.0)
    inp["c_ctx"] = nrm((D,), 1.0)
    inp["mod_w"] = nrm((DEPTH, D, N_MOD * D), 0.5 * D ** -0.5)
    inp["mod_b"] = nrm((DEPTH, N_MOD * D), 0.01)
    inp["norm_mix"] = gain((DEPTH, D))
    inp["norm_ffn"] = gain((DEPTH, D))
    inp["norm_final"] = gain((D,))
    inp["rec_w_in"] = nrm((N_REC, D, REC_IN_COLS), D ** -0.5)
    inp["rec_w_out"] = nrm((N_REC, D_MIX, D), D_MIX ** -0.5)
    inp["rwkv_mu"] = jax.random.uniform(next(ks), (N_REC, RWKV_COLS), F32)
    inp["rwkv_w0"] = jax.random.uniform(next(ks), (N_REC, 2, A_W), F32, minval=-6.0, maxval=-1.0)
    inp["rwkv_w_up"] = nrm((N_REC, 2, DECAY_LORA, A_W), 0.5 * DECAY_LORA ** -0.5)
    inp["rwkv_a0"] = nrm((N_REC, A_W), 0.1)
    inp["rwkv_a_up"] = nrm((N_REC, AAA_LORA, A_W), 0.5 * AAA_LORA ** -0.5)
    inp["rwkv_g_up"] = nrm((N_REC, GATE_LORA, A_W), GATE_LORA ** -0.5)
    inp["rwkv_k_k"] = 0.85 + nrm((N_REC, A_W), 0.02)
    inp["rwkv_k_a"] = gain((N_REC, A_W))
    inp["rwkv_r_k"] = nrm((N_REC, A_HEADS, A_HD), 0.1)
    inp["rwkv_ln_w"] = gain((N_REC, A_W))
    inp["rwkv_ln_b"] = nrm((N_REC, A_W), 0.01)
    inp["hgrn_lb"] = nrm((2, N_REC + 1, B_W), 0.1)
    inp["hgrn_norm"] = gain((N_REC, B_DV))
    inp["ffn_w_gate"] = nrm((N_REC, D, D_FF), D ** -0.5)
    inp["ffn_w_up"] = nrm((N_REC, D, D_FF), D ** -0.5)
    inp["ffn_w_down"] = nrm((N_REC, D_FF, D), D_FF ** -0.5)
    inp["att_w_in"] = nrm((N_ATT, D, ATT_COLS), D ** -0.5)
    inp["att_w_out"] = nrm((N_ATT, HQ * HD, D), (HQ * HD) ** -0.5)
    inp["att_sink"] = nrm((N_ATT, HQ), 0.5)
    inp["moe_router"] = nrm((N_ATT, D, N_EXPERTS), D ** -0.5)
    inp["moe_router_b"] = nrm((N_ATT, N_EXPERTS), 0.01)
    inp["moe_w_gate"] = nrm((N_ATT, N_EXPERTS, D, D_FF_E), D ** -0.5)
    inp["moe_w_up"] = nrm((N_ATT, N_EXPERTS, D, D_FF_E), D ** -0.5)
    inp["moe_w_down"] = nrm((N_ATT, N_EXPERTS, D_FF_E, D), D_FF_E ** -0.5)
    return inp


def reference(x, c, ctx, c_ctx, mod_w, mod_b, norm_mix, norm_ffn, norm_final, rec_w_in, rec_w_out,
              rwkv_mu, rwkv_w0, rwkv_w_up, rwkv_a0, rwkv_a_up, rwkv_g_up, rwkv_k_k, rwkv_k_a, rwkv_r_k,
              rwkv_ln_w, rwkv_ln_b, hgrn_lb, hgrn_norm, ffn_w_gate, ffn_w_up, ffn_w_down,
              att_w_in, att_w_out, att_sink, moe_router, moe_router_b, moe_w_gate, moe_w_up, moe_w_down):
    T = x.shape[1]
    cos, sin = axial_rope(T)
    lb_all = jnp.cumsum(jax.nn.softmax(hgrn_lb.astype(F32), axis=1), axis=1)
    x_lat, x_ctx = x, ctx
    for l in range(DEPTH):
        j = l // 2
        m_lat = [m[:, None, :] for m in adaln(c, mod_w[l], mod_b[l])]
        m_ctx = adaln(c_ctx, mod_w[l], mod_b[l])
        h_lat = modulate(x_lat, norm_mix[l], m_lat[0], m_lat[1])
        h_ctx = modulate(x_ctx, norm_mix[l], m_ctx[0], m_ctx[1])
        if l % 2 == 0:
            y_ctx, y_lat = rec_mixer(h_ctx, h_lat, rec_w_in[j], rec_w_out[j], rwkv_mu[j], rwkv_w0[j], rwkv_w_up[j],
                                     rwkv_a0[j], rwkv_a_up[j], rwkv_g_up[j], rwkv_k_k[j], rwkv_k_a[j], rwkv_r_k[j],
                                     rwkv_ln_w[j], rwkv_ln_b[j], lb_all[:, j], hgrn_norm[j])
            x_lat = x_lat + m_lat[2] * y_lat
            x_ctx = x_ctx + m_ctx[2] * y_ctx
            f_lat = modulate(x_lat, norm_ffn[l], m_lat[3], m_lat[4])
            f_ctx = modulate(x_ctx, norm_ffn[l], m_ctx[3], m_ctx[4])
            x_lat = x_lat + m_lat[5] * swiglu(f_lat, ffn_w_gate[j], ffn_w_up[j], ffn_w_down[j])
            x_ctx = x_ctx + m_ctx[5] * swiglu(f_ctx, ffn_w_gate[j], ffn_w_up[j], ffn_w_down[j])
        else:
            y_lat = window_attn_mixer(h_ctx, h_lat, att_w_in[j], att_w_out[j], att_sink[j], cos, sin)
            x_lat = x_lat + m_lat[2] * y_lat
            f_lat = modulate(x_lat, norm_ffn[l], m_lat[3], m_lat[4])
            x_lat = x_lat + m_lat[5] * moe_swiglu(f_lat, moe_router[j], moe_router_b[j],
                                                  moe_w_gate[j], moe_w_up[j], moe_w_down[j])
    return rmsnorm(x_lat, norm_final)
```

```cpp
#include <hip/hip_runtime.h>
#include <cstdio>
#include <cstdint>

#ifndef MK_PER_PHASE
#define MK_PER_PHASE 0
#endif

namespace pg8 {
#define PG8_LAS __attribute__((address_space(3)))
typedef unsigned short bf16_t;
typedef short bf16x8 __attribute__((ext_vector_type(8)));
typedef float f32x4 __attribute__((ext_vector_type(4)));
typedef float f32x2 __attribute__((ext_vector_type(2)));
typedef unsigned u32x4 __attribute__((ext_vector_type(4)));
typedef unsigned u32x2 __attribute__((ext_vector_type(2)));
constexpr int BM = 256, BK = 64, HALF = 128, HTB = HALF * BK * 2  , STAGE_BYTES = 8 * HTB, NXCD = 8, WGM = 8;

__host__ __device__ __forceinline__ int lds_byte(int r, int c) { const int st = (r >> 4) * 2 + (c >> 5), rr = r & 15, cc = c & 31, ob = rr * 64 + cc * 2; return st * 1024 + (ob ^ (((ob >> 9) & 1) << 5)); }
__host__ __device__ __forceinline__ void stage_rc(int b, int& R, int& C) { const int st = b / 1024, sb = b % 1024, swz = sb ^ (((sb >> 9) & 1) << 5); R = (st >> 1) * 16 + swz / 64; C = (st & 1) * 32 + (swz % 64) / 2; }
__host__ __device__ __forceinline__ int perm32(int rho) { const int n = rho >> 4, i = rho & 15; return 8 * (i >> 2) + 4 * n + (i & 3); }

struct Unit { int pm, pn, pb, ko; };
struct Gemm { const bf16_t* A; const bf16_t* Bt; int K; int ld; };

struct StaticOrder {
    int nM, nN, nwg, G, c;
    __device__ __forceinline__ void init(int nM_, int nN_, int G_, int c_) { nM = nM_; nN = nN_; nwg = nM * nN; G = G_; c = c_; }
    __device__ __forceinline__ bool next(int i, Unit& u) const {
        const long L = (long)i * G + c; if (L >= nwg) return false;
        int wgid = (int)L; { const int q = nwg / NXCD, r = nwg % NXCD, xcd = wgid % NXCD, off = wgid / NXCD; wgid = (xcd < r ? xcd * (q + 1) : r * (q + 1) + (xcd - r) * q) + off; }
        const int nig = WGM * nN, gid = wgid / nig, fm = gid * WGM, gsz = (nM - fm) < WGM ? (nM - fm) : WGM;
        u.pm = fm + ((wgid % nig) % gsz); u.pn = (wgid % nig) / gsz; u.pb = u.pn; u.ko = 0; return true;
    }
};
struct MoeOrder {
    StaticOrder so; int p0; const int* pexp;
    __device__ __forceinline__ bool next(int i, Unit& u) const {
        if (!so.next(i, u)) return false;
        u.pb = pexp[p0 + u.pm] * so.nN + u.pn; return true;
    }
};

struct SplitKOrder {
    int nM, nN, nS, KS, G, c, pm0, p0; const int* pexp;
    __device__ __forceinline__ bool next(int i, Unit& u) const {
        const long L = (long)i * G + c; if (L >= (long)nM * nN * nS) return false;
        const int l = (int)L, ks = l % nS, r = l / nS; u.pn = r % nN; u.pm = pm0 + r / nN; u.ko = ks * KS;
        u.pb = pexp ? pexp[p0 + u.pm] * nN + u.pn : u.pn; return true;
    }
};

__device__ __forceinline__ unsigned cvt_pk_bf16(float lo, float hi) { unsigned r; asm volatile("v_cvt_pk_bf16_f32 %0, %1, %2" : "=v"(r) : "v"(lo), "v"(hi)); return r; }

typedef int v8i32 __attribute__((ext_vector_type(8)));
template <class Epi, class Sched, bool ALIGN_EPI = false, bool SP2 = false, bool FP8 = false>
__device__ __forceinline__ void gemm_phase(PG8_LAS unsigned char* lds, const Gemm g, const Sched& S, const Epi& E) {
    const int tid = threadIdx.x, wid = __builtin_amdgcn_readfirstlane(tid >> 6), lane = tid & 63, wr = wid >> 2, wc = wid & 3, fr = lane & 15, fq = lane >> 4;
    const int K = g.ld, nt = g.K / BK;
    unsigned voffA[2], voffB[2];
#pragma unroll
    for (int i = 0; i < 2; ++i) { int R, C; stage_rc(tid * 16 + i * 8192, R, C); const int Rb = Epi::PERM ? ((R & ~31) + perm32(R & 31)) : R;
        voffA[i] = (unsigned)(R * K + C) * 2u; voffB[i] = (unsigned)(Rb * K + C) * 2u; }
    const size_t kstep = (size_t)(BK * 2);
    const size_t hstep = (size_t)HALF * K * 2;
    const size_t tstep = 2 * hstep;
    const unsigned ldsw = (unsigned)wid * 1024u;
    const int aoff = lds_byte(wr * 64 + fr, fq * 8), boff = lds_byte(wc * 32 + fr, fq * 8);
#define PG8_SA(b, h) (((b) * 2 + (h)) * HTB)
#define PG8_SB(b, h) ((4 + (b) * 2 + (h)) * HTB)
#define PG8_STAGE(bufoff, gbase, voff) do { _Pragma("unroll") for (int _i = 0; _i < 2; ++_i) \
        __builtin_amdgcn_global_load_lds((const unsigned*)((const char*)(gbase) + (voff)[_i]), (PG8_LAS unsigned*)(lds + (bufoff) + ldsw + _i * 8192), 16, 0, 0); } while (0)
#define PG8_RD(off) (*(const PG8_LAS bf16x8*)(lds + (off)))
#define PG8_CAT2(x, y) __builtin_bit_cast(v8i32, __builtin_shufflevector((x), (y), 0, 1, 2, 3, 4, 5, 6, 7, 8, 9, 10, 11, 12, 13, 14, 15))
#define PG8_LDA(dst, b, h) do { _Pragma("unroll") for (int m = 0; m < 4; ++m) { if constexpr (FP8) dst##8[m] = PG8_CAT2(PG8_RD(PG8_SA(b, h) + aoff + m * 2048), PG8_RD(PG8_SA(b, h) + aoff + m * 2048 + 1024)); \
        else { _Pragma("unroll") for (int k = 0; k < 2; ++k) dst[m][k] = PG8_RD(PG8_SA(b, h) + aoff + m * 2048 + k * 1024); } } } while (0)
#define PG8_LDB(dst, b, h) do { _Pragma("unroll") for (int n = 0; n < 2; ++n) { if constexpr (FP8) dst##8[n] = PG8_CAT2(PG8_RD(PG8_SB(b, h) + boff + n * 2048), PG8_RD(PG8_SB(b, h) + boff + n * 2048 + 1024)); \
        else { _Pragma("unroll") for (int k = 0; k < 2; ++k) dst[n][k] = PG8_RD(PG8_SB(b, h) + boff + n * 2048 + k * 1024); } } } while (0)
#define PG8_MMA(ai, bj, At, Bt) do { __builtin_amdgcn_s_setprio(1); _Pragma("unroll") for (int m = 0; m < 4; ++m) _Pragma("unroll") for (int n = 0; n < 2; ++n) { \
        if constexpr (FP8) asm volatile("v_mfma_scale_f32_16x16x128_f8f6f4 %0, %1, %2, %0, %3, %3 op_sel_hi:[0,0,0]" : "+v"(acc[ai][bj][m][n]) : "v"(Bt##8[n]), "v"(At##8[m]), "v"(fp8_one));   \
        else { _Pragma("unroll") for (int k = 0; k < 2; ++k) acc[ai][bj][m][n] = __builtin_amdgcn_mfma_f32_16x16x32_bf16(Bt[n][k], At[m][k], acc[ai][bj][m][n], 0, 0, 0); } } __builtin_amdgcn_s_setprio(0); } while (0)
#define PG8_WAIT_V(n) asm volatile("s_waitcnt vmcnt(" #n ")" ::: "memory")
#define PG8_WAIT_L(n) asm volatile("s_waitcnt lgkmcnt(" #n ")" ::: "memory")
#define PG8_BAR __builtin_amdgcn_s_barrier()
#define PG8_SCHED __builtin_amdgcn_sched_barrier(0)
    Unit cur, nxt; int ui = 0;
    if (!S.next(0, cur)) return;
    f32x4 acc[2][2][4][2];
#pragma unroll
    for (int a = 0; a < 2; ++a)
#pragma unroll
        for (int b = 0; b < 2; ++b)
#pragma unroll
            for (int m = 0; m < 4; ++m)
#pragma unroll
                for (int n = 0; n < 2; ++n) acc[a][b][m][n] = (f32x4){0.f, 0.f, 0.f, 0.f};
    const int fp8_one = 0x7f7f7f7f;
    bf16x8 At[4][2], B0[2][2], B1[2][2]; v8i32 At8[4], B08[2], B18[2];
    const char* cA = (const char*)g.A + (size_t)cur.pm * tstep + (size_t)cur.ko * 2; const char* cB = (const char*)g.Bt + (size_t)cur.pb * tstep + (size_t)cur.ko * 2;
    if constexpr (SP2) {
        PG8_STAGE(PG8_SB(0, 0), cB, voffB); PG8_STAGE(PG8_SB(0, 1), cB + hstep, voffB); PG8_STAGE(PG8_SA(0, 0), cA, voffA); PG8_STAGE(PG8_SA(0, 1), cA + hstep, voffA);
        if (wr == 1) PG8_BAR;
        PG8_WAIT_V(2); PG8_BAR;
        PG8_STAGE(PG8_SB(1, 0), cB + kstep, voffB); PG8_STAGE(PG8_SA(1, 0), cA + kstep, voffA); PG8_STAGE(PG8_SB(1, 1), cB + hstep + kstep, voffB);
        PG8_WAIT_V(6); PG8_BAR;
    } else {
        PG8_STAGE(PG8_SB(0, 0), cB, voffB); PG8_STAGE(PG8_SA(0, 0), cA, voffA); PG8_STAGE(PG8_SB(0, 1), cB + hstep, voffB); PG8_STAGE(PG8_SA(0, 1), cA + hstep, voffA);
        if (wr == 1) PG8_BAR;
        PG8_WAIT_V(4); PG8_BAR;
        PG8_STAGE(PG8_SB(1, 0), cB + kstep, voffB); PG8_STAGE(PG8_SA(1, 0), cA + kstep, voffA); PG8_STAGE(PG8_SB(1, 1), cB + hstep + kstep, voffB);
        PG8_WAIT_V(6); PG8_BAR;
    }
    for (;;) {
        const bool has_next = S.next(ui + 1, nxt);
        const char* nA = has_next ? (const char*)g.A + (size_t)nxt.pm * tstep + (size_t)nxt.ko * 2 : cA; const char* nB = has_next ? (const char*)g.Bt + (size_t)nxt.pb * tstep + (size_t)nxt.ko * 2 : cB;
        for (int t = 0; t < nt; t += 2) {
            const bool last = (t == nt - 2);
            const char* a1 = cA + (size_t)(t + 1) * kstep;
            const char* a2 = last ? nA : cA + (size_t)(t + 2) * kstep; const char* b2 = last ? nB : cB + (size_t)(t + 2) * kstep;
            const char* a3 = a2 + kstep; const char* b3 = b2 + kstep;
            if constexpr (SP2) {
            PG8_LDB(B0, 0, 0); PG8_LDB(B1, 0, 1); PG8_SCHED; PG8_LDA(At, 0, 0); PG8_STAGE(PG8_SA(1, 1), a1 + hstep, voffA);
            PG8_WAIT_V(8); PG8_WAIT_L(0); PG8_BAR; PG8_MMA(0, 0, At, B0); PG8_MMA(0, 1, At, B1); PG8_BAR; PG8_SCHED;
            PG8_LDA(At, 0, 1); PG8_STAGE(PG8_SB(0, 0), b2, voffB); PG8_STAGE(PG8_SB(0, 1), b2 + hstep, voffB); PG8_STAGE(PG8_SA(0, 0), a2, voffA);
            PG8_WAIT_V(8); PG8_WAIT_L(0); PG8_BAR; PG8_MMA(1, 0, At, B0); PG8_MMA(1, 1, At, B1); PG8_BAR; PG8_SCHED;
            PG8_LDB(B0, 1, 0); PG8_LDB(B1, 1, 1); PG8_SCHED; PG8_LDA(At, 1, 0); PG8_STAGE(PG8_SA(0, 1), a2 + hstep, voffA);
            PG8_WAIT_V(8); PG8_WAIT_L(0); PG8_BAR; PG8_MMA(0, 0, At, B0); PG8_MMA(0, 1, At, B1); PG8_BAR; PG8_SCHED;
            PG8_LDA(At, 1, 1); PG8_STAGE(PG8_SB(1, 0), b3, voffB); PG8_STAGE(PG8_SB(1, 1), b3 + hstep, voffB); PG8_STAGE(PG8_SA(1, 0), a3, voffA);
            PG8_WAIT_V(8); PG8_WAIT_L(0); PG8_BAR; PG8_MMA(1, 0, At, B0); PG8_MMA(1, 1, At, B1); PG8_BAR; PG8_SCHED;
            } else {
            PG8_LDB(B0, 0, 0); PG8_SCHED; PG8_LDA(At, 0, 0); PG8_STAGE(PG8_SA(1, 1), a1 + hstep, voffA);
            PG8_WAIT_L(8); PG8_BAR; PG8_WAIT_L(0); PG8_MMA(0, 0, At, B0); PG8_BAR; PG8_SCHED;
            PG8_LDB(B1, 0, 1); PG8_STAGE(PG8_SB(0, 0), b2, voffB);
            PG8_BAR; PG8_WAIT_L(0); PG8_MMA(0, 1, At, B1); PG8_BAR;
            PG8_LDA(At, 0, 1); PG8_STAGE(PG8_SA(0, 0), a2, voffA);
            PG8_BAR; PG8_WAIT_L(0); PG8_MMA(1, 0, At, B0); PG8_BAR; PG8_SCHED;
            PG8_STAGE(PG8_SB(0, 1), b2 + hstep, voffB);
            PG8_WAIT_V(6); PG8_BAR; PG8_MMA(1, 1, At, B1); PG8_BAR;
            PG8_LDB(B0, 1, 0); PG8_SCHED; PG8_LDA(At, 1, 0); PG8_STAGE(PG8_SA(0, 1), a2 + hstep, voffA);
            PG8_WAIT_L(8); PG8_BAR; PG8_WAIT_L(0); PG8_MMA(0, 0, At, B0); PG8_BAR; PG8_SCHED;
            PG8_LDB(B1, 1, 1); PG8_STAGE(PG8_SB(1, 0), b3, voffB);
            PG8_BAR; PG8_WAIT_L(0); PG8_MMA(0, 1, At, B1); PG8_BAR;
            PG8_LDA(At, 1, 1); PG8_STAGE(PG8_SA(1, 0), a3, voffA);
            PG8_BAR; PG8_WAIT_L(0); PG8_MMA(1, 0, At, B0); PG8_BAR; PG8_SCHED;
            PG8_STAGE(PG8_SB(1, 1), b3 + hstep, voffB);
            PG8_WAIT_V(6); PG8_BAR; PG8_MMA(1, 1, At, B1); PG8_BAR;
            }
        }
        if constexpr (ALIGN_EPI) { if (wr == 0) PG8_BAR; }
        if constexpr (FP8) asm volatile("s_nop 15\n\ts_nop 7" ::: "memory");
        { Unit eu = cur; asm volatile("" : "+s"(eu.pm), "+s"(eu.pn));
          E(acc, eu, wr, wc, fr, fq); }
        if (!has_next) break;
#pragma unroll
        for (int a = 0; a < 2; ++a)
#pragma unroll
            for (int b = 0; b < 2; ++b)
#pragma unroll
                for (int m = 0; m < 4; ++m)
#pragma unroll
                    for (int n = 0; n < 2; ++n) acc[a][b][m][n] = (f32x4){0.f, 0.f, 0.f, 0.f};
        cur = nxt; cA = nA; cB = nB; ++ui;
        if constexpr (ALIGN_EPI) { if (wr == 1) PG8_BAR; }
    }
    PG8_WAIT_V(0);
    if constexpr (!ALIGN_EPI) { if (wr == 0) PG8_BAR; }
    PG8_BAR;
#undef PG8_SA
#undef PG8_SB
#undef PG8_STAGE
#undef PG8_LDA
#undef PG8_LDB
#undef PG8_MMA
#undef PG8_CAT2
#undef PG8_RD
#undef PG8_WAIT_V
#undef PG8_WAIT_L
#undef PG8_BAR
#undef PG8_SCHED
}
}

constexpr int NWAVES = 8, NTHR = 512;
constexpr int D = 1024, NB = 16, T = 2048, CT = 256;
constexpr int NL = NB * T;
constexpr int NC = NB * CT;
constexpr int NT = NL + NC;
constexpr int RW = 1792, HG = 2560, RIN = RW + HG;
constexpr int AW = 512;
constexpr int FF = 2816, FF2 = 2 * FF;
constexpr int QKVW = 1536;
constexpr int NEXP = 8;
constexpr int MAXPAN = 264;
constexpr int CHUNK_PAN = 128;
constexpr float NORM_EPS = 1e-6f, GN_EPS = 64e-5f;
constexpr float LOG2E = 1.4426950408889634f;

constexpr size_t MiB = 1u << 20;
constexpr size_t WS_CTL = 0, CTL_ZERO_BYTES = 1 * MiB;
constexpr size_t WS_MODS = 1 * MiB;
constexpr size_t WS_MISC = 2 * MiB;
constexpr size_t WS_ROPE = WS_MISC;
constexpr size_t WS_RCNT = WS_MISC + 8192;
constexpr size_t WS_PEXP = WS_MISC + 16384;
constexpr size_t WS_NPAN = WS_MISC + 18432;
constexpr size_t WS_TOPE = WS_MISC + 32768;
constexpr size_t WS_TOPW = WS_TOPE + (size_t)NL * 8;
constexpr size_t WS_SLOT = WS_TOPW + (size_t)NL * 8;
static_assert(WS_SLOT + (size_t)NL * 8 <= 4 * MiB, "misc");
constexpr size_t WS_WIN = 4 * MiB;
constexpr size_t WS_WLORA = WS_WIN + (size_t)RIN * D * 2;
constexpr size_t WS_WOUT0 = WS_WLORA + (size_t)2048 * 256 * 2;
constexpr size_t WS_WGU0 = WS_WOUT0 + (size_t)D * D * 2;
constexpr size_t WS_WD0 = WS_WGU0 + (size_t)FF2 * D * 2;
constexpr size_t WS_WATTIN = WS_WD0 + (size_t)D * FF * 2;
constexpr size_t WS_WATTOUT = WS_WATTIN + (size_t)QKVW * D * 2;
static_assert(WS_WATTOUT + (size_t)D * D * 2 <= 38 * MiB, "weights");
constexpr size_t WS_PHG = 38 * MiB;
constexpr size_t WS_H0 = 218 * MiB;
constexpr size_t WS_R = 218 * MiB, WS_KS = 254 * MiB, WS_V = 290 * MiB, WS_KK = 326 * MiB, WS_LB = 362 * MiB;
constexpr size_t WS_BB = 380 * MiB;
constexpr size_t WS_OF = 416 * MiB, WS_OB = 452 * MiB;
constexpr size_t WS_YMIX = 326 * MiB;
constexpr size_t WS_X1C = 308 * MiB;
constexpr size_t WS_X2 = 326 * MiB, WS_X2C = 390 * MiB;
constexpr size_t WS_F = 38 * MiB;
constexpr size_t WS_HFF = 110 * MiB;
constexpr size_t WS_H1 = 38 * MiB;
constexpr size_t WS_WMGU = 446 * MiB;
constexpr size_t WS_WMD = 490 * MiB;
constexpr size_t WS_QKV = 110 * MiB;
constexpr size_t WS_OATT = 218 * MiB;
constexpr size_t WS_FLAT = 170 * MiB;
constexpr size_t WS_ASORT = 38 * MiB;
constexpr size_t WS_A8 = 362 * MiB;
constexpr size_t WS_HMOE = 170 * MiB;
constexpr size_t WS_END = 512 * MiB;
static_assert(WS_WMD + (size_t)NEXP * D * FF <= WS_END && WS_WMGU + (size_t)NEXP * FF2 * D <= WS_WMD, "moe weights");
static_assert(WS_PHG + (size_t)NT * HG * 2 <= WS_H0 && WS_H0 + (size_t)NT * D * 2 <= WS_V, "layer0 a");
static_assert(WS_LB + (size_t)NT * 256 * 2 <= WS_BB && WS_BB + (size_t)NT * AW * 2 <= WS_OF && WS_OB + (size_t)NT * AW * 2 <= WS_END, "layer0 b");
static_assert(WS_HFF + (size_t)NT * FF * 2 <= WS_X1C && WS_X1C + (size_t)NC * D * 4 <= WS_YMIX, "layer0 c");
static_assert(WS_ASORT + (size_t)MAXPAN * 256 * D * 2 <= WS_HMOE && WS_HMOE + (size_t)MAXPAN * 256 * FF <= WS_A8 && WS_A8 + (size_t)MAXPAN * 256 * D <= WS_WMGU && WS_FLAT + (size_t)NL * D <= WS_A8, "moe bufs");
static_assert(WS_QKV + (size_t)NT * QKVW * 2 <= WS_OATT && WS_OATT + (size_t)NL * D * 2 <= WS_A8, "layer1");
constexpr size_t DO_PRW = 0, DO_LWF = 0, DO_LWB = 36 * MiB, DO_GG = 72 * MiB, DO_OHF = 0, DO_OHB = 36 * MiB;
static_assert((size_t)NT * RW * 2 <= 128 * MiB, "P_rwkv in d_out");

constexpr int CW_BAR = 4096;

constexpr int RING_BYTES = 147456;
constexpr int LDSCTL_OFF = RING_BYTES, MISC_OFF = LDSCTL_OFF + 320;
constexpr int LDS_BYTES = RING_BYTES + 1024;

#define GAS __attribute__((address_space(1)))
#define LAS __attribute__((address_space(3)))
typedef unsigned short bf16;
typedef unsigned v4u __attribute__((ext_vector_type(4)));
typedef unsigned v2u __attribute__((ext_vector_type(2)));
typedef float f32x4 __attribute__((ext_vector_type(4)));
typedef float f32x2 __attribute__((ext_vector_type(2)));
typedef float f32x16 __attribute__((ext_vector_type(16)));
typedef short bf16x8 __attribute__((ext_vector_type(8)));
typedef short s16x4 __attribute__((ext_vector_type(4)));
typedef __bf16 bf16x2_t __attribute__((ext_vector_type(2)));
#define LDS_WAIT() asm volatile("s_waitcnt lgkmcnt(0)" ::: "memory")
__device__ __forceinline__ unsigned pk2(float lo, float hi) { f32x2 v = {lo, hi}; bf16x2_t b = __builtin_convertvector(v, bf16x2_t); return __builtin_bit_cast(unsigned, b); }
__device__ __forceinline__ unsigned pk4_fp8(float a, float b, float c, float d) {
    a = fminf(fmaxf(a, -448.f), 448.f); b = fminf(fmaxf(b, -448.f), 448.f); c = fminf(fmaxf(c, -448.f), 448.f); d = fminf(fmaxf(d, -448.f), 448.f);
    int p = __builtin_amdgcn_cvt_pk_fp8_f32(a, b, 0, false); p = __builtin_amdgcn_cvt_pk_fp8_f32(c, d, p, true); return (unsigned)p;
}
__device__ __forceinline__ float bflo(unsigned u) { return __uint_as_float(u << 16); }
__device__ __forceinline__ float bfhi(unsigned u) { return __uint_as_float(u & 0xffff0000u); }
__device__ __forceinline__ float fsigmoid(float x) { return __builtin_amdgcn_rcpf(1.f + __expf(-x)); }
__device__ __forceinline__ float fsilu(float x) { return x * fsigmoid(x); }
__device__ __forceinline__ float ftanh(float x) { return 1.f - 2.f * __builtin_amdgcn_rcpf(1.f + __expf(2.f * x)); }
__device__ __forceinline__ float wave_sum(float v) {
#pragma unroll
    for (int o = 1; o < 64; o <<= 1) v += __shfl_xor(v, o);
    return v;
}
template <int CTRL> __device__ __forceinline__ float dpp_f(float v) { return __builtin_bit_cast(float, __builtin_amdgcn_update_dpp(0, __builtin_bit_cast(int, v), CTRL, 0xf, 0xf, true)); }
__device__ __forceinline__ float sum8(float v) { v += dpp_f<0xB1>(v); v += dpp_f<0x4E>(v); v += dpp_f<0x141>(v); return v; }
__device__ __forceinline__ float sum16(float v) { v = sum8(v); v += dpp_f<0x140>(v); return v; }

#define XB_TMO      128
#define XB_XCNT(j)  (256  + 64 * (j))
#define XB_XSUB(j)  (1280 + 64 * (j))
#define XB_XGEN(j)  (2304 + 64 * (j))
#define XB_TOP      3328
#define XB_TOPGEN   3392
#define XCD_BAR_WORDS 3456
#define XB_SPIN_CAP (1u << 18)
__device__ __forceinline__ unsigned xb_ld(unsigned* p)              { return __hip_atomic_load(p, __ATOMIC_RELAXED, __HIP_MEMORY_SCOPE_AGENT); }
__device__ __forceinline__ unsigned xb_add(unsigned* p, unsigned v) { return __hip_atomic_fetch_add(p, v, __ATOMIC_RELAXED, __HIP_MEMORY_SCOPE_AGENT); }
__device__ __forceinline__ unsigned xb_xcc_id() { return (unsigned)__builtin_amdgcn_s_getreg((3 << 11) | 20) & 0xFu; }
#define XB_SPIN(cond, bar) do { unsigned _sp = 0; while (cond) { __builtin_amdgcn_s_sleep(1); \
    if ((++_sp & 255u) == 0u) { if (xb_ld(&(bar)[XB_TMO])) break; if (_sp > XB_SPIN_CAP) { atomicAdd(&(bar)[XB_TMO], 1u); break; } } } } while (0)
struct XcdBarrier { unsigned* bar; unsigned x; volatile LAS unsigned* st; };
__device__ __forceinline__ XcdBarrier xcd_barrier_post(unsigned* bar, volatile LAS unsigned* st) {
    XcdBarrier b; b.bar = bar; b.x = xb_xcc_id(); b.st = st;
    if (threadIdx.x == 0) (void)xb_add(&bar[XB_XCNT(b.x)], 1u);
    return b;
}
__device__ __forceinline__ void xcd_barrier_complete(unsigned* bar, unsigned x, unsigned& nloc, unsigned& nx) {
    const unsigned G = gridDim.x * gridDim.y * gridDim.z;
    unsigned sum, cnt, mine, sp = 0u;
    for (;;) {
        sum = 0u; cnt = 0u; mine = 0u;
#pragma unroll
        for (unsigned j = 0; j < 16; ++j) { const unsigned c = xb_ld(&bar[XB_XCNT(j)]); sum += c; cnt += (c > 0u) ? 1u : 0u; mine = (j == x) ? c : mine; }
        if (sum == G) break;
        __builtin_amdgcn_s_sleep(1);
        if ((++sp & 255u) == 0u) { if (xb_ld(&bar[XB_TMO])) break; if (sp > XB_SPIN_CAP) { atomicAdd(&bar[XB_TMO], 1u); break; } }
    }
    nloc = mine > 0u ? mine : 1u; nx = cnt > 0u ? cnt : 1u;
}
__device__ __forceinline__ void xcd_barrier(const XcdBarrier& b) {
    asm volatile("s_waitcnt vmcnt(0)" ::: "memory");
    __syncthreads();
    if (threadIdx.x == 0) {
        unsigned* bar = b.bar;
        __builtin_amdgcn_s_waitcnt(0);
        unsigned nloc = b.st[0], nx = b.st[1];
        if (nloc == 0u) { xcd_barrier_complete(bar, b.x, nloc, nx); b.st[0] = nloc; b.st[1] = nx; }
        const unsigned old = xb_add(&bar[XB_XSUB(b.x)], 1u);
        const unsigned gen = old / nloc;
        if (old + 1u == (gen + 1u) * nloc) {
            __builtin_amdgcn_fence(__ATOMIC_RELEASE, "agent");
            asm volatile("s_waitcnt vmcnt(0)" ::: "memory");
            const unsigned og = xb_add(&bar[XB_TOP], 1u);
            const unsigned tg = og / nx;
            if (og + 1u == (tg + 1u) * nx) xb_add(&bar[XB_TOPGEN], 1u);
            else XB_SPIN(xb_ld(&bar[XB_TOPGEN]) == tg, bar);
            __builtin_amdgcn_fence(__ATOMIC_ACQUIRE, "agent");
            xb_add(&bar[XB_XGEN(b.x)], 1u);
            asm volatile("s_waitcnt vmcnt(0)" ::: "memory");
        } else {
            XB_SPIN(xb_ld(&bar[XB_XGEN(b.x)]) == gen, bar);
            __builtin_amdgcn_fence(__ATOMIC_ACQUIRE, "agent");
            asm volatile("s_waitcnt vmcnt(0)" ::: "memory");
        }
    }
    __syncthreads();
}

struct Args { const float* in[35]; float* out; unsigned char* ws; int ph_lo, ph_hi; };
enum InIdx { I_X = 0, I_C, I_CTX, I_CCTX, I_MODW, I_MODB, I_NMIX, I_NFFN, I_NFIN, I_RWIN, I_RWOUT, I_MU, I_W0, I_WUP, I_A0, I_AUP, I_GUP, I_KK, I_KA, I_RK, I_LNW, I_LNB,
             I_HLB, I_HNORM, I_FG, I_FU, I_FD, I_AWIN, I_AWOUT, I_SINK, I_ROUTER, I_ROUTERB, I_MG, I_MU2, I_MD };
struct Frame {
    LAS unsigned char* lds;
    int tid, lane, wave, G, bid;
    float* out; unsigned char* ws;
};

namespace epi {
using pg8::Unit; using pg8::f32x4; using pg8::u32x4; using pg8::u32x2; using pg8::bf16_t; using pg8::HALF; using pg8::BM;
__device__ __forceinline__ u32x4 pack8(const f32x4& v0, const f32x4& v1) { u32x4 w; w.x = pk2(v0[0], v0[1]); w.y = pk2(v0[2], v0[3]); w.z = pk2(v1[0], v1[1]); w.w = pk2(v1[2], v1[3]); return w; }

struct EpiP {
    static constexpr bool PERM = true;
    bf16_t* P0; bf16_t* P1;
    __device__ __forceinline__ void operator()(const f32x4 (&acc)[2][2][4][2], const Unit& u, int wr, int wc, int fr, int fq) const {
        const int row0 = u.pm * BM + wr * 64 + fr; int colt = u.pn * BM; bf16_t* base = P0; int ld = RW;
        if (u.pn >= RW / 256) { base = P1; ld = HG; colt -= RW; }
        const int col0 = colt + wc * 32 + 8 * fq;
#pragma unroll
        for (int ai = 0; ai < 2; ++ai)
#pragma unroll
            for (int m = 0; m < 4; ++m) { bf16_t* rowp = base + (size_t)(row0 + ai * HALF + m * 16) * ld + col0;
#pragma unroll
                for (int bj = 0; bj < 2; ++bj) *(u32x4*)(rowp + bj * HALF) = pack8(acc[ai][bj][m][0], acc[ai][bj][m][1]); }
    }
};

struct EpiLora {
    static constexpr bool PERM = true;
    const float* w0; const float* a0; const float* k_a;
    bf16_t* LWF; bf16_t* LWB; bf16_t* KS; const bf16_t* KK; bf16_t* BB; bf16_t* GG;
    __device__ __forceinline__ void operator()(const f32x4 (&acc)[2][2][4][2], const Unit& u, int wr, int wc, int fr, int fq) const {
        const int row0 = u.pm * BM + wr * 64 + fr; const int q = u.pn >> 1;
        const int cc0 = (u.pn & 1) * 256 + wc * 32 + 8 * fq;
#pragma unroll
        for (int bj = 0; bj < 2; ++bj) { const int cc = cc0 + bj * HALF;
            if (q < 2) {
                const f32x4 z0 = *(const f32x4*)(w0 + q * AW + cc), z1 = *(const f32x4*)(w0 + q * AW + cc + 4); bf16_t* O = q ? LWB : LWF;
#pragma unroll
                for (int ai = 0; ai < 2; ++ai)
#pragma unroll
                    for (int m = 0; m < 4; ++m) { f32x4 v0 = acc[ai][bj][m][0] + z0, v1 = acc[ai][bj][m][1] + z1;
#pragma unroll
                        for (int j = 0; j < 4; ++j) { v0[j] = -0.6065306597f * fsigmoid(v0[j]); v1[j] = -0.6065306597f * fsigmoid(v1[j]); }
                        *(u32x4*)(O + (size_t)(row0 + ai * HALF + m * 16) * AW + cc) = pack8(v0, v1); asm volatile("" ::: "memory"); }
            } else if (q == 2) {
                const f32x4 z0 = *(const f32x4*)(a0 + cc), z1 = *(const f32x4*)(a0 + cc + 4), ka0 = *(const f32x4*)(k_a + cc), ka1 = *(const f32x4*)(k_a + cc + 4);
#pragma unroll
                for (int ai = 0; ai < 2; ++ai)
#pragma unroll
                    for (int m = 0; m < 4; ++m) { const size_t off = (size_t)(row0 + ai * HALF + m * 16) * AW + cc;
                        f32x4 a_0 = acc[ai][bj][m][0] + z0, a_1 = acc[ai][bj][m][1] + z1;
                        const u32x4 kw = *(const u32x4*)(KS + off), kkw = *(const u32x4*)(KK + off);
                        f32x4 k0 = {bflo(kw.x), bfhi(kw.x), bflo(kw.y), bfhi(kw.y)}, k1 = {bflo(kw.z), bfhi(kw.z), bflo(kw.w), bfhi(kw.w)};
                        f32x4 q0 = {bflo(kkw.x), bfhi(kkw.x), bflo(kkw.y), bfhi(kkw.y)}, q1 = {bflo(kkw.z), bfhi(kkw.z), bflo(kkw.w), bfhi(kkw.w)};
#pragma unroll
                        for (int j = 0; j < 4; ++j) { const float s0 = fsigmoid(a_0[j]), s1 = fsigmoid(a_1[j]);
                            k0[j] = k0[j] * (1.f + (s0 - 1.f) * ka0[j]); k1[j] = k1[j] * (1.f + (s1 - 1.f) * ka1[j]); q0[j] *= s0; q1[j] *= s1; }
                        *(u32x4*)(KS + off) = pack8(k0, k1); *(u32x4*)(BB + off) = pack8(q0, q1); asm volatile("" ::: "memory"); }
            } else {
#pragma unroll
                for (int ai = 0; ai < 2; ++ai)
#pragma unroll
                    for (int m = 0; m < 4; ++m) *(u32x4*)(GG + (size_t)(row0 + ai * HALF + m * 16) * AW + cc) = pack8(acc[ai][bj][m][0], acc[ai][bj][m][1]);
            }
        }
    }
};

template <bool R16, bool O16>
struct EpiResT {
    static constexpr bool PERM = true;
    const void* resL; void* outL; const void* resC; void* outC; const float* gateBase; int ldo; float ys = 1.f;
    __device__ __forceinline__ void operator()(const f32x4 (&acc)[2][2][4][2], const Unit& u, int wr, int wc, int fr, int fq) const {
        const bool lat = u.pm < NL / 256; const int s = lat ? (u.pm >> 3) : NB;
        const void* res = lat ? resL : resC; void* out = lat ? outL : outC; const int prow = lat ? u.pm : u.pm - NL / 256;
        const int row0 = prow * BM + wr * 64 + fr, col0 = u.pn * BM + wc * 32 + 8 * fq;
        const float* gate = gateBase + (size_t)s * 6144 + col0;
        f32x4 gv[2][2];
#pragma unroll
        for (int bj = 0; bj < 2; ++bj)
#pragma unroll
            for (int n = 0; n < 2; ++n) gv[bj][n] = *(const f32x4*)(gate + bj * HALF + n * 4) * ys;
#pragma unroll
        for (int ai = 0; ai < 2; ++ai)
#pragma unroll
            for (int m = 0; m < 4; ++m) { const size_t off = (size_t)(row0 + ai * HALF + m * 16) * D + col0, offo = (size_t)(row0 + ai * HALF + m * 16) * ldo + col0;
#pragma unroll
                for (int bj = 0; bj < 2; ++bj) { f32x4 r0, r1;
                    if constexpr (R16) { const u32x4 w = *(const u32x4*)((const bf16_t*)res + off + bj * HALF); r0 = (f32x4){bflo(w.x), bfhi(w.x), bflo(w.y), bfhi(w.y)}; r1 = (f32x4){bflo(w.z), bfhi(w.z), bflo(w.w), bfhi(w.w)}; }
                    else { r0 = *(const f32x4*)((const float*)res + off + bj * HALF); r1 = *(const f32x4*)((const float*)res + off + bj * HALF + 4); }
                    const f32x4 v0 = r0 + gv[bj][0] * acc[ai][bj][m][0], v1 = r1 + gv[bj][1] * acc[ai][bj][m][1];
                    if constexpr (O16) *(u32x4*)((bf16_t*)out + offo + bj * HALF) = pack8(v0, v1);
                    else { *(f32x4*)((float*)out + offo + bj * HALF) = v0; *(f32x4*)((float*)out + offo + bj * HALF + 4) = v1; } }
                asm volatile("" ::: "memory"); }
    }
};

struct EpiResAtomic {
    static constexpr bool PERM = false;
    float* outC; const float* gate;
    __device__ __forceinline__ void operator()(const f32x4 (&acc)[2][2][4][2], const Unit& u, int wr, int wc, int fr, int fq) const {
        const int row0 = u.pm * BM + wr * 64 + fr, col0 = u.pn * BM + wc * 32 + 4 * fq;
#pragma unroll
        for (int bj = 0; bj < 2; ++bj)
#pragma unroll
            for (int n = 0; n < 2; ++n) { const f32x4 gv = *(const f32x4*)(gate + col0 + bj * HALF + n * 16);
#pragma unroll
                for (int ai = 0; ai < 2; ++ai)
#pragma unroll
                    for (int m = 0; m < 4; ++m) { float* p = outC + (size_t)(row0 + ai * HALF + m * 16) * D + col0 + bj * HALF + n * 16;
#pragma unroll
                        for (int j = 0; j < 4; ++j) __hip_atomic_fetch_add(p + j, gv[j] * acc[ai][bj][m][n][j], __ATOMIC_RELAXED, __HIP_MEMORY_SCOPE_AGENT); } }
    }
};
struct EpiPartY {
    static constexpr bool PERM = false;
    float* Yp;
    __device__ __forceinline__ void operator()(const f32x4 (&acc)[2][2][4][2], const Unit& u, int wr, int wc, int fr, int fq) const {
        const int row0 = u.pm * BM + wr * 64 + fr, col0 = u.pn * BM + wc * 32 + 4 * fq; float* base = Yp + (size_t)(u.ko >> 8) * ((size_t)(MAXPAN - 2 * CHUNK_PAN) * 256 * D);
#pragma unroll
        for (int ai = 0; ai < 2; ++ai)
#pragma unroll
            for (int m = 0; m < 4; ++m)
#pragma unroll
                for (int bj = 0; bj < 2; ++bj)
#pragma unroll
                    for (int n = 0; n < 2; ++n) *(f32x4*)(base + (size_t)(row0 + ai * HALF + m * 16) * D + col0 + bj * HALF + n * 16) = acc[ai][bj][m][n];
    }
};

struct EpiSwiGLU {
    static constexpr bool PERM = true;
    bf16_t* H;
    __device__ __forceinline__ void operator()(const f32x4 (&acc)[2][2][4][2], const Unit& u, int wr, int wc, int fr, int fq) const {
        const int row0 = u.pm * BM + wr * 64 + fr, col0 = u.pn * HALF + wc * 32 + 8 * fq;
#pragma unroll
        for (int ai = 0; ai < 2; ++ai)
#pragma unroll
            for (int m = 0; m < 4; ++m) { f32x4 v0, v1;
#pragma unroll
                for (int j = 0; j < 4; ++j) { v0[j] = fsilu(acc[ai][0][m][0][j]) * acc[ai][1][m][0][j]; v1[j] = fsilu(acc[ai][0][m][1][j]) * acc[ai][1][m][1][j]; }
                *(u32x4*)(H + (size_t)(row0 + ai * HALF + m * 16) * FF + col0) = pack8(v0, v1); }
    }
};

struct EpiSwiGLU8 {
    static constexpr bool PERM = true;
    unsigned char* H; float inv, hs;
    __device__ __forceinline__ void operator()(const f32x4 (&acc)[2][2][4][2], const Unit& u, int wr, int wc, int fr, int fq) const {
        const int row0 = u.pm * BM + wr * 64 + fr, col0 = u.pn * HALF + wc * 32 + 8 * fq;
#pragma unroll
        for (int ai = 0; ai < 2; ++ai)
#pragma unroll
            for (int m = 0; m < 4; ++m) { f32x4 v0, v1;
#pragma unroll
                for (int j = 0; j < 4; ++j) { v0[j] = fsilu(acc[ai][0][m][0][j] * inv) * (acc[ai][1][m][0][j] * inv) * hs; v1[j] = fsilu(acc[ai][0][m][1][j] * inv) * (acc[ai][1][m][1][j] * inv) * hs; }
                u32x2 w; w.x = pk4_fp8(v0[0], v0[1], v0[2], v0[3]); w.y = pk4_fp8(v1[0], v1[1], v1[2], v1[3]);
                *(u32x2*)(H + (size_t)(row0 + ai * HALF + m * 16) * FF + col0) = w; asm volatile("" ::: "memory"); }
    }
};
struct EpiBf16S {
    static constexpr bool PERM = true;
    bf16_t* O; int ld; float s;
    __device__ __forceinline__ void operator()(const f32x4 (&acc)[2][2][4][2], const Unit& u, int wr, int wc, int fr, int fq) const {
        const int row0 = u.pm * BM + wr * 64 + fr, col0 = u.pn * BM + wc * 32 + 8 * fq;
#pragma unroll
        for (int ai = 0; ai < 2; ++ai)
#pragma unroll
            for (int m = 0; m < 4; ++m) { bf16_t* rowp = O + (size_t)(row0 + ai * HALF + m * 16) * ld + col0;
#pragma unroll
                for (int bj = 0; bj < 2; ++bj) *(u32x4*)(rowp + bj * HALF) = pack8(acc[ai][bj][m][0] * s, acc[ai][bj][m][1] * s); }
    }
};
struct EpiBf16 {
    static constexpr bool PERM = true;
    bf16_t* O; int ld;
    __device__ __forceinline__ void operator()(const f32x4 (&acc)[2][2][4][2], const Unit& u, int wr, int wc, int fr, int fq) const {
        const int row0 = u.pm * BM + wr * 64 + fr, col0 = u.pn * BM + wc * 32 + 8 * fq;
#pragma unroll
        for (int ai = 0; ai < 2; ++ai)
#pragma unroll
            for (int m = 0; m < 4; ++m) { bf16_t* rowp = O + (size_t)(row0 + ai * HALF + m * 16) * ld + col0;
#pragma unroll
                for (int bj = 0; bj < 2; ++bj) *(u32x4*)(rowp + bj * HALF) = pack8(acc[ai][bj][m][0], acc[ai][bj][m][1]); }
    }
};

struct EpiQKV {
    static constexpr bool PERM = true;
    bf16_t* O; const float* rope;
    __device__ __forceinline__ void operator()(const f32x4 (&acc)[2][2][4][2], const Unit& u, int wr, int wc, int fr, int fq) const {
        const int row0 = u.pm * BM + wr * 64 + fr, col0 = u.pn * BM + wc * 32 + 8 * fq;
        const bool lat = u.pm < NL / 256, isv = u.pn == 5, isq = u.pn < 4;
        const int axis = wc & 1;
        const float qs = isq ? 0.125f * LOG2E : 1.f;
#pragma unroll
        for (int ai = 0; ai < 2; ++ai)
#pragma unroll
            for (int m = 0; m < 4; ++m) { const int row = row0 + ai * HALF + m * 16; bf16_t* rowp = O + (size_t)row * QKVW + col0;
                f32x4 c0 = {1.f, 0.f, 1.f, 0.f}, c1 = {1.f, 0.f, 1.f, 0.f};
                if (lat && !isv) { const int t = row & (T - 1), pos = axis ? (t & 63) : (t >> 6); const float* rp = rope + (pos * 16 + 4 * fq) * 2; c0 = *(const f32x4*)rp; c1 = *(const f32x4*)(rp + 4); }
#pragma unroll
                for (int bj = 0; bj < 2; ++bj) { const f32x4 a = acc[ai][bj][m][0], b = acc[ai][bj][m][1]; f32x4 v0, v1;
                    v0[0] = (a[0] * c0[0] - a[1] * c0[1]) * qs; v0[1] = (a[1] * c0[0] + a[0] * c0[1]) * qs;
                    v0[2] = (a[2] * c0[2] - a[3] * c0[3]) * qs; v0[3] = (a[3] * c0[2] + a[2] * c0[3]) * qs;
                    v1[0] = (b[0] * c1[0] - b[1] * c1[1]) * qs; v1[1] = (b[1] * c1[0] + b[0] * c1[1]) * qs;
                    v1[2] = (b[2] * c1[2] - b[3] * c1[3]) * qs; v1[3] = (b[3] * c1[2] + b[2] * c1[3]) * qs;
                    *(u32x4*)(rowp + bj * HALF) = pack8(v0, v1); } }
    }
};
}

__device__ __forceinline__ void tr_item(const float* src, int ldS, int k0, int n0, bf16* dst, int ldD, int drow0, int dcol0, bool rperm, LAS float* scr, int lane) {
    const int c4 = (lane & 7) * 4, r0 = lane >> 3;
    f32x4 v[8];
#pragma unroll
    for (int i = 0; i < 8; ++i) v[i] = *(const f32x4*)(src + (size_t)(k0 + r0 + 8 * i) * ldS + n0 + c4);
#pragma unroll
    for (int i = 0; i < 8; ++i) { LAS float* d = scr + (r0 + 8 * i) * 33;
#pragma unroll
        for (int q = 0; q < 4; ++q) { const int nl = c4 + q, pn = rperm ? (((nl & 15) << 1) | (nl >> 4)) : nl; d[pn] = v[i][q]; } }
    LDS_WAIT(); asm volatile("" ::: "memory");
    const int c = lane & 7;
#pragma unroll
    for (int j = 0; j < 4; ++j) { const int n = (lane >> 3) + 8 * j; const LAS float* s = scr + (8 * c) * 33 + n;
        v4u o; o.x = pk2(s[0 * 33], s[1 * 33]); o.y = pk2(s[2 * 33], s[3 * 33]); o.z = pk2(s[4 * 33], s[5 * 33]); o.w = pk2(s[6 * 33], s[7 * 33]);
        *(v4u*)(dst + (size_t)(drow0 + n) * ldD + dcol0 + 8 * c) = o; }
    LDS_WAIT(); asm volatile("" ::: "memory");
}
__device__ __forceinline__ void tr_item8(const float* src, int ldS, int k0, int n0, unsigned char* dst, int ldD, int drow0, int dcol0, float scale, LAS float* scr, int lane) {
    const int c4 = (lane & 7) * 4, r0 = lane >> 3;
    f32x4 v[8];
#pragma unroll
    for (int i = 0; i < 8; ++i) v[i] = *(const f32x4*)(src + (size_t)(k0 + r0 + 8 * i) * ldS + n0 + c4);
#pragma unroll
    for (int i = 0; i < 8; ++i) { LAS float* d = scr + (r0 + 8 * i) * 33;
#pragma unroll
        for (int q = 0; q < 4; ++q) d[c4 + q] = v[i][q] * scale; }
    LDS_WAIT(); asm volatile("" ::: "memory");
    const int c = lane & 3;
#pragma unroll
    for (int j = 0; j < 2; ++j) { const int n = (lane >> 2) + 16 * j; const LAS float* s = scr + (16 * c) * 33 + n;
        v4u o; o.x = pk4_fp8(s[0 * 33], s[1 * 33], s[2 * 33], s[3 * 33]); o.y = pk4_fp8(s[4 * 33], s[5 * 33], s[6 * 33], s[7 * 33]);
        o.z = pk4_fp8(s[8 * 33], s[9 * 33], s[10 * 33], s[11 * 33]); o.w = pk4_fp8(s[12 * 33], s[13 * 33], s[14 * 33], s[15 * 33]);
        *(v4u*)(dst + (size_t)(drow0 + n) * ldD + dcol0 + 16 * c) = o; }
    LDS_WAIT(); asm volatile("" ::: "memory");
}
__device__ __forceinline__ void tr_gu_item8(const float* wg, const float* wu, unsigned char* dst, int it, float scale, LAS float* scr, int lane) {
    const int which = it / 1408, r = it % 1408, kb = r / 88, nb = r % 88, n0 = nb * 32;
    tr_item8(which ? wu : wg, FF, kb * 64, n0, dst, D, (n0 >> 7) * 256 + which * 128 + (n0 & 127), kb * 64, scale, scr, lane);
}
__device__ __forceinline__ void tr_plain_item8(const float* w, int K, int N, unsigned char* dst, int it, float scale, LAS float* scr, int lane) {
    const int nblk = N / 32, kb = it / nblk, nb = it % nblk;
    tr_item8(w, N, kb * 64, nb * 32, dst, K, nb * 32, kb * 64, scale, scr, lane);
}
__device__ __forceinline__ void tr_gu_item(const float* wg, const float* wu, bf16* dst, int it, LAS float* scr, int lane) {
    const int which = it / 1408, r = it % 1408, kb = r / 88, nb = r % 88, n0 = nb * 32;
    tr_item(which ? wu : wg, FF, kb * 64, n0, dst, D, (n0 >> 7) * 256 + which * 128 + (n0 & 127), kb * 64, false, scr, lane);
}
__device__ __forceinline__ void tr_plain_item(const float* w, int K, int N, bf16* dst, int it, LAS float* scr, int lane) {
    const int nblk = N / 32, kb = it / nblk, nb = it % nblk;
    tr_item(w, N, kb * 64, nb * 32, dst, K, nb * 32, kb * 64, false, scr, lane);
}

constexpr int PW_IN = 16 * (RIN / 32), PW_SQ = 16 * 32, PW_GU = 2 * 1408, PW_DN = 44 * 32, PW_AI = 16 * (QKVW / 32), PW_LORA = 16 + 16 + 16 + 32;
constexpr float FFN_SW = 64.f, FFN_SA = 8.f, FFN_SH = 8.f;
constexpr int PW_ITEMS = PW_IN + PW_SQ + PW_GU + PW_DN + PW_AI + PW_SQ + PW_LORA;
__device__ __forceinline__ void phase_layer_weights(const Frame& F, const Args& a, int lo, int hi, int first) {
    if (F.bid < first) return;
    LAS float* scr = (LAS float*)(F.lds + F.wave * 8704);
    const int gw = (F.bid - first) * NWAVES + F.wave, NGW = (F.G - first) * NWAVES;
    bf16* Win = (bf16*)(F.ws + WS_WIN); bf16* Wlora = (bf16*)(F.ws + WS_WLORA); bf16* Wout0 = (bf16*)(F.ws + WS_WOUT0); bf16* Wgu0 = (bf16*)(F.ws + WS_WGU0);
    bf16* Wd0 = (bf16*)(F.ws + WS_WD0); bf16* Wai = (bf16*)(F.ws + WS_WATTIN); bf16* Wao = (bf16*)(F.ws + WS_WATTOUT);
    for (int it = lo + gw; it < hi; it += NGW) {
        int r = it;
        if (r < PW_IN) { tr_plain_item(a.in[I_RWIN], D, RIN, Win, r, scr, F.lane); continue; } r -= PW_IN;
        if (r < PW_SQ) { tr_plain_item(a.in[I_RWOUT], D, D, Wout0, r, scr, F.lane); continue; } r -= PW_SQ;
        if (r < PW_GU) { tr_gu_item(a.in[I_FG], a.in[I_FU], Wgu0, r, scr, F.lane); continue; } r -= PW_GU;
        if (r < PW_DN) { tr_plain_item8(a.in[I_FD], FF, D, (unsigned char*)Wd0, r, FFN_SW, scr, F.lane); continue; } r -= PW_DN;
        if (r < PW_AI) { const int kb = r / (QKVW / 32), nb = r % (QKVW / 32); tr_item(a.in[I_AWIN], QKVW, kb * 64, nb * 32, Wai, D, nb * 32, kb * 64, nb < 40, scr, F.lane); continue; } r -= PW_AI;
        if (r < PW_SQ) { tr_plain_item(a.in[I_AWOUT], D, D, Wao, r, scr, F.lane); continue; } r -= PW_SQ;
        if (r < 32) { const int d = r >> 4, nb = r & 15; tr_item(a.in[I_WUP] + (size_t)d * 64 * AW, AW, 0, nb * 32, Wlora, 256, d * AW + nb * 32, 0, false, scr, F.lane); continue; } r -= 32;
        if (r < 16) { tr_item(a.in[I_AUP], AW, 0, r * 32, Wlora, 256, 1024 + r * 32, 64, false, scr, F.lane); continue; } r -= 16;
        { const int kb = r >> 4, nb = r & 15; tr_item(a.in[I_GUP], AW, kb * 64, nb * 32, Wlora, 256, 1536 + nb * 32, 128 + kb * 64, false, scr, F.lane); }
    }
}
__device__ __forceinline__ void phase_prologue(const Frame& F, const Args& a) {
    bf16* Wlora = (bf16*)(F.ws + WS_WLORA);
    phase_layer_weights(F, a, 0, PW_IN, 0);
    for (int i = (F.bid * NTHR + F.tid); i < 2048 * 32; i += F.G * NTHR) { const int row = i >> 5, k = (i & 31) * 8;
        const bool nz = row < 1024 ? (k < 64) : (row < 1536 ? (k >= 64 && k < 128) : (k >= 128));
        if (!nz) *(v4u*)(Wlora + (size_t)row * 256 + k) = (v4u){0u, 0u, 0u, 0u}; }
    if (F.bid == 0) for (int i = F.tid; i < 1024; i += NTHR) { const int pos = i >> 4, ii = i & 15; const float inv = exp2f(-(float)ii * (13.287712379549449f / 16.f)); const float ang = (float)pos * inv;
        float* rp = (float*)(F.ws + WS_ROPE) + 2 * i; rp[0] = __cosf(ang); rp[1] = __sinf(ang); }
    __syncthreads();
    {
        LAS float* sc = (LAS float*)(F.lds + 36864);
        LAS float* red = (LAS float*)(F.lds);
        if (F.bid < 192) {
            for (int i = F.tid; i < 17 * 1024; i += NTHR) { const int s = i >> 10, k = i & 1023; const float v = s < NB ? a.in[I_C][s * D + k] : a.in[I_CCTX][k]; sc[i] = fsilu(v); }
            __syncthreads();
        }
        for (int u = F.bid; u < 192; u += F.G) {
            const int l = u / 96, col0 = (u % 96) * 64, c4 = F.tid & 15, kg = F.tid >> 4;
            f32x4 acc[17];
#pragma unroll
            for (int s = 0; s < 17; ++s) acc[s] = (f32x4){0.f, 0.f, 0.f, 0.f};
            const float* wp = a.in[I_MODW] + ((size_t)l * D + kg * 32) * 6144 + col0 + c4 * 4;
            for (int kk = 0; kk < 32; ++kk) { const f32x4 w = *(const f32x4*)(wp + (size_t)kk * 6144); const int k = kg * 32 + kk;
#pragma unroll
                for (int s = 0; s < 17; ++s) acc[s] += w * sc[s * 1024 + k]; }
#pragma unroll
            for (int s = 0; s < 17; ++s)
#pragma unroll
                for (int j = 0; j < 4; ++j) { float v = acc[s][j]; v += __shfl_xor(v, 16); v += __shfl_xor(v, 32); acc[s][j] = v; }
            if (F.lane < 16) {
#pragma unroll
                for (int s = 0; s < 17; ++s) *(LAS f32x4*)(red + (F.wave * 17 + s) * 64 + c4 * 4) = acc[s];
            }
            __syncthreads();
            for (int i = F.tid; i < 17 * 64; i += NTHR) { const int s = i >> 6, c = i & 63; float v = a.in[I_MODB][l * 6144 + col0 + c];
#pragma unroll
                for (int w = 0; w < 8; ++w) v += red[(w * 17 + s) * 64 + c];
                ((float*)(F.ws + WS_MODS))[((size_t)l * 17 + s) * 6144 + col0 + c] = v; }
            __syncthreads();
        }
    }
}

constexpr int MW_DOWN = NEXP * 1408, MW_ITEMS = MW_DOWN + NEXP * 2816;
constexpr float MOE_SW = 64.f, MOE_SA = 8.f, MOE_SH = 8.f;
__device__ __forceinline__ void phase_moe_weights(const Frame& F, const Args& a, int lo, int hi, int first) {
    if (F.bid < first) return;
    LAS float* scr = (LAS float*)(F.lds + F.wave * 8704);
    const int gw = (F.bid - first) * NWAVES + F.wave, NGW = (F.G - first) * NWAVES;
    unsigned char* Wgu = F.ws + WS_WMGU; unsigned char* Wd = F.ws + WS_WMD;
    for (int it = lo + gw; it < hi; it += NGW) {
        if (it < MW_DOWN) { const int e = it / 1408, r = it % 1408; tr_plain_item8(a.in[I_MD] + (size_t)e * FF * D, FF, D, Wd + (size_t)e * D * FF, r, MOE_SW, scr, F.lane); }
        else { const int i2 = it - MW_DOWN, e = NEXP - 1 - i2 / 2816, r = i2 % 2816; tr_gu_item8(a.in[I_MG] + (size_t)e * D * FF, a.in[I_MU2] + (size_t)e * D * FF, Wgu + (size_t)e * FF2 * D, r, MOE_SW, scr, F.lane); }
    }
}

__device__ __forceinline__ void load_row(const float* p, int lane, f32x4 (&v)[4]) {
#pragma unroll
    for (int j = 0; j < 4; ++j) v[j] = *(const f32x4*)(p + 256 * j + 4 * lane);
}
__device__ __forceinline__ void norm_mod(f32x4 (&v)[4], const float* gain, const float* shift, const float* scale, int lane) {
    float ss = 0.f;
#pragma unroll
    for (int j = 0; j < 4; ++j) ss += (v[j][0] * v[j][0] + v[j][1] * v[j][1]) + (v[j][2] * v[j][2] + v[j][3] * v[j][3]);
    const float r = __builtin_amdgcn_rsqf(wave_sum(ss) * (1.f / D) + NORM_EPS);
#pragma unroll
    for (int j = 0; j < 4; ++j) { const int c = 256 * j + 4 * lane; const f32x4 g = *(const f32x4*)(gain + c), sh = *(const f32x4*)(shift + c), sc = *(const f32x4*)(scale + c);
        v[j] = v[j] * r * g * (sc + 1.f) + sh; }
}
__device__ __forceinline__ void store_row_bf16(bf16* p, int lane, const f32x4 (&v)[4]) {
#pragma unroll
    for (int j = 0; j < 4; ++j) { v2u o; o.x = pk2(v[j][0], v[j][1]); o.y = pk2(v[j][2], v[j][3]); *(v2u*)(p + 256 * j + 4 * lane) = o; }
}
__device__ __forceinline__ void load_row16(const bf16* p, int lane, f32x4 (&v)[4]) {
#pragma unroll
    for (int j = 0; j < 4; ++j) { const v2u u = *(const v2u*)(p + 256 * j + 4 * lane); v[j] = (f32x4){bflo(u.x), bfhi(u.x), bflo(u.y), bfhi(u.y)}; }
}
__device__ __forceinline__ void store_row_fp8(unsigned char* p, int lane, const f32x4 (&v)[4], float s) {
#pragma unroll
    for (int j = 0; j < 4; ++j) *(unsigned*)(p + 256 * j + 4 * lane) = pk4_fp8(v[j][0] * s, v[j][1] * s, v[j][2] * s, v[j][3] * s);
}
template <bool X16, bool O8 = false>
__device__ __forceinline__ void phase_norm_rows(const Frame& F, const void* xl, const void* xc, const float* gain, const float* modsL, int sh, bf16* out, int nrows) {
    const int gw = F.bid * NWAVES + F.wave, NGW = F.G * NWAVES;
    for (int m = 2 * gw; m < nrows; m += 2 * NGW) {
        const bool lat = m < NL; const int s = lat ? m / T : NB; const size_t ro = lat ? (size_t)m * D : (size_t)(m - NL) * D;
        f32x4 v[4], w[4];
        if constexpr (X16) { const bf16* xr = (const bf16*)(lat ? xl : xc) + ro; load_row16(xr, F.lane, v); load_row16(xr + D, F.lane, w); }
        else { const float* xr = (const float*)(lat ? xl : xc) + ro; load_row(xr, F.lane, v); load_row(xr + D, F.lane, w); }
        const float* shp = modsL + (size_t)s * 6144 + sh * 1024;
        norm_mod(v, gain, shp, shp + 1024, F.lane); norm_mod(w, gain, shp, shp + 1024, F.lane);
        if constexpr (O8) { store_row_fp8((unsigned char*)out + (size_t)m * D, F.lane, v, FFN_SA); store_row_fp8((unsigned char*)out + (size_t)(m + 1) * D, F.lane, w, FFN_SA); }
        else { store_row_bf16(out + (size_t)m * D, F.lane, v); store_row_bf16(out + (size_t)(m + 1) * D, F.lane, w); }
    }
}

__device__ __forceinline__ void phase_rwkv_feat(const Frame& F, const Args& a) {
    const bf16* P = (const bf16*)((unsigned char*)F.out + DO_PRW);
    bf16* R = (bf16*)(F.ws + WS_R); bf16* KS = (bf16*)(F.ws + WS_KS); bf16* V = (bf16*)(F.ws + WS_V); bf16* KK = (bf16*)(F.ws + WS_KK); bf16* LB = (bf16*)(F.ws + WS_LB);
    const float* mu = a.in[I_MU]; const float* k_k = a.in[I_KK];
    const int gw = F.bid * NWAVES + F.wave, NGW = F.G * NWAVES, lane = F.lane;
    const int RPW = (NT + NGW - 1) / NGW, m0 = gw * RPW, m1 = m0 + RPW < NT ? m0 + RPW : NT;
    v2u rp[7], rc[7], rn[7];
#pragma unroll
    for (int j = 0; j < 7; ++j) { rp[j] = (v2u){0u, 0u}; rc[j] = (v2u){0u, 0u}; }
    if (m0 < m1) {
#pragma unroll
        for (int j = 0; j < 7; ++j) { rc[j] = *(const v2u*)(P + (size_t)m0 * RW + 4 * lane + 256 * j); if (m0 > 0) rp[j] = *(const v2u*)(P + (size_t)(m0 - 1) * RW + 4 * lane + 256 * j); } }
    for (int m = m0; m < m1; ++m) {
        const bool lat = m < NL; const int t = lat ? (m & (T - 1)) : ((m - NL) & (CT - 1)); const int tl = lat ? T : CT;
        const bool hp = t > 0, hn = t < tl - 1;
#pragma unroll
        for (int j = 0; j < 7; ++j) { rn[j] = (v2u){0u, 0u}; if (m + 1 < NT) rn[j] = *(const v2u*)(P + (size_t)(m + 1) * RW + 4 * lane + 256 * j); }
        f32x4 x[7];
#pragma unroll
        for (int j = 0; j < 7; ++j) { const v2u c = rc[j]; v2u p = rp[j], n = rn[j];
            if (!hp) p = (v2u){0u, 0u}; if (!hn) n = (v2u){0u, 0u};
            const f32x4 cv = {bflo(c.x), bfhi(c.x), bflo(c.y), bfhi(c.y)}, pv = {bflo(p.x), bfhi(p.x), bflo(p.y), bfhi(p.y)}, nv = {bflo(n.x), bfhi(n.x), bflo(n.y), bfhi(n.y)};
            const f32x4 mv = *(const f32x4*)(mu + 256 * j + 4 * lane);
            x[j] = cv + mv * ((pv + nv) * 0.5f - cv); rp[j] = rc[j]; rc[j] = rn[j]; }
#pragma unroll
        for (int jj = 0; jj < 2; ++jj) { const int c = 256 * jj + 4 * lane;
            v2u o; o.x = pk2(x[jj][0], x[jj][1]); o.y = pk2(x[jj][2], x[jj][3]); *(v2u*)(R + (size_t)m * AW + c) = o;
            o.x = pk2(x[2 + jj][0], x[2 + jj][1]); o.y = pk2(x[2 + jj][2], x[2 + jj][3]); *(v2u*)(KS + (size_t)m * AW + c) = o;
            o.x = pk2(x[4 + jj][0], x[4 + jj][1]); o.y = pk2(x[4 + jj][2], x[4 + jj][3]); *(v2u*)(V + (size_t)m * AW + c) = o;
            f32x4 kk = x[2 + jj] * *(const f32x4*)(k_k + c);
            const float ss = sum16((kk[0] * kk[0] + kk[1] * kk[1]) + (kk[2] * kk[2] + kk[3] * kk[3]));
            const float inv = 1.f / fmaxf(sqrtf(ss), 1e-12f);
            kk = kk * inv; o.x = pk2(kk[0], kk[1]); o.y = pk2(kk[2], kk[3]); *(v2u*)(KK + (size_t)m * AW + c) = o; }
        { f32x4 y = x[6];
#pragma unroll
          for (int i = 0; i < 4; ++i) { const float th = ftanh(y[i]), sg = fsigmoid(y[i]); y[i] = lane < 16 ? th : (lane < 32 ? y[i] : sg); }
          v2u o; o.x = pk2(y[0], y[1]); o.y = pk2(y[2], y[3]); *(v2u*)(LB + (size_t)m * 256 + 4 * lane) = o; }
    }
}

__device__ __forceinline__ void unpack8(const v4u& w, float (&f)[8]) { f[0] = bflo(w.x); f[1] = bfhi(w.x); f[2] = bflo(w.y); f[3] = bfhi(w.y); f[4] = bflo(w.z); f[5] = bfhi(w.z); f[6] = bflo(w.w); f[7] = bfhi(w.w); }
__device__ __forceinline__ v4u pack8f(const float (&f)[8]) { v4u w; w.x = pk2(f[0], f[1]); w.y = pk2(f[2], f[3]); w.z = pk2(f[4], f[5]); w.w = pk2(f[6], f[7]); return w; }
__device__ __forceinline__ void phase_rwkv_post(const Frame& F, const Args& a) {
    const bf16* OF = (const bf16*)(F.ws + WS_OF); const bf16* OB = (const bf16*)(F.ws + WS_OB); const bf16* R = (const bf16*)(F.ws + WS_R); const bf16* KS = (const bf16*)(F.ws + WS_KS);
    const bf16* V = (const bf16*)(F.ws + WS_V); const bf16* GG = (const bf16*)((unsigned char*)F.out + DO_GG); bf16* Y = (bf16*)(F.ws + WS_YMIX);
    const int gw = F.bid * NWAVES + F.wave, NGW = F.G * NWAVES, lane = F.lane, c = 8 * lane;
    float rk[8], lw[8], lb[8];
#pragma unroll
    for (int i = 0; i < 8; ++i) { rk[i] = a.in[I_RK][c + i]; lw[i] = a.in[I_LNW][c + i]; lb[i] = a.in[I_LNB][c + i]; }
    for (int m = gw; m < NT; m += NGW) { const size_t off = (size_t)m * AW + c;
        float of[8], ob[8], r[8], k[8], v[8], g[8];
        unpack8(*(const v4u*)(OF + off), of); unpack8(*(const v4u*)(OB + off), ob); unpack8(*(const v4u*)(R + off), r); unpack8(*(const v4u*)(KS + off), k);
        unpack8(*(const v4u*)(V + off), v); unpack8(*(const v4u*)(GG + off), g);
        float s = 0.f, bs = 0.f;
#pragma unroll
        for (int i = 0; i < 8; ++i) { of[i] += ob[i]; s += of[i]; bs += r[i] * k[i] * rk[i]; }
        const float mean = sum8(s) * (1.f / 64.f); bs = sum8(bs);
        float q = 0.f;
#pragma unroll
        for (int i = 0; i < 8; ++i) { of[i] -= mean; q += of[i] * of[i]; }
        const float rstd = __builtin_amdgcn_rsqf(sum8(q) * (1.f / 64.f) + GN_EPS);
        float y[8];
#pragma unroll
        for (int i = 0; i < 8; ++i) y[i] = (of[i] * rstd * lw[i] + lb[i] + bs * v[i]) * g[i];
        *(v4u*)(Y + (size_t)m * D + c) = pack8f(y);
    }
}
__device__ __forceinline__ void phase_hgrn_post(const Frame& F, const Args& a) {
    const bf16* OF = (const bf16*)((unsigned char*)F.out + DO_OHF); const bf16* OB = (const bf16*)((unsigned char*)F.out + DO_OHB); const bf16* PH = (const bf16*)(F.ws + WS_PHG); bf16* Y = (bf16*)(F.ws + WS_YMIX);
    const int gw = F.bid * NWAVES + F.wave, NGW = F.G * NWAVES, lane = F.lane, c = 8 * lane;
    float gn[8];
#pragma unroll
    for (int i = 0; i < 8; ++i) gn[i] = a.in[I_HNORM][(c & 127) + i];
    for (int m = gw; m < NT; m += NGW) { const size_t off = (size_t)m * AW + c;
        float of[8], ob[8], gt[8];
        unpack8(*(const v4u*)(OF + off), of); unpack8(*(const v4u*)(OB + off), ob); unpack8(*(const v4u*)(PH + (size_t)m * HG + 2048 + c), gt);
        float q = 0.f;
#pragma unroll
        for (int i = 0; i < 8; ++i) { of[i] += ob[i]; q += of[i] * of[i]; }
        const float rstd = __builtin_amdgcn_rsqf(sum16(q) * (1.f / 128.f) + NORM_EPS);
        float y[8];
#pragma unroll
        for (int i = 0; i < 8; ++i) y[i] = of[i] * rstd * gn[i] * fsilu(gt[i]);
        *(v4u*)(Y + (size_t)m * D + AW + c) = pack8f(y);
    }
}

constexpr int SC_CH = 32;
__device__ __forceinline__ int scan_row(int b, int dir, int c, int s) {
    if (c < CT / SC_CH) { const int tt = c * SC_CH + s; return NL + b * CT + (dir ? CT - 1 - tt : tt); }
    const int tt = (c - CT / SC_CH) * SC_CH + s; return b * T + (dir ? T - 1 - tt : tt);
}
__device__ __forceinline__ f32x4 bf4(const v2u& w) { return (f32x4){bflo(w.x), bfhi(w.x), bflo(w.y), bfhi(w.y)}; }
__device__ __forceinline__ void phase_rwkv_scan(const Frame& F) {
    const bf16* R = (const bf16*)(F.ws + WS_R); const bf16* KS = (const bf16*)(F.ws + WS_KS); const bf16* V = (const bf16*)(F.ws + WS_V); const bf16* KK = (const bf16*)(F.ws + WS_KK);
    const bf16* BB = (const bf16*)(F.ws + WS_BB);
    LAS float* inb = (LAS float*)F.lds;
    LAS float* outb = (LAS float*)(F.lds + 98304);
    constexpr int NCH = (CT + T) / SC_CH, ASZ = SC_CH * 64, BSZ = 6 * ASZ;
    const int tid = F.tid, rp = F.lane >> 4, kq = F.lane & 15, rowp = F.wave * 8 + 2 * rp, ls = tid >> 4, lc = (tid & 15) * 4;
    for (int task = F.bid; task < NB * 8 * 2; task += F.G) {
        const int b = task >> 4, h = (task >> 1) & 7, dir = task & 1;
        const bf16* LW = (const bf16*)((unsigned char*)F.out + (dir ? DO_LWB : DO_LWF)); bf16* O = (bf16*)(F.ws + (dir ? WS_OB : WS_OF));
        f32x4 Sa = {0.f, 0.f, 0.f, 0.f}, Sb = {0.f, 0.f, 0.f, 0.f};
        v2u g0, g1, g2, g3, g4, g5;
#define RW_LOAD(c) do { const size_t o_ = (size_t)scan_row(b, dir, (c), ls) * AW + h * 64 + lc; \
        g0 = *(const v2u*)(KK + o_); g1 = *(const v2u*)(LW + o_); g2 = *(const v2u*)(BB + o_); g3 = *(const v2u*)(KS + o_); g4 = *(const v2u*)(R + o_); g5 = *(const v2u*)(V + o_); } while (0)
#define RW_STORE(buf) do { LAS float* d_ = inb + (buf) * BSZ + ls * 64 + lc; f32x4 w_ = bf4(g1); w_[0] = __expf(w_[0]); w_[1] = __expf(w_[1]); w_[2] = __expf(w_[2]); w_[3] = __expf(w_[3]); \
        *(LAS f32x4*)(d_) = bf4(g0); *(LAS f32x4*)(d_ + ASZ) = w_; *(LAS f32x4*)(d_ + 2 * ASZ) = bf4(g2); *(LAS f32x4*)(d_ + 3 * ASZ) = bf4(g3); *(LAS f32x4*)(d_ + 4 * ASZ) = bf4(g4); *(LAS f32x4*)(d_ + 5 * ASZ) = bf4(g5); } while (0)
        RW_LOAD(0); RW_STORE(0);
        __syncthreads();
        for (int c = 0; c < NCH; ++c) {
            const int buf = c & 1;
            if (c + 1 < NCH) RW_LOAD(c + 1);
            const LAS float* ib = inb + buf * BSZ + 4 * kq; const LAS float* vb = inb + buf * BSZ + 5 * ASZ + rowp;
            for (int s16 = 0; s16 < SC_CH / 16; ++s16) {
                float oa = 0.f, ob2 = 0.f;
#pragma unroll
                for (int j = 0; j < 16; ++j) {
                    const LAS float* p = ib + (s16 * 16 + j) * 64;
                    const f32x4 kk = *(const LAS f32x4*)(p), w = *(const LAS f32x4*)(p + ASZ), bb = *(const LAS f32x4*)(p + 2 * ASZ), k = *(const LAS f32x4*)(p + 3 * ASZ), r = *(const LAS f32x4*)(p + 4 * ASZ);
                    const f32x2 vv = *(const LAS f32x2*)(vb + (s16 * 16 + j) * 64);
                    float sa = (Sa[0] * kk[0] + Sa[1] * kk[1]) + (Sa[2] * kk[2] + Sa[3] * kk[3]), sb = (Sb[0] * kk[0] + Sb[1] * kk[1]) + (Sb[2] * kk[2] + Sb[3] * kk[3]);
                    sa = sum16(sa); sb = sum16(sb);
                    Sa = Sa * w + (k * vv[0] - bb * sa); Sb = Sb * w + (k * vv[1] - bb * sb);
                    float o0 = (Sa[0] * r[0] + Sa[1] * r[1]) + (Sa[2] * r[2] + Sa[3] * r[3]), o1 = (Sb[0] * r[0] + Sb[1] * r[1]) + (Sb[2] * r[2] + Sb[3] * r[3]);
                    o0 = sum16(o0); o1 = sum16(o1);
                    oa = (kq == j) ? o0 : oa; ob2 = (kq == j) ? o1 : ob2;
                }
                *(LAS f32x2*)(outb + buf * ASZ + (s16 * 16 + kq) * 64 + rowp) = (f32x2){oa, ob2};
            }
            if (c + 1 < NCH) RW_STORE(buf ^ 1);
            __syncthreads();
            { const LAS float* q = outb + buf * ASZ + ls * 64 + lc; const f32x4 v = *(const LAS f32x4*)q; v2u w; w.x = pk2(v[0], v[1]); w.y = pk2(v[2], v[3]);
              *(v2u*)(O + (size_t)scan_row(b, dir, c, ls) * AW + h * 64 + lc) = w; }
        }
        __syncthreads();
#undef RW_LOAD
#undef RW_STORE
    }
}

__device__ __forceinline__ void phase_hgrn_scan(const Frame& F, const Args& a) {
    const bf16* PH = (const bf16*)(F.ws + WS_PHG);
    LAS float* inb = (LAS float*)F.lds;
    LAS float* outb = (LAS float*)(F.lds + 81920);
    constexpr int NCH = (CT + T) / SC_CH, FSZ = SC_CH * 128, BSZ = 2 * FSZ + SC_CH * 64, OSZ = SC_CH * 64;
    const int tid = F.tid, vc = tid >> 3, ks = tid & 7, ls = tid >> 4, l16 = tid & 15;
    for (int task = F.bid; task < NB * 4 * 2 * 2; task += F.G) {
        const int b = task >> 4, h = (task >> 2) & 3, dir = (task >> 1) & 1, half = task & 1;
        bf16* O = (bf16*)((unsigned char*)F.out + (dir ? DO_OHB : DO_OHF));
        float lbv[8];
#pragma unroll
        for (int i = 0; i < 8; ++i) { const int cidx = h * 128 + l16 * 8 + i; lbv[i] = fsigmoid(a.in[I_HLB][(dir * 2 + 0) * AW + cidx] - a.in[I_HLB][(dir * 2 + 1) * AW + cidx]); }
        float S[16];
#pragma unroll
        for (int i = 0; i < 16; ++i) S[i] = 0.f;
        v4u gq, gf; v2u gv;
#define HG_LOAD(c) do { const size_t o_ = (size_t)scan_row(b, dir, (c), ls) * HG + h * 128; \
        gq = *(const v4u*)(PH + o_ + l16 * 8); gf = *(const v4u*)(PH + o_ + 1024 + dir * AW + l16 * 8); gv = *(const v2u*)(PH + o_ + AW + half * 64 + l16 * 4); } while (0)
#define HG_STORE(buf) do { LAS float* d_ = inb + (buf) * BSZ + ls * 128 + l16 * 8; float q_[8], f_[8]; unpack8(gq, q_); unpack8(gf, f_); \
        _Pragma("unroll") for (int i = 0; i < 8; ++i) { q_[i] = fsilu(q_[i]); f_[i] = lbv[i] + (1.f - lbv[i]) * fsigmoid(f_[i]); } \
        *(LAS f32x4*)(d_) = (f32x4){f_[0], f_[1], f_[2], f_[3]}; *(LAS f32x4*)(d_ + 4) = (f32x4){f_[4], f_[5], f_[6], f_[7]}; \
        *(LAS f32x4*)(d_ + FSZ) = (f32x4){q_[0], q_[1], q_[2], q_[3]}; *(LAS f32x4*)(d_ + FSZ + 4) = (f32x4){q_[4], q_[5], q_[6], q_[7]}; \
        *(LAS f32x4*)(inb + (buf) * BSZ + 2 * FSZ + ls * 64 + l16 * 4) = bf4(gv); } while (0)
        HG_LOAD(0); HG_STORE(0);
        __syncthreads();
        for (int c = 0; c < NCH; ++c) {
            const int buf = c & 1;
            if (c + 1 < NCH) HG_LOAD(c + 1);
            const LAS float* ib = inb + buf * BSZ + 16 * ks; LAS float* ob = outb + buf * OSZ + vc;
#pragma unroll 2
            for (int s = 0; s < SC_CH; ++s) {
                const LAS float* p = ib + s * 128;
                const float vv = inb[buf * BSZ + 2 * FSZ + s * 64 + vc];
                float o0 = 0.f, o1 = 0.f;
#pragma unroll
                for (int j = 0; j < 4; ++j) { const f32x4 f = *(const LAS f32x4*)(p + 4 * j), q = *(const LAS f32x4*)(p + FSZ + 4 * j);
#pragma unroll
                    for (int i = 0; i < 4; ++i) { const float t = vv - f[i] * vv; S[4 * j + i] = S[4 * j + i] * f[i] + t; if (i & 1) o1 += q[i] * S[4 * j + i]; else o0 += q[i] * S[4 * j + i]; } }
                float o = sum8(o0 + o1);
                if (ks == 0) ob[s * 64] = o;
            }
            if (c + 1 < NCH) HG_STORE(buf ^ 1);
            __syncthreads();
            { const int fc = l16 * 4; const f32x4 v = *(const LAS f32x4*)(outb + buf * OSZ + ls * 64 + fc); v2u w; w.x = pk2(v[0], v[1]); w.y = pk2(v[2], v[3]);
              *(v2u*)(O + (size_t)scan_row(b, dir, c, ls) * AW + h * 128 + half * 64 + fc) = w; }
        }
        __syncthreads();
#undef HG_LOAD
#undef HG_STORE
    }
}

__device__ __forceinline__ int crow(int r, int hi) { return (r & 3) + 8 * (r >> 2) + 4 * hi; }
typedef short v4i16_t __attribute__((ext_vector_type(4)));
__device__ __forceinline__ s16x4 vtr(LAS const unsigned char* p) { return __builtin_bit_cast(s16x4, __builtin_amdgcn_ds_read_tr16_b64_v4i16((LAS v4i16_t*)p)); }
__device__ __forceinline__ void phase_attn(const Frame& F, const Args& a) {
    const bf16* QKV = (const bf16*)(F.ws + WS_QKV); bf16* OA = (bf16*)(F.ws + WS_OATT);
    constexpr int KPITCH = 144, KBYTES = 64 * KPITCH, VBYTES = 8192;
    constexpr int L_K = 0, L_V = 2 * KBYTES, L_WS = L_V + 2 * VBYTES, L_OST = L_WS + NWAVES * 256;
    const int tid = F.tid, lane = F.lane, wid = F.wave, r32 = lane & 31, hi = lane >> 5, g = wid >> 1, half = wid & 1;
    const int lkey = tid >> 3, lch = tid & 7;
    LAS float* wsf = (LAS float*)(F.lds + L_WS) + wid * 64;
    LAS bf16* stg = (LAS bf16*)(F.lds + L_OST + wid * 4096);
    const int kst = lkey * KPITCH + lch * 16, vst = ((lch >> 2) * 4 + (lkey >> 4)) * 1024 + (lkey & 15) * 64 + (lch & 3) * 16;
    const int vrd = ((lane >> 4) & 1) * 32 + (lane & 3) * 8 + (4 * hi + ((lane & 15) >> 2)) * 64;
    const int per = (NB * 4 * 32 + F.G - 1) / F.G;
    for (int ui = 0; ui < per; ++ui) {
        const int u = F.bid * per + ui; if (u >= NB * 4 * 32) break;
        const int b = u >> 7, kvh = (u >> 5) & 3, qb = u & 31, q0 = qb * 64, head = kvh * 4 + g;
        const int bt_lo = q0 >= 128 ? 0 : (128 - q0) / 64, bt_hi = (T + 64 - q0) / 64 > 4 ? 4 : (T + 64 - q0) / 64, nt = 4 + (bt_hi - bt_lo + 1);
        bf16x8 qr[4];
        { const bf16* qp = QKV + (size_t)(b * T + q0 + half * 32 + r32) * QKVW + head * 64 + hi * 8;
#pragma unroll
          for (int d0 = 0; d0 < 4; ++d0) qr[d0] = *(const bf16x8*)(qp + d0 * 16); }
        float m = a.in[I_SINK][head] * LOG2E, l = hi ? 0.f : 1.f;
        f32x16 o0, o1;
#pragma unroll
        for (int i = 0; i < 16; ++i) { o0[i] = 0.f; o1[i] = 0.f; }
        v4u kreg, vreg;
#define AT_ROWBASE(t) ((t) < 4 ? NL + b * CT + 64 * (t) : b * T + q0 - 128 + 64 * (bt_lo + (t) - 4))
#define AT_LOAD(t) do { const bf16* p_ = QKV + (size_t)(AT_ROWBASE(t) + lkey) * QKVW + 1024 + kvh * 64 + lch * 8; kreg = *(const v4u*)p_; vreg = *(const v4u*)(p_ + 256); } while (0)
        AT_LOAD(0);
        for (int t = 0; t < nt; ++t) {
            const int buf = t & 1;
            *(LAS v4u*)(F.lds + L_K + buf * KBYTES + kst) = kreg; *(LAS v4u*)(F.lds + L_V + buf * VBYTES + vst) = vreg;
            __syncthreads();
            if (t + 1 < nt) AT_LOAD(t + 1);
            const LAS unsigned char* Kb = F.lds + L_K + buf * KBYTES + r32 * KPITCH + hi * 16;
            f32x16 p0, p1;
            { const float nm = -m;
#pragma unroll
              for (int i = 0; i < 16; ++i) { p0[i] = nm; p1[i] = nm; } }
#pragma unroll
            for (int d0 = 0; d0 < 4; ++d0) {
                const bf16x8 ka = *(const LAS bf16x8*)(Kb + d0 * 32), kb2 = *(const LAS bf16x8*)(Kb + 32 * KPITCH + d0 * 32);
                p0 = __builtin_amdgcn_mfma_f32_32x32x16_bf16(ka, qr[d0], p0, 0, 0, 0);
                p1 = __builtin_amdgcn_mfma_f32_32x32x16_bf16(kb2, qr[d0], p1, 0, 0, 0);
            }
            const int bt = t < 4 ? -1 : bt_lo + t - 4; int qi = half * 32 + r32;
            asm volatile("" : "+v"(qi));
            if (bt == 0) {
#pragma unroll
                for (int r = 0; r < 16; ++r) { const int kj = crow(r, hi); if (kj < qi) p0[r] = -1e30f; if (kj + 32 < qi) p1[r] = -1e30f; }
            } else if (bt == 4) {
#pragma unroll
                for (int r = 0; r < 16; ++r) { const int kj = crow(r, hi); if (kj > qi) p0[r] = -1e30f; if (kj + 32 > qi) p1[r] = -1e30f; }
            }
            float tm = __builtin_fmaxf(__builtin_fmaxf(p0[0], p1[0]), p0[1]);
#pragma unroll
            for (int r = 1; r < 16; ++r) tm = __builtin_fmaxf(__builtin_fmaxf(tm, p1[r]), r + 1 < 16 ? p0[r + 1] : p1[r]);
            { auto rr = __builtin_amdgcn_permlane32_swap(__float_as_uint(tm), __float_as_uint(tm), false, false); tm = fmaxf(__uint_as_float(rr[0]), __uint_as_float(rr[1])); }
            if (__any(tm > 8.f)) {
                const float dl = tm > 8.f ? tm : 0.f, alpha = __builtin_amdgcn_exp2f(-dl);
                m += dl; l *= alpha;
#pragma unroll
                for (int r = 0; r < 16; ++r) { p0[r] -= dl; p1[r] -= dl; }
                if (hi == 0) wsf[r32] = alpha;
                LDS_WAIT();
#pragma unroll
                for (int r = 0; r < 16; ++r) { const float al = wsf[crow(r, hi)]; o0[r] *= al; o1[r] *= al; }
            }
            float ls = 0.f;
#pragma unroll
            for (int r = 0; r < 16; ++r) { p0[r] = __builtin_amdgcn_exp2f(p0[r]); p1[r] = __builtin_amdgcn_exp2f(p1[r]); ls += p0[r] + p1[r]; }
            l += ls;
            bf16x8 pk[4];
#pragma unroll
            for (int s = 0; s < 2; ++s) {
                v4u w0, w1;
                w0.x = pk2(p0[8 * s], p0[8 * s + 1]); w0.y = pk2(p0[8 * s + 2], p0[8 * s + 3]); w0.z = pk2(p0[8 * s + 4], p0[8 * s + 5]); w0.w = pk2(p0[8 * s + 6], p0[8 * s + 7]);
                w1.x = pk2(p1[8 * s], p1[8 * s + 1]); w1.y = pk2(p1[8 * s + 2], p1[8 * s + 3]); w1.z = pk2(p1[8 * s + 4], p1[8 * s + 5]); w1.w = pk2(p1[8 * s + 6], p1[8 * s + 7]);
                pk[s] = __builtin_bit_cast(bf16x8, w0); pk[2 + s] = __builtin_bit_cast(bf16x8, w1);
            }
            const LAS unsigned char* Vb = F.lds + L_V + buf * VBYTES + vrd;
#pragma unroll
            for (int k4 = 0; k4 < 4; ++k4) {
                const s16x4 lo0 = vtr(Vb + k4 * 1024), hi0 = vtr(Vb + k4 * 1024 + 512), lo1 = vtr(Vb + 4096 + k4 * 1024), hi1 = vtr(Vb + 4096 + k4 * 1024 + 512);
                const bf16x8 v0 = {lo0[0], lo0[1], lo0[2], lo0[3], hi0[0], hi0[1], hi0[2], hi0[3]}, v1 = {lo1[0], lo1[1], lo1[2], lo1[3], hi1[0], hi1[1], hi1[2], hi1[3]};
                o0 = __builtin_amdgcn_mfma_f32_32x32x16_bf16(pk[k4], v0, o0, 0, 0, 0);
                o1 = __builtin_amdgcn_mfma_f32_32x32x16_bf16(pk[k4], v1, o1, 0, 0, 0);
            }
        }
        l += __shfl_xor(l, 32);
        if (hi == 0) wsf[32 + r32] = 1.f / l;
        LDS_WAIT();
#pragma unroll
        for (int r = 0; r < 16; ++r) { const int orow = crow(r, hi); const float li = wsf[32 + orow];
            stg[orow * 64 + r32] = (bf16)(pk2(o0[r] * li, 0.f) & 0xffffu); stg[orow * 64 + 32 + r32] = (bf16)(pk2(o1[r] * li, 0.f) & 0xffffu); }
        LDS_WAIT();
        { bf16* op = OA + (size_t)(b * T + q0 + half * 32) * D + head * 64;
#pragma unroll
          for (int i = 0; i < 4; ++i) { const int rowi = i * 8 + (lane >> 3), ch = lane & 7; *(v4u*)(op + (size_t)rowi * D + ch * 8) = *(const LAS v4u*)(stg + rowi * 64 + ch * 8); } }
        __syncthreads();
#undef AT_ROWBASE
#undef AT_LOAD
    }
}


constexpr int HC_L = 64, HC_PQ = 272  , HC_PK = 144  ;
constexpr int HC_QT = 0, HC_KT = 17408, HC_QG = 34816, HC_KH = 52224, HC_VV = 70656, HC_SB = 78848, HC_SEG = 111616, HC_DEC = 113664, HC_OST = 114176, HC_END = 122368;
static_assert(HC_END <= RING_BYTES, "hgrn chunk LDS");
__device__ __forceinline__ int hc_row(int b, int dir, int c, int s) {
    if (c < CT / HC_L) { const int tt = c * HC_L + s; return NL + b * CT + (dir ? CT - 1 - tt : tt); }
    const int tt = (c - CT / HC_L) * HC_L + s; return b * T + (dir ? T - 1 - tt : tt);
}
__device__ __forceinline__ bf16x8 cat4(const s16x4 lo, const s16x4 hi) { return (bf16x8){lo[0], lo[1], lo[2], lo[3], hi[0], hi[1], hi[2], hi[3]}; }
__device__ __forceinline__ void phase_hgrn_chunk(const Frame& F, const Args& a) {
    const bf16* PH = (const bf16*)(F.ws + WS_PHG);
    constexpr int NCH = (CT + T) / HC_L;
    const int tid = F.tid, lane = F.lane, wid = F.wave, r32 = lane & 31, hi = lane >> 5;
    const int col = tid & 127, seg = tid >> 7;
    LAS unsigned char* L = F.lds;
    const int vrd = ((lane >> 4) & 1) * 32 + (lane & 3) * 8 + (4 * hi + ((lane & 15) >> 2)) * 64;
    for (int task = F.bid; task < NB * 4 * 2 * 2; task += F.G) {
        const int b = task >> 4, h = (task >> 2) & 3, dir = (task >> 1) & 1, half = task & 1;
        bf16* O = (bf16*)((unsigned char*)F.out + (dir ? DO_OHB : DO_OHF));
        const float lb = fsigmoid(a.in[I_HLB][(dir * 2 + 0) * AW + h * 128 + col] - a.in[I_HLB][(dir * 2 + 1) * AW + h * 128 + col]);
        f32x16 S0, S1;
#pragma unroll
        for (int i = 0; i < 16; ++i) { S0[i] = 0.f; S1[i] = 0.f; }
        for (int i = tid; i < 16384 / 16; i += NTHR) *(LAS v4u*)(L + HC_SB + i * 16) = (v4u){0u, 0u, 0u, 0u};
        v4u gq0, gq1, gf0, gf1, gv;
        const int qrow0 = tid >> 4, qc8 = tid & 15, vrow = tid >> 3, vc8 = tid & 7;
#define HC_LOAD(c) do { const size_t r0_ = (size_t)hc_row(b, dir, (c), qrow0) * HG + h * 128 + qc8 * 8, r1_ = (size_t)hc_row(b, dir, (c), qrow0 + 32) * HG + h * 128 + qc8 * 8; \
        gq0 = *(const v4u*)(PH + r0_); gq1 = *(const v4u*)(PH + r1_); gf0 = *(const v4u*)(PH + r0_ + 1024 + dir * AW); gf1 = *(const v4u*)(PH + r1_ + 1024 + dir * AW); \
        gv = *(const v4u*)(PH + (size_t)hc_row(b, dir, (c), vrow) * HG + AW + h * 128 + half * 64 + vc8 * 8); } while (0)
        HC_LOAD(0);
        __syncthreads();
        for (int c = 0; c < NCH; ++c) {
            const int sbuf = c & 1;
            *(LAS v4u*)(L + HC_QT + qrow0 * HC_PQ + qc8 * 16) = gq0; *(LAS v4u*)(L + HC_QT + (qrow0 + 32) * HC_PQ + qc8 * 16) = gq1;
            *(LAS v4u*)(L + HC_KT + qrow0 * HC_PQ + qc8 * 16) = gf0; *(LAS v4u*)(L + HC_KT + (qrow0 + 32) * HC_PQ + qc8 * 16) = gf1;
            *(LAS v4u*)(L + HC_VV + ((vc8 >> 2) * 4 + (vrow >> 4)) * 1024 + (vrow & 15) * 64 + (vc8 & 3) * 16) = gv;
            __syncthreads();
            if (c + 1 < NCH) HC_LOAD(c + 1);
            float Pl[16], kk[16], qv[16];
            { float run = 1.f;
#pragma unroll
              for (int i = 0; i < 16; ++i) { const int t = seg * 16 + i;
                  const float fr = __uint_as_float((unsigned)*(const LAS unsigned short*)(L + HC_KT + t * HC_PQ + col * 2) << 16), qr = __uint_as_float((unsigned)*(const LAS unsigned short*)(L + HC_QT + t * HC_PQ + col * 2) << 16);
                  const float f = lb + (1.f - lb) * fsigmoid(fr); run *= f; Pl[i] = run; kk[i] = 1.f - f; qv[i] = fsilu(qr); }
              *(LAS float*)(L + HC_SEG + (seg * 128 + col) * 4) = run; }
            __syncthreads();
            { const float s0 = *(const LAS float*)(L + HC_SEG + col * 4), s1 = *(const LAS float*)(L + HC_SEG + (128 + col) * 4), s2 = *(const LAS float*)(L + HC_SEG + (256 + col) * 4), s3 = *(const LAS float*)(L + HC_SEG + (384 + col) * 4);
              const float off = seg == 0 ? 1.f : (seg == 1 ? s0 : (seg == 2 ? s0 * s1 : s0 * s1 * s2)), pref = s0 * s1, pend = pref * s2 * s3;
              const float iref = __builtin_amdgcn_rcpf(pref), egref = pref, eend = s2 * s3, offr = off * iref;
              unsigned khw[8];
#pragma unroll
              for (int i = 0; i < 16; ++i) { const int t = seg * 16 + i; const float e = Pl[i] * offr, ri = __builtin_amdgcn_rcpf(e);
                  const float qt = qv[i] * e, kt = kk[i] * ri, qg = qt * egref, kh = kt * eend;
                  *(LAS unsigned short*)(L + HC_QT + t * HC_PQ + col * 2) = (unsigned short)(pk2(qt, 0.f) & 0xffffu);
                  *(LAS unsigned short*)(L + HC_KT + t * HC_PQ + col * 2) = (unsigned short)(pk2(kt, 0.f) & 0xffffu);
                  *(LAS unsigned short*)(L + HC_QG + t * HC_PQ + col * 2) = (unsigned short)(pk2(qg, 0.f) & 0xffffu);
                  if (i & 1) khw[i >> 1] = (khw[i >> 1] & 0xffffu) | (pk2(kh, 0.f) << 16); else khw[i >> 1] = pk2(kh, 0.f) & 0xffffu; }
              *(LAS v4u*)(L + HC_KH + col * HC_PK + seg * 32) = (v4u){khw[0], khw[1], khw[2], khw[3]}; *(LAS v4u*)(L + HC_KH + col * HC_PK + seg * 32 + 16) = (v4u){khw[4], khw[5], khw[6], khw[7]};
              if (seg == 0) *(LAS float*)(L + HC_DEC + col * 4) = pend; }
            __syncthreads();
            if (wid < 4) {
                const int tb = wid >> 1, vb = wid & 1;
                f32x16 o;
#pragma unroll
                for (int i = 0; i < 16; ++i) o[i] = 0.f;
                const LAS unsigned char* Vb = L + HC_VV + vb * 4096 + vrd;
                const LAS unsigned char* Qb = L + HC_QT + (32 * tb + r32) * HC_PQ + hi * 16;
#pragma unroll
                for (int sb = 0; sb < 2; ++sb) { if (sb <= tb) {
                    f32x16 p;
#pragma unroll
                    for (int i = 0; i < 16; ++i) p[i] = 0.f;
                    const LAS unsigned char* Kb = L + HC_KT + (32 * sb + r32) * HC_PQ + hi * 16;
#pragma unroll
                    for (int d0 = 0; d0 < 8; ++d0) p = __builtin_amdgcn_mfma_f32_32x32x16_bf16(*(const LAS bf16x8*)(Kb + d0 * 32), *(const LAS bf16x8*)(Qb + d0 * 32), p, 0, 0, 0);
                    if (sb == tb) {
#pragma unroll
                        for (int r = 0; r < 16; ++r) if (crow(r, hi) > r32) p[r] = 0.f;
                    }
#pragma unroll
                    for (int s2 = 0; s2 < 2; ++s2) { v4u w; w.x = pk2(p[8 * s2], p[8 * s2 + 1]); w.y = pk2(p[8 * s2 + 2], p[8 * s2 + 3]); w.z = pk2(p[8 * s2 + 4], p[8 * s2 + 5]); w.w = pk2(p[8 * s2 + 6], p[8 * s2 + 7]);
                        const int k4 = 2 * sb + s2;
                        o = __builtin_amdgcn_mfma_f32_32x32x16_bf16(__builtin_bit_cast(bf16x8, w), cat4(vtr(Vb + k4 * 1024), vtr(Vb + k4 * 1024 + 512)), o, 0, 0, 0); }
                } }
                const LAS unsigned char* Gb = L + HC_QG + (32 * tb + r32) * HC_PQ + hi * 8;
                const LAS unsigned char* Sb = L + HC_SB + sbuf * 16384 + vb * 4096 + vrd;
#pragma unroll
                for (int d0 = 0; d0 < 8; ++d0) { const s16x4 alo = *(const LAS s16x4*)(Gb + d0 * 32), ahi = *(const LAS s16x4*)(Gb + d0 * 32 + 16);
                    const LAS unsigned char* sp = Sb + (d0 >> 2) * 8192 + (d0 & 3) * 1024;
                    o = __builtin_amdgcn_mfma_f32_32x32x16_bf16(cat4(alo, ahi), cat4(vtr(sp), vtr(sp + 512)), o, 0, 0, 0); }
                LAS bf16* stg = (LAS bf16*)(L + HC_OST + wid * 2048);
#pragma unroll
                for (int r = 0; r < 16; ++r) stg[crow(r, hi) * 32 + r32] = (bf16)(pk2(o[r], 0.f) & 0xffffu);
                LDS_WAIT();
#pragma unroll
                for (int i = 0; i < 2; ++i) { const int rowi = i * 16 + (lane >> 2), ch = lane & 3;
                    *(v4u*)(O + (size_t)hc_row(b, dir, c, 32 * tb + rowi) * AW + h * 128 + half * 64 + 32 * vb + ch * 8) = *(const LAS v4u*)(stg + rowi * 32 + ch * 8); }
            } else {
                const int kb = wid - 4;
                const LAS unsigned char* Ab = L + HC_KH + (32 * kb + r32) * HC_PK + hi * 8;
                const LAS unsigned char* Vb = L + HC_VV + vrd;
#pragma unroll
                for (int r = 0; r < 16; ++r) { const float dc = *(const LAS float*)(L + HC_DEC + (32 * kb + crow(r, hi)) * 4); S0[r] *= dc; S1[r] *= dc; }
#pragma unroll
                for (int s4 = 0; s4 < 4; ++s4) { const bf16x8 af = cat4(*(const LAS s16x4*)(Ab + s4 * 32), *(const LAS s16x4*)(Ab + s4 * 32 + 16));
                    S0 = __builtin_amdgcn_mfma_f32_32x32x16_bf16(af, cat4(vtr(Vb + s4 * 1024), vtr(Vb + s4 * 1024 + 512)), S0, 0, 0, 0);
                    S1 = __builtin_amdgcn_mfma_f32_32x32x16_bf16(af, cat4(vtr(Vb + 4096 + s4 * 1024), vtr(Vb + 4096 + s4 * 1024 + 512)), S1, 0, 0, 0); }
                LAS unsigned char* Sn = L + HC_SB + (sbuf ^ 1) * 16384 + (kb >> 1) * 8192;
#pragma unroll
                for (int r = 0; r < 16; ++r) { const int rw = (kb & 1) * 32 + crow(r, hi); LAS unsigned char* p = Sn + (rw >> 4) * 1024 + (rw & 15) * 64 + r32 * 2;
                    *(LAS unsigned short*)(p) = (unsigned short)(pk2(S0[r], 0.f) & 0xffffu); *(LAS unsigned short*)(p + 4096) = (unsigned short)(pk2(S1[r], 0.f) & 0xffffu); }
            }
            __syncthreads();
        }
#undef HC_LOAD
    }
}


#ifndef RC_PROBE
#define RC_PROBE 1
#endif
constexpr int RC_L = 16, RC_NCH = (CT + T) / RC_L, RC_NSS = RC_NCH / 8;
constexpr int RS_A = 0, RS_RM = 2304, RS_KH = 4608, RS_BH = 6656, RS_VT = 8704, RS_A1 = 10752, RS_TT = 11264, RS_B1 = 11776, RS_B2 = 12288, RS_PL = 12800, RS_SLOT = 13056;
constexpr int RC_SCR = 8 * RS_SLOT, RC_SCRSZ = 4608, RC_END = RC_SCR + 8 * RC_SCRSZ;
static_assert(RC_END <= RING_BYTES, "rwkv chunk LDS");
__device__ __forceinline__ int rc_row(int b, int dir, int cc, int t) {
    if (cc < CT / RC_L) { const int tt = cc * RC_L + t; return NL + b * CT + (dir ? CT - 1 - tt : tt); }
    const int tt = (cc - CT / RC_L) * RC_L + t; return b * T + (dir ? T - 1 - tt : tt);
}
__device__ __forceinline__ s16x4 pack4(const f32x4& v) { v2u w; w.x = pk2(v[0], v[1]); w.y = pk2(v[2], v[3]); return __builtin_bit_cast(s16x4, w); }
__device__ __forceinline__ float bfu(unsigned short h) { return __uint_as_float((unsigned)h << 16); }
__device__ __forceinline__ unsigned short f2b(float f) { return (unsigned short)(pk2(f, 0.f) & 0xffffu); }
#define MF16(a, b, c) __builtin_amdgcn_mfma_f32_16x16x32_bf16((a), (b), (c), 0, 0, 0)
__device__ __forceinline__ void phase_rwkv_chunk(const Frame& F) {
    const bf16* R = (const bf16*)(F.ws + WS_R); const bf16* KS = (const bf16*)(F.ws + WS_KS); const bf16* V = (const bf16*)(F.ws + WS_V); const bf16* KK = (const bf16*)(F.ws + WS_KK);
    const bf16* BB = (const bf16*)(F.ws + WS_BB);
    LAS unsigned char* L = F.lds;
    const int lane = F.lane, wid = F.wave, c = lane & 15, g = lane >> 4;
    const s16x4 z4 = {0, 0, 0, 0};
    for (int task = F.bid; task < NB * 8 * 2; task += F.G) {
        const int b = task >> 4, h = (task >> 1) & 7, dir = task & 1;
        const bf16* LW = (const bf16*)((unsigned char*)F.out + (dir ? DO_LWB : DO_LWF)); bf16* O = (bf16*)(F.ws + (dir ? WS_OB : WS_OF));
        f32x4 Xt[4];
#pragma unroll
        for (int i = 0; i < 4; ++i) Xt[i] = (f32x4){0.f, 0.f, 0.f, 0.f};
        v4u pg[12];
        const int prow = lane >> 2, pcol = (lane & 3) * 16;
#define RC_LOAD(cc) do { const size_t o_ = (size_t)rc_row(b, dir, (cc), prow) * AW + h * 64 + pcol; \
        pg[0] = *(const v4u*)(KK + o_); pg[1] = *(const v4u*)(KK + o_ + 8); pg[2] = *(const v4u*)(LW + o_); pg[3] = *(const v4u*)(LW + o_ + 8); pg[4] = *(const v4u*)(BB + o_); pg[5] = *(const v4u*)(BB + o_ + 8); \
        pg[6] = *(const v4u*)(KS + o_); pg[7] = *(const v4u*)(KS + o_ + 8); pg[8] = *(const v4u*)(R + o_); pg[9] = *(const v4u*)(R + o_ + 8); pg[10] = *(const v4u*)(V + o_); pg[11] = *(const v4u*)(V + o_ + 8); } while (0)
        RC_LOAD(wid);
        for (int n = 0; n < RC_NSS; ++n) {
            {
                {
                    const int p = wid;
                    for (int rep_ = 0; rep_ < RC_PROBE; ++rep_) {
                    LAS unsigned char* S = L + p * RS_SLOT; LAS unsigned char* Q = L + RC_SCR + p * RC_SCRSZ;
                    *(LAS v4u*)(S + RS_A + prow * 144 + pcol * 2) = pg[0]; *(LAS v4u*)(S + RS_A + prow * 144 + pcol * 2 + 16) = pg[1];
                    *(LAS v4u*)(S + RS_KH + prow * 128 + pcol * 2) = pg[2]; *(LAS v4u*)(S + RS_KH + prow * 128 + pcol * 2 + 16) = pg[3];
                    *(LAS v4u*)(Q + prow * 144 + pcol * 2) = pg[4]; *(LAS v4u*)(Q + prow * 144 + pcol * 2 + 16) = pg[5];
                    *(LAS v4u*)(Q + 2304 + prow * 144 + pcol * 2) = pg[6]; *(LAS v4u*)(Q + 2304 + prow * 144 + pcol * 2 + 16) = pg[7];
                    *(LAS v4u*)(S + RS_RM + prow * 144 + pcol * 2) = pg[8]; *(LAS v4u*)(S + RS_RM + prow * 144 + pcol * 2 + 16) = pg[9];
                    *(LAS v4u*)(S + RS_VT + prow * 128 + pcol * 2) = pg[10]; *(LAS v4u*)(S + RS_VT + prow * 128 + pcol * 2 + 16) = pg[11];
                    if (n + 1 < RC_NSS && rep_ == RC_PROBE - 1) RC_LOAD(8 * (n + 1) + p);
                    LDS_WAIT();
                    { float cum[16], vk[16], vb[16], vkk[16], vr[16]; unsigned short vv[16];
                      float run = 0.f;
#pragma unroll
                      for (int t = 0; t < 16; ++t) { run += bfu(*(const LAS unsigned short*)(S + RS_KH + t * 128 + lane * 2)); cum[t] = run;
                          vkk[t] = bfu(*(const LAS unsigned short*)(S + RS_A + t * 144 + lane * 2)); vr[t] = bfu(*(const LAS unsigned short*)(S + RS_RM + t * 144 + lane * 2));
                          vb[t] = bfu(*(const LAS unsigned short*)(Q + t * 144 + lane * 2)); vk[t] = bfu(*(const LAS unsigned short*)(Q + 2304 + t * 144 + lane * 2));
                          vv[t] = *(const LAS unsigned short*)(S + RS_VT + t * 128 + lane * 2); }
                      LDS_WAIT();
                      const float eL = __expf(run);
                      unsigned kh[8], bh[8], vt[8];
                      float eprev = 1.f;
#pragma unroll
                      for (int t = 0; t < 16; ++t) { const float e = __expf(cum[t]), ei = __expf(-cum[t]), el = eL * ei;
                          *(LAS unsigned short*)(S + RS_A + t * 144 + lane * 2) = f2b(vkk[t] * eprev); *(LAS unsigned short*)(S + RS_RM + t * 144 + lane * 2) = f2b(vr[t] * e);
                          *(LAS unsigned short*)(Q + t * 144 + lane * 2) = f2b(vb[t] * ei); *(LAS unsigned short*)(Q + 2304 + t * 144 + lane * 2) = f2b(vk[t] * ei);
                          const unsigned khv = f2b(vk[t] * el), bhv = f2b(-vb[t] * el);
                          if (t & 1) { kh[t >> 1] |= khv << 16; bh[t >> 1] |= bhv << 16; vt[t >> 1] |= (unsigned)vv[t] << 16; } else { kh[t >> 1] = khv; bh[t >> 1] = bhv; vt[t >> 1] = vv[t]; }
                          eprev = e; }
                      *(LAS v4u*)(S + RS_KH + lane * 32) = (v4u){kh[0], kh[1], kh[2], kh[3]}; *(LAS v4u*)(S + RS_KH + lane * 32 + 16) = (v4u){kh[4], kh[5], kh[6], kh[7]};
                      *(LAS v4u*)(S + RS_BH + lane * 32) = (v4u){bh[0], bh[1], bh[2], bh[3]}; *(LAS v4u*)(S + RS_BH + lane * 32 + 16) = (v4u){bh[4], bh[5], bh[6], bh[7]};
                      *(LAS v4u*)(S + RS_VT + lane * 32) = (v4u){vt[0], vt[1], vt[2], vt[3]}; *(LAS v4u*)(S + RS_VT + lane * 32 + 16) = (v4u){vt[4], vt[5], vt[6], vt[7]};
                      *(LAS float*)(S + RS_PL + lane * 4) = eL; }
                    LDS_WAIT();
                    { f32x4 a2 = {0.f, 0.f, 0.f, 0.f}, a1 = a2, b2 = a2, b1 = a2; int a2i[4];
#pragma unroll
                      for (int s = 0; s < 2; ++s) { const int ko = (32 * s + 8 * g) * 2;
                          const bf16x8 fa = *(const LAS bf16x8*)(S + RS_A + c * 144 + ko), fr = *(const LAS bf16x8*)(S + RS_RM + c * 144 + ko), fb = *(const LAS bf16x8*)(Q + c * 144 + ko), fk = *(const LAS bf16x8*)(Q + 2304 + c * 144 + ko);
                          a2 = MF16(fa, fb, a2); a1 = MF16(fa, fk, a1); b2 = MF16(fr, fb, b2); b1 = MF16(fr, fk, b1); }
#pragma unroll
                      for (int r = 0; r < 4; ++r) { const int t = 4 * g + r;
                          const bool lo = c < t, le = c <= t;
                          a2i[r] = __builtin_bit_cast(int, lo ? a2[r] : 0.f);
                          *(LAS unsigned short*)(S + RS_A1 + t * 32 + c * 2) = f2b(lo ? a1[r] : 0.f);
                          *(LAS unsigned short*)(S + RS_B1 + t * 32 + c * 2) = f2b(le ? b1[r] : 0.f);
                          *(LAS unsigned short*)(S + RS_B2 + t * 32 + c * 2) = f2b(le ? -b2[r] : 0.f); }
                      float Tc[16];
#pragma unroll
                      for (int t = 0; t < 16; ++t) { float acc = (c == t) ? 1.f : 0.f;
#pragma unroll
                          for (int i = 0; i < 16; ++i) if (i < t) acc -= __builtin_bit_cast(float, __builtin_amdgcn_readlane(a2i[t & 3], (t >> 2) * 16 + i)) * Tc[i];
                          Tc[t] = acc; }
                      if (g == 0) {
#pragma unroll
                          for (int t = 0; t < 16; ++t) *(LAS unsigned short*)(S + RS_TT + t * 32 + c * 2) = f2b(Tc[t]); } }
                    LDS_WAIT();
                    }
                }
            }
            __syncthreads();
            if (wid < 4) {
                LAS bf16* stg = (LAS bf16*)(L + RC_SCR + wid * RC_SCRSZ);
#pragma unroll 1
                for (int q = 0; q < 8; ++q) {
                    const LAS unsigned char* S = L + q * RS_SLOT;
                    const bf16x8 bx0 = cat4(pack4(Xt[0]), pack4(Xt[1])), bx1 = cat4(pack4(Xt[2]), pack4(Xt[3]));
                    const LAS unsigned char* pa = S + RS_A + c * 144 + g * 8; const LAS unsigned char* pr = S + RS_RM + c * 144 + g * 8;
                    const s16x4 vtl = *(const LAS s16x4*)(S + RS_VT + (16 * wid + c) * 32 + g * 8);
                    f32x4 W = {0.f, 0.f, 0.f, 0.f};
                    W = MF16(cat4(*(const LAS s16x4*)(pa), *(const LAS s16x4*)(pa + 32)), bx0, W);
                    W = MF16(cat4(*(const LAS s16x4*)(pa + 64), *(const LAS s16x4*)(pa + 96)), bx1, W);
                    W = MF16(cat4(*(const LAS s16x4*)(S + RS_A1 + c * 32 + g * 8), z4), cat4(vtl, z4), W);
                    f32x4 U = {0.f, 0.f, 0.f, 0.f};
                    U = MF16(cat4(*(const LAS s16x4*)(S + RS_TT + c * 32 + g * 8), z4), cat4(pack4(W), z4), U);
                    const bf16x8 bvu = cat4(vtl, pack4(U));
                    f32x4 Ov = {0.f, 0.f, 0.f, 0.f};
                    Ov = MF16(cat4(*(const LAS s16x4*)(pr), *(const LAS s16x4*)(pr + 32)), bx0, Ov);
                    Ov = MF16(cat4(*(const LAS s16x4*)(pr + 64), *(const LAS s16x4*)(pr + 96)), bx1, Ov);
                    Ov = MF16(cat4(*(const LAS s16x4*)(S + RS_B1 + c * 32 + g * 8), *(const LAS s16x4*)(S + RS_B2 + c * 32 + g * 8)), bvu, Ov);
#pragma unroll
                    for (int kt = 0; kt < 4; ++kt) { const f32x4 pl = *(const LAS f32x4*)(S + RS_PL + (16 * kt + 4 * g) * 4);
                        Xt[kt] = MF16(cat4(*(const LAS s16x4*)(S + RS_KH + (16 * kt + c) * 32 + g * 8), *(const LAS s16x4*)(S + RS_BH + (16 * kt + c) * 32 + g * 8)), bvu, Xt[kt] * pl); }
#pragma unroll
                    for (int r = 0; r < 4; ++r) stg[(q * 16 + 4 * g + r) * 16 + c] = f2b(Ov[r]);
                }
                LDS_WAIT();
#pragma unroll
                for (int hf = 0; hf < 2; ++hf) { const int rw = hf * 64 + lane, q = rw >> 4, t = rw & 15; const v4u x0 = *(const LAS v4u*)(stg + rw * 16), x1 = *(const LAS v4u*)(stg + rw * 16 + 8);
                  bf16* op = O + (size_t)rc_row(b, dir, 8 * n + q, t) * AW + h * 64 + 16 * wid; *(v4u*)op = x0; *(v4u*)(op + 8) = x1; }
            }
            __syncthreads();
        }
#undef RC_LOAD
    }
}

__device__ __forceinline__ void phase_route1(const Frame& F, const Args& a) {
    LAS float* rw = (LAS float*)F.lds;
    LAS int* cnt = (LAS int*)(F.lds + 32768);
    const float* modsL = (const float*)(F.ws + WS_MODS) + (size_t)17 * 6144;
    unsigned char* FL = F.ws + WS_FLAT; int* tope = (int*)(F.ws + WS_TOPE); float* topw = (float*)(F.ws + WS_TOPW); int* rcnt = (int*)(F.ws + WS_RCNT);
    for (int i = F.tid; i < D * NEXP; i += NTHR) rw[(i & 7) * D + (i >> 3)] = a.in[I_ROUTER][i];
    const int nblk = NL / 128;
    for (int blk = F.bid; blk < nblk; blk += F.G) {
        if (F.tid < NEXP) cnt[F.tid] = 0;
        __syncthreads();
        for (int i = 0; i < 16; ++i) { const int m = blk * 128 + F.wave * 16 + i, s = m / T;
            f32x4 v[4]; load_row16((const bf16*)F.out + (size_t)m * (2 * D) + D, F.lane, v);
            norm_mod(v, a.in[I_NFFN] + D, modsL + (size_t)s * 6144 + 3 * 1024, modsL + (size_t)s * 6144 + 4 * 1024, F.lane);
#pragma unroll
            for (int j = 0; j < 4; ++j) *(unsigned*)(FL + (size_t)m * D + 256 * j + 4 * F.lane) = pk4_fp8(v[j][0] * MOE_SA, v[j][1] * MOE_SA, v[j][2] * MOE_SA, v[j][3] * MOE_SA);
            float lg[NEXP];
#pragma unroll
            for (int e = 0; e < NEXP; ++e) lg[e] = 0.f;
#pragma unroll
            for (int e = 0; e < NEXP; ++e)
#pragma unroll
                for (int j = 0; j < 4; ++j) { const f32x4 w = *(const LAS f32x4*)(rw + e * D + 256 * j + 4 * F.lane); lg[e] += (v[j][0] * w[0] + v[j][1] * w[1]) + (v[j][2] * w[2] + v[j][3] * w[3]); }
#pragma unroll
            for (int e = 0; e < NEXP; ++e) lg[e] = wave_sum(lg[e]) + a.in[I_ROUTERB][e];
            int e1 = 0; float l1 = lg[0];
#pragma unroll
            for (int e = 1; e < NEXP; ++e) if (lg[e] > l1) { l1 = lg[e]; e1 = e; }
            int e2 = -1; float l2 = -3.0e38f;
#pragma unroll
            for (int e = 0; e < NEXP; ++e) if (e != e1 && lg[e] > l2) { l2 = lg[e]; e2 = e; }
            const float r = __expf(l2 - l1), w1 = 1.f / (1.f + r), w2 = r * w1;
            if (F.lane == 0) { tope[2 * m] = e1; tope[2 * m + 1] = e2; topw[2 * m] = w1; topw[2 * m + 1] = w2; __hip_atomic_fetch_add(&cnt[e1], 1, __ATOMIC_RELAXED, __HIP_MEMORY_SCOPE_WORKGROUP); __hip_atomic_fetch_add(&cnt[e2], 1, __ATOMIC_RELAXED, __HIP_MEMORY_SCOPE_WORKGROUP); }
        }
        __syncthreads();
        if (F.tid < NEXP) rcnt[blk * NEXP + F.tid] = cnt[F.tid];
        __syncthreads();
    }
}
__device__ __forceinline__ void phase_route2(const Frame& F) {
    LAS int* tot = (LAS int*)F.lds;
    LAS int* base = tot + 8;
    LAS int* mine = tot + 24;
    LAS int* wcnt = tot + 32;
    LAS int* slots = tot + 64;
    const int* rcnt = (const int*)(F.ws + WS_RCNT); const int* tope = (const int*)(F.ws + WS_TOPE); int* slot_g = (int*)(F.ws + WS_SLOT); int* pexp = (int*)(F.ws + WS_PEXP); int* npan = (int*)(F.ws + WS_NPAN);
    const unsigned char* FL = F.ws + WS_FLAT; unsigned char* AS = F.ws + WS_A8;
    const int nblk = NL / 128;
    for (int blk = F.bid; blk < nblk; blk += F.G) {
        { const int e = F.wave; int t = 0, before = 0;
          for (int k = F.lane; k < nblk; k += 64) { const int c = rcnt[k * NEXP + e]; t += c; if (k < blk) before += c; }
#pragma unroll
          for (int o = 1; o < 64; o <<= 1) { t += __shfl_xor(t, o); before += __shfl_xor(before, o); }
          if (F.lane == 0) { tot[e] = t; mine[e] = before; } }
        __syncthreads();
        if (F.tid == 0) { int s = 0; for (int e = 0; e < NEXP; ++e) { base[e] = s; s += (tot[e] + 255) & ~255; } base[8] = s; }
        __syncthreads();
        int ej = 0;
        if (F.tid < 256) { ej = tope[(blk * 128) * 2 + F.tid];
#pragma unroll
            for (int e = 0; e < NEXP; ++e) { const unsigned long long mk = __ballot(ej == e); if (F.lane == 0) wcnt[F.wave * 8 + e] = __popcll(mk); } }
        __syncthreads();
        if (F.tid < 256) {
            unsigned long long same = 0ull;
#pragma unroll
            for (int e = 0; e < NEXP; ++e) { const unsigned long long bm = __ballot(ej == e); if (ej == e) same = bm; }
            int rank = __popcll(same & ((1ull << F.lane) - 1ull));
            for (int w = 0; w < F.wave; ++w) rank += wcnt[w * 8 + ej];
            const int sl = base[ej] + mine[ej] + rank;
            slots[F.tid] = sl; slot_g[(blk * 128) * 2 + F.tid] = sl; }
        __syncthreads();
        for (int j = F.wave; j < 256; j += NWAVES) { const int tok = blk * 128 + (j >> 1); *((v4u*)(AS + (size_t)slots[j] * D) + F.lane) = *((const v4u*)(FL + (size_t)tok * D) + F.lane); }
        if (blk < NEXP) { const int r0 = base[blk] + tot[blk], r1 = base[blk] + ((tot[blk] + 255) & ~255);
            for (int r = r0 + F.wave; r < r1; r += NWAVES) *((v4u*)(AS + (size_t)r * D) + F.lane) = (v4u){0u, 0u, 0u, 0u}; }
        if (blk == NEXP) { const int np = base[8] >> 8;
            for (int p = F.tid; p < MAXPAN; p += NTHR) { int e = 0;
#pragma unroll
                for (int q = 1; q < NEXP; ++q) if (p * 256 >= base[q]) e = q;
                pexp[p] = p < np ? e : 0; }
            if (F.tid == 0) npan[0] = np; }
        __syncthreads();
    }
}
__device__ __forceinline__ void phase_final(const Frame& F, const Args& a) {
    const float* modsL = (const float*)(F.ws + WS_MODS) + (size_t)17 * 6144;
    const bf16* Y = (const bf16*)(F.ws + WS_ASORT); const int* slot_g = (const int*)(F.ws + WS_SLOT); const float* topw = (const float*)(F.ws + WS_TOPW);
    const int gw = F.bid * NWAVES + F.wave, NGW = F.G * NWAVES, lane = F.lane;
    for (int m = gw; m < NL; m += NGW) { const int s = m / T;
        f32x4 v[4]; load_row16((const bf16*)F.out + (size_t)m * (2 * D) + D, lane, v);
        const int s1 = slot_g[2 * m], s2 = slot_g[2 * m + 1]; const float w1 = topw[2 * m], w2 = topw[2 * m + 1];
        const float* gate = modsL + (size_t)s * 6144 + 5 * 1024;
        float ss = 0.f;
#pragma unroll
        for (int j = 0; j < 4; ++j) { const int c = 256 * j + 4 * lane; const f32x4 g = *(const f32x4*)(gate + c);
            const f32x4 y1 = bf4(*(const v2u*)(Y + (size_t)s1 * D + c)), y2 = bf4(*(const v2u*)(Y + (size_t)s2 * D + c));
            v[j] = v[j] + g * (y1 * w1 + y2 * w2); ss += (v[j][0] * v[j][0] + v[j][1] * v[j][1]) + (v[j][2] * v[j][2] + v[j][3] * v[j][3]); }
        const float r = __builtin_amdgcn_rsqf(wave_sum(ss) * (1.f / D) + NORM_EPS);
#pragma unroll
        for (int j = 0; j < 4; ++j) { const int c = 256 * j + 4 * lane; *(f32x4*)(F.out + (size_t)m * D + c) = v[j] * r * *(const f32x4*)(a.in[I_NFIN] + c); }
    }
}

constexpr int NPHASE = 23;
constexpr int MW_P8 = 6500, MW_P10 = 11264, MW_P11 = 28160;
static_assert(MW_P10 <= MW_DOWN && MW_P11 <= MW_DOWN + 6 * 2816, "items converted before phase 10 / during phase 11 must not touch the YMIX overlay (gate|up of experts 0, 1)");
#define GEMM_CALL(EPI, SCHED, g, S, E) pg8::gemm_phase<EPI, SCHED, true, true>(F.lds, g, S, E)
#define GEMM_CALL8(EPI, SCHED, g, S, E) pg8::gemm_phase<EPI, SCHED, true, true, true>(F.lds, g, S, E)
__global__ void __launch_bounds__(NTHR, 2) mk_fwd(Args args) {
    extern __shared__ __attribute__((aligned(16))) unsigned char lds_raw[];
    Frame F;
    F.lds = (LAS unsigned char*)lds_raw;
    F.tid = threadIdx.x; F.lane = F.tid & 63; F.wave = __builtin_amdgcn_readfirstlane(F.tid >> 6);
    F.G = gridDim.x; F.bid = blockIdx.x; F.out = args.out; F.ws = args.ws;
    volatile LAS unsigned* MISC = (volatile LAS unsigned*)(F.lds + MISC_OFF);
    for (int u = F.tid; u < (LDS_BYTES - LDSCTL_OFF) / 4; u += NTHR) ((LAS unsigned*)(F.lds + LDSCTL_OFF))[u] = 0u;
    __syncthreads();
    XcdBarrier bar; bar.bar = (unsigned*)(F.ws + WS_CTL) + CW_BAR; bar.x = 0; bar.st = nullptr;
#if !MK_PER_PHASE
    bar = xcd_barrier_post((unsigned*)(F.ws + WS_CTL) + CW_BAR, MISC + 8);
#endif
    const int lo = args.ph_lo, hi = args.ph_hi;
#ifndef MK_MASK
#define MK_MASK 0x7fffff
#endif
#define IN(k) (((MK_MASK >> (k)) & 1) && lo <= (k) && (k) < hi)
#define SEAM(k) do { if (IN((k) + 1)) xcd_barrier(bar); } while (0)
#ifndef MK_DUP
#define MK_DUP 0
#endif
#define REP(k) for (int rep_ = 0; rep_ < (((MK_DUP >> (k)) & 1) ? 2 : 1); ++rep_)
#define RSYNC(k) do { if ((MK_DUP >> (k)) & 1) { if (MK_PER_PHASE) __syncthreads(); else xcd_barrier(bar); } } while (0)
    const float* mods0 = (const float*)(F.ws + WS_MODS); const float* mods1 = mods0 + (size_t)17 * 6144;
    unsigned char* dout = (unsigned char*)F.out;

    if (IN(0)) { REP(0) { phase_prologue(F, args); RSYNC(0); } SEAM(0); }
    if (IN(1)) { REP(1) { phase_norm_rows<false>(F, args.in[I_X], args.in[I_CTX], args.in[I_NMIX], mods0, 0, (bf16*)(F.ws + WS_H0), NT); RSYNC(1); } SEAM(1); }
    if (IN(2)) {
        pg8::Gemm g{(const bf16*)(F.ws + WS_H0), (const bf16*)(F.ws + WS_WIN), D, D}; pg8::StaticOrder S; S.init(NT / 256, RIN / 256, F.G, F.bid);
        epi::EpiP E{(bf16*)(dout + DO_PRW), (bf16*)(F.ws + WS_PHG)};
        REP(2) { GEMM_CALL(epi::EpiP, pg8::StaticOrder, g, S, E); RSYNC(2); }
        phase_layer_weights(F, args, PW_IN, PW_ITEMS, (NT / 256 * (RIN / 256)) % F.G);
        SEAM(2); }
    if (IN(3)) { REP(3) { phase_rwkv_feat(F, args); RSYNC(3); } SEAM(3); }
    if (IN(4)) {
        int klora = 256; asm volatile("" : "+s"(klora));
        pg8::Gemm g{(const bf16*)(F.ws + WS_LB), (const bf16*)(F.ws + WS_WLORA), klora, klora}; pg8::StaticOrder S; S.init(NT / 256, 2048 / 256, F.G, F.bid);
        epi::EpiLora E{args.in[I_W0], args.in[I_A0], args.in[I_KA], (bf16*)(dout + DO_LWF), (bf16*)(dout + DO_LWB), (bf16*)(F.ws + WS_KS), (const bf16*)(F.ws + WS_KK), (bf16*)(F.ws + WS_BB), (bf16*)(dout + DO_GG)};
        GEMM_CALL(epi::EpiLora, pg8::StaticOrder, g, S, E); SEAM(4); }
    if (IN(5)) { REP(5) { phase_rwkv_chunk(F); RSYNC(5); } SEAM(5); }
    if (IN(6)) { REP(6) { phase_rwkv_post(F, args); RSYNC(6); } REP(23) { phase_hgrn_chunk(F, args); RSYNC(23); } SEAM(6); }
    if (IN(7)) { REP(7) { phase_hgrn_post(F, args); RSYNC(7); }
        SEAM(7); }
    if (IN(8)) {
        pg8::Gemm g{(const bf16*)(F.ws + WS_YMIX), (const bf16*)(F.ws + WS_WOUT0), D, D}; pg8::StaticOrder S; S.init(NT / 256, D / 256, F.G, F.bid);
        using ER8 = epi::EpiResT<false, true>; ER8 E{args.in[I_X], F.out, args.in[I_CTX], F.ws + WS_X1C, mods0 + 2 * 1024, D};
        GEMM_CALL(ER8, pg8::StaticOrder, g, S, E);
        phase_moe_weights(F, args, 0, MW_P8, (NT / 256 * (D / 256)) % F.G);
        SEAM(8); }
    if (IN(9)) { REP(9) { phase_norm_rows<true>(F, F.out, F.ws + WS_X1C, args.in[I_NFFN], mods0, 3, (bf16*)(F.ws + WS_F), NT); RSYNC(9); } SEAM(9); }
    if (IN(10)) {
        pg8::Gemm g{(const bf16*)(F.ws + WS_F), (const bf16*)(F.ws + WS_WGU0), D, D}; pg8::StaticOrder S; S.init(NT / 256, FF2 / 256, F.G, F.bid);
        epi::EpiSwiGLU8 E{F.ws + WS_HFF, 1.f, FFN_SH};
        REP(10) { GEMM_CALL(epi::EpiSwiGLU8, pg8::StaticOrder, g, S, E); RSYNC(10); }
        phase_moe_weights(F, args, MW_P8, MW_P10, (NT / 256 * (FF2 / 256)) % F.G);
        SEAM(10); }
    if (IN(11)) {
        pg8::Gemm g{(const bf16*)(F.ws + WS_HFF), (const bf16*)(F.ws + WS_WD0), FF / 2, FF / 2}; pg8::StaticOrder S; S.init(NT / 256, D / 256, F.G, F.bid);
        using ER11 = epi::EpiResT<true, true>; ER11 E{F.out, F.ws + WS_X2, F.ws + WS_X1C, F.ws + WS_X2C, mods0 + 5 * 1024, D, 1.f / (FFN_SH * FFN_SW)};
        GEMM_CALL8(ER11, pg8::StaticOrder, g, S, E);
        phase_moe_weights(F, args, MW_P10, MW_P11, (NT / 256 * (D / 256)) % F.G);
        SEAM(11); }
    if (IN(12)) { REP(12) { phase_norm_rows<true>(F, F.ws + WS_X2, F.ws + WS_X2C, args.in[I_NMIX] + D, mods1, 0, (bf16*)(F.ws + WS_H1), NT); RSYNC(12); }  SEAM(12); }
    if (IN(13)) {
        pg8::Gemm g{(const bf16*)(F.ws + WS_H1), (const bf16*)(F.ws + WS_WATTIN), D, D}; pg8::StaticOrder S; S.init(NT / 256, QKVW / 256, F.G, F.bid);
        epi::EpiQKV E{(bf16*)(F.ws + WS_QKV), (const float*)(F.ws + WS_ROPE)};
        REP(13) { GEMM_CALL(epi::EpiQKV, pg8::StaticOrder, g, S, E); RSYNC(13); }
        phase_moe_weights(F, args, MW_P11, MW_ITEMS, (NT / 256 * (QKVW / 256)) % F.G);
        SEAM(13); }
    if (IN(14)) { REP(14) { phase_attn(F, args); RSYNC(14); } SEAM(14); }
    if (IN(15)) {
        pg8::Gemm g{(const bf16*)(F.ws + WS_OATT), (const bf16*)(F.ws + WS_WATTOUT), D, D}; pg8::StaticOrder S; S.init(NL / 256, D / 256, F.G, F.bid);
        using ER15 = epi::EpiResT<true, true>; ER15 E{F.ws + WS_X2, (bf16*)F.out + D, F.ws + WS_X2, (bf16*)F.out + D, mods1 + 2 * 1024, 2 * D};
        GEMM_CALL(ER15, pg8::StaticOrder, g, S, E); SEAM(15); }
    if (IN(16)) { REP(16) { phase_route1(F, args); RSYNC(16); } SEAM(16); }
    if (IN(17)) { REP(17) { phase_route2(F); RSYNC(17); }
        SEAM(17); }
    if (IN(18)) {
        const int np = *(const int*)(F.ws + WS_NPAN), n = np > MAXPAN ? MAXPAN : np;
        pg8::Gemm g{(const bf16*)(F.ws + WS_A8), (const bf16*)(F.ws + WS_WMGU), D / 2, D / 2};
        pg8::MoeOrder S; S.so.init(n, FF2 / 256, F.G, F.bid); S.p0 = 0; S.pexp = (const int*)(F.ws + WS_PEXP);
        epi::EpiSwiGLU8 E{F.ws + WS_HMOE, 1.f / (MOE_SA * MOE_SW), MOE_SH};
        REP(18) { GEMM_CALL8(epi::EpiSwiGLU8, pg8::MoeOrder, g, S, E); RSYNC(18); } SEAM(18); }
    if (IN(19)) {
        const int np = *(const int*)(F.ws + WS_NPAN), n = np > MAXPAN ? MAXPAN : np;
        pg8::Gemm g{(const bf16*)(F.ws + WS_HMOE), (const bf16*)(F.ws + WS_WMD), FF / 2, FF / 2};
        pg8::MoeOrder S; S.so.init(n, D / 256, F.G, F.bid); S.p0 = 0; S.pexp = (const int*)(F.ws + WS_PEXP);
        epi::EpiBf16S E{(bf16*)(F.ws + WS_ASORT), D, 1.f / (MOE_SH * MOE_SW)};
        REP(19) { GEMM_CALL8(epi::EpiBf16S, pg8::MoeOrder, g, S, E); RSYNC(19); } SEAM(21); }
    if (IN(22)) { phase_final(F, args); }
#undef IN
#undef SEAM
}

extern "C" void kernel_launch(void* const* d_in, const int* in_sizes, int n_in, void* d_out, int out_size, void* d_ws, size_t ws_size, hipStream_t stream) {
    static int grid = 0;
    if (grid == 0) {
        if (n_in != 35 || out_size != NL * D || ws_size < WS_END) { fprintf(stderr, "kernel_launch: unexpected problem (n_in %d, out %d, ws %zu)\n", n_in, out_size, ws_size); grid = -1; return; }
        int dev = 0, cus = 0, per_cu = 0;
        if (hipGetDevice(&dev) != hipSuccess || hipDeviceGetAttribute(&cus, hipDeviceAttributeMultiprocessorCount, dev) != hipSuccess) { grid = -1; return; }
        if (hipFuncSetAttribute((const void*)mk_fwd, hipFuncAttributeMaxDynamicSharedMemorySize, LDS_BYTES) != hipSuccess) { fprintf(stderr, "kernel_launch: hipFuncSetAttribute failed\n"); grid = -1; return; }
        if (hipOccupancyMaxActiveBlocksPerMultiprocessor(&per_cu, (const void*)mk_fwd, NTHR, LDS_BYTES) != hipSuccess || per_cu < 1) fprintf(stderr, "kernel_launch: occupancy query reports %d\n", per_cu);
        (void)hipGetLastError();
        grid = cus;
    }
    if (grid < 0) return;
    (void)hipMemsetAsync((char*)d_ws + WS_CTL, 0, CTL_ZERO_BYTES, stream);
    Args a{};
    for (int i = 0; i < 35; ++i) a.in[i] = (const float*)d_in[i];
    a.out = (float*)d_out; a.ws = (unsigned char*)d_ws;
#if MK_PER_PHASE
    for (int p = 0; p < NPHASE; ++p) { a.ph_lo = p; a.ph_hi = p + 1; hipLaunchKernelGGL(mk_fwd, dim3(grid), dim3(NTHR), LDS_BYTES, stream, a); }
#else
    a.ph_lo = 0; a.ph_hi = NPHASE; hipLaunchKernelGGL(mk_fwd, dim3(grid), dim3(NTHR), LDS_BYTES, stream, a);
#endif
}
```

```cpp
#include <hip/hip_runtime.h>
#include <cstdio>
#include <cstdint>

#ifndef MK_PER_PHASE
#define MK_PER_PHASE 0
#endif

namespace pg8 {
#define PG8_LAS __attribute__((address_space(3)))
typedef unsigned short bf16_t;
typedef short bf16x8 __attribute__((ext_vector_type(8)));
typedef float f32x4 __attribute__((ext_vector_type(4)));
typedef float f32x2 __attribute__((ext_vector_type(2)));
typedef unsigned u32x4 __attribute__((ext_vector_type(4)));
typedef unsigned u32x2 __attribute__((ext_vector_type(2)));
constexpr int BM = 256, BK = 64, HALF = 128, HTB = HALF * BK * 2  , STAGE_BYTES = 8 * HTB, NXCD = 8, WGM = 8;

__host__ __device__ __forceinline__ int lds_byte(int r, int c) { const int st = (r >> 4) * 2 + (c >> 5), rr = r & 15, cc = c & 31, ob = rr * 64 + cc * 2; return st * 1024 + (ob ^ (((ob >> 9) & 1) << 5)); }
__host__ __device__ __forceinline__ void stage_rc(int b, int& R, int& C) { const int st = b / 1024, sb = b % 1024, swz = sb ^ (((sb >> 9) & 1) << 5); R = (st >> 1) * 16 + swz / 64; C = (st & 1) * 32 + (swz % 64) / 2; }
__host__ __device__ __forceinline__ int perm32(int rho) { const int n = rho >> 4, i = rho & 15; return 8 * (i >> 2) + 4 * n + (i & 3); }

struct Unit { int pm, pn, pb, ko; };
struct Gemm { const bf16_t* A; const bf16_t* Bt; int K; int ld; };

struct StaticOrder {
    int nM, nN, nwg, G, c;
    __device__ __forceinline__ void init(int nM_, int nN_, int G_, int c_) { nM = nM_; nN = nN_; nwg = nM * nN; G = G_; c = c_; }
    __device__ __forceinline__ bool next(int i, Unit& u) const {
        const long L = (long)i * G + c; if (L >= nwg) return false;
        int wgid = (int)L; { const int q = nwg / NXCD, r = nwg % NXCD, xcd = wgid % NXCD, off = wgid / NXCD; wgid = (xcd < r ? xcd * (q + 1) : r * (q + 1) + (xcd - r) * q) + off; }
        const int nig = WGM * nN, gid = wgid / nig, fm = gid * WGM, gsz = (nM - fm) < WGM ? (nM - fm) : WGM;
        u.pm = fm + ((wgid % nig) % gsz); u.pn = (wgid % nig) / gsz; u.pb = u.pn; u.ko = 0; return true;
    }
};
struct MoeOrder {
    StaticOrder so; int p0; const int* pexp;
    __device__ __forceinline__ bool next(int i, Unit& u) const {
        if (!so.next(i, u)) return false;
        u.pb = pexp[p0 + u.pm] * so.nN + u.pn; return true;
    }
};

struct SplitKOrder {
    int nM, nN, nS, KS, G, c, pm0, p0; const int* pexp;
    __device__ __forceinline__ bool next(int i, Unit& u) const {
        const long L = (long)i * G + c; if (L >= (long)nM * nN * nS) return false;
        const int l = (int)L, ks = l % nS, r = l / nS; u.pn = r % nN; u.pm = pm0 + r / nN; u.ko = ks * KS;
        u.pb = pexp ? pexp[p0 + u.pm] * nN + u.pn : u.pn; return true;
    }
};

__device__ __forceinline__ unsigned cvt_pk_bf16(float lo, float hi) { unsigned r; asm volatile("v_cvt_pk_bf16_f32 %0, %1, %2" : "=v"(r) : "v"(lo), "v"(hi)); return r; }

typedef int v8i32 __attribute__((ext_vector_type(8)));
template <class Epi, class Sched, bool ALIGN_EPI = false, bool SP2 = false, bool FP8 = false, bool I8 = false>
__device__ __forceinline__ void gemm_phase(PG8_LAS unsigned char* lds, const Gemm g, const Sched& S, const Epi& E) {
    const int tid = threadIdx.x, wid = __builtin_amdgcn_readfirstlane(tid >> 6), lane = tid & 63, wr = wid >> 2, wc = wid & 3, fr = lane & 15, fq = lane >> 4;
    const int K = g.ld, nt = g.K / BK;
    unsigned voffA[2], voffB[2];
#pragma unroll
    for (int i = 0; i < 2; ++i) { int R, C; stage_rc(tid * 16 + i * 8192, R, C); const int Rb = Epi::PERM ? ((R & ~31) + perm32(R & 31)) : R;
        voffA[i] = (unsigned)(R * K + C) * 2u; voffB[i] = (unsigned)(Rb * K + C) * 2u; }
    const size_t kstep = (size_t)(BK * 2);
    const size_t hstep = (size_t)HALF * K * 2;
    const size_t tstep = 2 * hstep;
    const unsigned ldsw = (unsigned)wid * 1024u;
    const int aoff = lds_byte(wr * 64 + fr, fq * 8), boff = lds_byte(wc * 32 + fr, fq * 8);
#define PG8_SA(b, h) (((b) * 2 + (h)) * HTB)
#define PG8_SB(b, h) ((4 + (b) * 2 + (h)) * HTB)
#define PG8_STAGE(bufoff, gbase, voff) do { _Pragma("unroll") for (int _i = 0; _i < 2; ++_i) \
        __builtin_amdgcn_global_load_lds((const unsigned*)((const char*)(gbase) + (voff)[_i]), (PG8_LAS unsigned*)(lds + (bufoff) + ldsw + _i * 8192), 16, 0, 0); } while (0)
#define PG8_RD(off) (*(const PG8_LAS bf16x8*)(lds + (off)))
#define PG8_CAT2(x, y) __builtin_bit_cast(v8i32, __builtin_shufflevector((x), (y), 0, 1, 2, 3, 4, 5, 6, 7, 8, 9, 10, 11, 12, 13, 14, 15))
#define PG8_LDA(dst, b, h) do { _Pragma("unroll") for (int m = 0; m < 4; ++m) { if constexpr (FP8) dst##8[m] = PG8_CAT2(PG8_RD(PG8_SA(b, h) + aoff + m * 2048), PG8_RD(PG8_SA(b, h) + aoff + m * 2048 + 1024)); \
        else { _Pragma("unroll") for (int k = 0; k < 2; ++k) dst[m][k] = PG8_RD(PG8_SA(b, h) + aoff + m * 2048 + k * 1024); } } } while (0)
#define PG8_LDB(dst, b, h) do { _Pragma("unroll") for (int n = 0; n < 2; ++n) { if constexpr (FP8) dst##8[n] = PG8_CAT2(PG8_RD(PG8_SB(b, h) + boff + n * 2048), PG8_RD(PG8_SB(b, h) + boff + n * 2048 + 1024)); \
        else { _Pragma("unroll") for (int k = 0; k < 2; ++k) dst[n][k] = PG8_RD(PG8_SB(b, h) + boff + n * 2048 + k * 1024); } } } while (0)
#define PG8_MMA(ai, bj, At, Bt) do { __builtin_amdgcn_s_setprio(1); \
        if constexpr (I8) { _Pragma("unroll") for (int k = 0; k < 2; ++k) _Pragma("unroll") for (int m = 0; m < 4; ++m) _Pragma("unroll") for (int n = 0; n < 2; ++n) \
            asm volatile("v_mfma_i32_16x16x64_i8 %0, %1, %2, %0" : "+v"(acc[ai][bj][m][n]) : "v"(Bt[n][k]), "v"(At[m][k])); } \
        else _Pragma("unroll") for (int m = 0; m < 4; ++m) _Pragma("unroll") for (int n = 0; n < 2; ++n) { \
        if constexpr (FP8) asm volatile("v_mfma_scale_f32_16x16x128_f8f6f4 %0, %1, %2, %0, %3, %3 op_sel_hi:[0,0,0]" : "+v"(acc[ai][bj][m][n]) : "v"(Bt##8[n]), "v"(At##8[m]), "v"(fp8_one));   \
        else { _Pragma("unroll") for (int k = 0; k < 2; ++k) acc[ai][bj][m][n] = __builtin_amdgcn_mfma_f32_16x16x32_bf16(Bt[n][k], At[m][k], acc[ai][bj][m][n], 0, 0, 0); } } __builtin_amdgcn_s_setprio(0); } while (0)
#define PG8_WAIT_V(n) asm volatile("s_waitcnt vmcnt(" #n ")" ::: "memory")
#define PG8_WAIT_L(n) asm volatile("s_waitcnt lgkmcnt(" #n ")" ::: "memory")
#define PG8_BAR __builtin_amdgcn_s_barrier()
#define PG8_SCHED __builtin_amdgcn_sched_barrier(0)
    Unit cur, nxt; int ui = 0;
    if (!S.next(0, cur)) return;
    f32x4 acc[2][2][4][2];
#pragma unroll
    for (int a = 0; a < 2; ++a)
#pragma unroll
        for (int b = 0; b < 2; ++b)
#pragma unroll
            for (int m = 0; m < 4; ++m)
#pragma unroll
                for (int n = 0; n < 2; ++n) acc[a][b][m][n] = (f32x4){0.f, 0.f, 0.f, 0.f};
    const int fp8_one = 0x7f7f7f7f;
    bf16x8 At[4][2], B0[2][2], B1[2][2]; v8i32 At8[4], B08[2], B18[2];
    const char* cA = (const char*)g.A + (size_t)cur.pm * tstep + (size_t)cur.ko * 2; const char* cB = (const char*)g.Bt + (size_t)cur.pb * tstep + (size_t)cur.ko * 2;
    if constexpr (SP2) {
        PG8_STAGE(PG8_SB(0, 0), cB, voffB); PG8_STAGE(PG8_SB(0, 1), cB + hstep, voffB); PG8_STAGE(PG8_SA(0, 0), cA, voffA); PG8_STAGE(PG8_SA(0, 1), cA + hstep, voffA);
        if (wr == 1) PG8_BAR;
        PG8_WAIT_V(2); PG8_BAR;
        PG8_STAGE(PG8_SB(1, 0), cB + kstep, voffB); PG8_STAGE(PG8_SA(1, 0), cA + kstep, voffA); PG8_STAGE(PG8_SB(1, 1), cB + hstep + kstep, voffB);
        PG8_WAIT_V(6); PG8_BAR;
    } else {
        PG8_STAGE(PG8_SB(0, 0), cB, voffB); PG8_STAGE(PG8_SA(0, 0), cA, voffA); PG8_STAGE(PG8_SB(0, 1), cB + hstep, voffB); PG8_STAGE(PG8_SA(0, 1), cA + hstep, voffA);
        if (wr == 1) PG8_BAR;
        PG8_WAIT_V(4); PG8_BAR;
        PG8_STAGE(PG8_SB(1, 0), cB + kstep, voffB); PG8_STAGE(PG8_SA(1, 0), cA + kstep, voffA); PG8_STAGE(PG8_SB(1, 1), cB + hstep + kstep, voffB);
        PG8_WAIT_V(6); PG8_BAR;
    }
    for (;;) {
        const bool has_next = S.next(ui + 1, nxt);
        const char* nA = has_next ? (const char*)g.A + (size_t)nxt.pm * tstep + (size_t)nxt.ko * 2 : cA; const char* nB = has_next ? (const char*)g.Bt + (size_t)nxt.pb * tstep + (size_t)nxt.ko * 2 : cB;
        for (int t = 0; t < nt; t += 2) {
            const bool last = (t == nt - 2);
            const char* a1 = cA + (size_t)(t + 1) * kstep;
            const char* a2 = last ? nA : cA + (size_t)(t + 2) * kstep; const char* b2 = last ? nB : cB + (size_t)(t + 2) * kstep;
            const char* a3 = a2 + kstep; const char* b3 = b2 + kstep;
            if constexpr (SP2) {
            PG8_LDB(B0, 0, 0); PG8_LDB(B1, 0, 1); PG8_SCHED; PG8_LDA(At, 0, 0); PG8_STAGE(PG8_SA(1, 1), a1 + hstep, voffA);
            PG8_WAIT_V(8); PG8_WAIT_L(0); PG8_BAR; PG8_MMA(0, 0, At, B0); PG8_MMA(0, 1, At, B1); PG8_BAR; PG8_SCHED;
            PG8_LDA(At, 0, 1); PG8_STAGE(PG8_SB(0, 0), b2, voffB); PG8_STAGE(PG8_SB(0, 1), b2 + hstep, voffB); PG8_STAGE(PG8_SA(0, 0), a2, voffA);
            PG8_WAIT_V(8); PG8_WAIT_L(0); PG8_BAR; PG8_MMA(1, 0, At, B0); PG8_MMA(1, 1, At, B1); PG8_BAR; PG8_SCHED;
            PG8_LDB(B0, 1, 0); PG8_LDB(B1, 1, 1); PG8_SCHED; PG8_LDA(At, 1, 0); PG8_STAGE(PG8_SA(0, 1), a2 + hstep, voffA);
            PG8_WAIT_V(8); PG8_WAIT_L(0); PG8_BAR; PG8_MMA(0, 0, At, B0); PG8_MMA(0, 1, At, B1); PG8_BAR; PG8_SCHED;
            PG8_LDA(At, 1, 1); PG8_STAGE(PG8_SB(1, 0), b3, voffB); PG8_STAGE(PG8_SB(1, 1), b3 + hstep, voffB); PG8_STAGE(PG8_SA(1, 0), a3, voffA);
            PG8_WAIT_V(8); PG8_WAIT_L(0); PG8_BAR; PG8_MMA(1, 0, At, B0); PG8_MMA(1, 1, At, B1); PG8_BAR; PG8_SCHED;
            } else {
            PG8_LDB(B0, 0, 0); PG8_SCHED; PG8_LDA(At, 0, 0); PG8_STAGE(PG8_SA(1, 1), a1 + hstep, voffA);
            PG8_WAIT_L(8); PG8_BAR; PG8_WAIT_L(0); PG8_MMA(0, 0, At, B0); PG8_BAR; PG8_SCHED;
            PG8_LDB(B1, 0, 1); PG8_STAGE(PG8_SB(0, 0), b2, voffB);
            PG8_BAR; PG8_WAIT_L(0); PG8_MMA(0, 1, At, B1); PG8_BAR;
            PG8_LDA(At, 0, 1); PG8_STAGE(PG8_SA(0, 0), a2, voffA);
            PG8_BAR; PG8_WAIT_L(0); PG8_MMA(1, 0, At, B0); PG8_BAR; PG8_SCHED;
            PG8_STAGE(PG8_SB(0, 1), b2 + hstep, voffB);
            PG8_WAIT_V(6); PG8_BAR; PG8_MMA(1, 1, At, B1); PG8_BAR;
            PG8_LDB(B0, 1, 0); PG8_SCHED; PG8_LDA(At, 1, 0); PG8_STAGE(PG8_SA(0, 1), a2 + hstep, voffA);
            PG8_WAIT_L(8); PG8_BAR; PG8_WAIT_L(0); PG8_MMA(0, 0, At, B0); PG8_BAR; PG8_SCHED;
            PG8_LDB(B1, 1, 1); PG8_STAGE(PG8_SB(1, 0), b3, voffB);
            PG8_BAR; PG8_WAIT_L(0); PG8_MMA(0, 1, At, B1); PG8_BAR;
            PG8_LDA(At, 1, 1); PG8_STAGE(PG8_SA(1, 0), a3, voffA);
            PG8_BAR; PG8_WAIT_L(0); PG8_MMA(1, 0, At, B0); PG8_BAR; PG8_SCHED;
            PG8_STAGE(PG8_SB(1, 1), b3 + hstep, voffB);
            PG8_WAIT_V(6); PG8_BAR; PG8_MMA(1, 1, At, B1); PG8_BAR;
            }
        }
        if constexpr (ALIGN_EPI) { if (wr == 0) PG8_BAR; }
        if constexpr (FP8 || I8) asm volatile("s_nop 15\n\ts_nop 7" ::: "memory");
        if constexpr (I8) {
#pragma unroll
            for (int a = 0; a < 2; ++a)
#pragma unroll
                for (int b = 0; b < 2; ++b)
#pragma unroll
                    for (int m = 0; m < 4; ++m)
#pragma unroll
                        for (int n = 0; n < 2; ++n)
#pragma unroll
                            for (int j = 0; j < 4; ++j) { const float t = acc[a][b][m][n][j]; acc[a][b][m][n][j] = (float)__float_as_int(t); }
        }
        { Unit eu = cur; asm volatile("" : "+s"(eu.pm), "+s"(eu.pn));
          E(acc, eu, wr, wc, fr, fq); }
        if (!has_next) break;
#pragma unroll
        for (int a = 0; a < 2; ++a)
#pragma unroll
            for (int b = 0; b < 2; ++b)
#pragma unroll
                for (int m = 0; m < 4; ++m)
#pragma unroll
                    for (int n = 0; n < 2; ++n) acc[a][b][m][n] = (f32x4){0.f, 0.f, 0.f, 0.f};
        cur = nxt; cA = nA; cB = nB; ++ui;
        if constexpr (ALIGN_EPI) { if (wr == 1) PG8_BAR; }
    }
    PG8_WAIT_V(0);
    if constexpr (!ALIGN_EPI) { if (wr == 0) PG8_BAR; }
    PG8_BAR;
#undef PG8_SA
#undef PG8_SB
#undef PG8_STAGE
#undef PG8_LDA
#undef PG8_LDB
#undef PG8_MMA
#undef PG8_CAT2
#undef PG8_RD
#undef PG8_WAIT_V
#undef PG8_WAIT_L
#undef PG8_BAR
#undef PG8_SCHED
}
}

constexpr int NWAVES = 8, NTHR = 512;
constexpr int D = 1024, NB = 16, T = 2048, CT = 256;
constexpr int NL = NB * T;
constexpr int NC = NB * CT;
constexpr int NT = NL + NC;
constexpr int RW = 1792, HG = 2560, RIN = RW + HG;
constexpr int AW = 512;
constexpr int FF = 2816, FF2 = 2 * FF;
constexpr int QKVW = 1536;
constexpr int NEXP = 8;
constexpr int MAXPAN = 264;
constexpr int CHUNK_PAN = 128;
constexpr float NORM_EPS = 1e-6f, GN_EPS = 64e-5f;
constexpr float LOG2E = 1.4426950408889634f;

constexpr size_t MiB = 1u << 20;
constexpr size_t WS_CTL = 0, CTL_ZERO_BYTES = 1 * MiB;
constexpr size_t WS_MODS = 1 * MiB;
constexpr size_t WS_MISC = 2 * MiB;
constexpr size_t WS_ROPE = WS_MISC;
constexpr size_t WS_RCNT = WS_MISC + 8192;
constexpr size_t WS_PEXP = WS_MISC + 16384;
constexpr size_t WS_NPAN = WS_MISC + 18432;
constexpr size_t WS_TOPE = WS_MISC + 32768;
constexpr size_t WS_TOPW = WS_TOPE + (size_t)NL * 8;
constexpr size_t WS_SLOT = WS_TOPW + (size_t)NL * 8;
constexpr size_t WS_SA = 3 * MiB;
constexpr size_t WS_SW = WS_SA + (size_t)NT * 4;
static_assert(WS_SLOT + (size_t)NL * 8 <= WS_SA && WS_SW + (size_t)FF2 * 4 <= 4 * MiB, "misc");
constexpr size_t WS_WIN = 4 * MiB;
constexpr size_t WS_WLORA = WS_WIN + (size_t)RIN * D * 2;
constexpr size_t WS_WOUT0 = WS_WLORA + (size_t)2048 * 256 * 2;
constexpr size_t WS_WGU0 = WS_WOUT0 + (size_t)D * D * 2;
constexpr size_t WS_WD0 = WS_WGU0 + (size_t)FF2 * D * 2;
constexpr size_t WS_WATTIN = WS_WD0 + (size_t)D * FF * 2;
constexpr size_t WS_WATTOUT = WS_WATTIN + (size_t)QKVW * D * 2;
static_assert(WS_WATTOUT + (size_t)D * D * 2 <= 38 * MiB, "weights");
constexpr size_t WS_PHG = 38 * MiB;
constexpr size_t WS_H0 = 218 * MiB;
constexpr size_t WS_R = 218 * MiB, WS_KS = 254 * MiB, WS_V = 290 * MiB, WS_KK = 326 * MiB, WS_LB = 362 * MiB;
constexpr size_t WS_BB = 380 * MiB;
constexpr size_t WS_OF = 416 * MiB, WS_OB = 452 * MiB;
constexpr size_t WS_YMIX = 326 * MiB;
constexpr size_t WS_X1C = 308 * MiB;
constexpr size_t WS_X2 = 326 * MiB, WS_X2C = 390 * MiB;
constexpr size_t WS_F = 38 * MiB;
constexpr size_t WS_HFF = 110 * MiB;
constexpr size_t WS_H1 = 38 * MiB;
constexpr size_t WS_WMGU = 446 * MiB;
constexpr size_t WS_WMD = 490 * MiB;
constexpr size_t WS_QKV = 110 * MiB;
constexpr size_t WS_OATT = 218 * MiB;
constexpr size_t WS_FLAT = 170 * MiB;
constexpr size_t WS_ASORT = 38 * MiB;
constexpr size_t WS_A8 = 362 * MiB;
constexpr size_t WS_HMOE = 170 * MiB;
constexpr size_t WS_END = 512 * MiB;
static_assert(WS_WMD + (size_t)NEXP * D * FF <= WS_END && WS_WMGU + (size_t)NEXP * FF2 * D <= WS_WMD, "moe weights");
static_assert(WS_PHG + (size_t)NT * HG * 2 <= WS_H0 && WS_H0 + (size_t)NT * D * 2 <= WS_V, "layer0 a");
static_assert(WS_LB + (size_t)NT * 256 * 2 <= WS_BB && WS_BB + (size_t)NT * AW * 2 <= WS_OF && WS_OB + (size_t)NT * AW * 2 <= WS_END, "layer0 b");
static_assert(WS_HFF + (size_t)NT * FF * 2 <= WS_X1C && WS_X1C + (size_t)NC * D * 4 <= WS_YMIX, "layer0 c");
static_assert(WS_ASORT + (size_t)MAXPAN * 256 * D * 2 <= WS_HMOE && WS_HMOE + (size_t)MAXPAN * 256 * FF <= WS_A8 && WS_A8 + (size_t)MAXPAN * 256 * D <= WS_WMGU && WS_FLAT + (size_t)NL * D <= WS_A8, "moe bufs");
static_assert(WS_QKV + (size_t)NT * QKVW * 2 <= WS_OATT && WS_OATT + (size_t)NL * D * 2 <= WS_A8, "layer1");
constexpr size_t DO_PRW = 0, DO_LWF = 0, DO_LWB = 36 * MiB, DO_GG = 72 * MiB, DO_OHF = 0, DO_OHB = 36 * MiB;
static_assert((size_t)NT * RW * 2 <= 128 * MiB, "P_rwkv in d_out");

constexpr int CW_BAR = 4096;

constexpr int RING_BYTES = 147456;
constexpr int LDSCTL_OFF = RING_BYTES, MISC_OFF = LDSCTL_OFF + 320;
constexpr int LDS_BYTES = RING_BYTES + 1024;

#define GAS __attribute__((address_space(1)))
#define LAS __attribute__((address_space(3)))
typedef unsigned short bf16;
typedef unsigned v4u __attribute__((ext_vector_type(4)));
typedef unsigned v2u __attribute__((ext_vector_type(2)));
typedef float f32x4 __attribute__((ext_vector_type(4)));
typedef float f32x2 __attribute__((ext_vector_type(2)));
typedef float f32x16 __attribute__((ext_vector_type(16)));
typedef short bf16x8 __attribute__((ext_vector_type(8)));
typedef short s16x4 __attribute__((ext_vector_type(4)));
typedef __bf16 bf16x2_t __attribute__((ext_vector_type(2)));
#define LDS_WAIT() asm volatile("s_waitcnt lgkmcnt(0)" ::: "memory")
__device__ __forceinline__ unsigned pk2(float lo, float hi) { f32x2 v = {lo, hi}; bf16x2_t b = __builtin_convertvector(v, bf16x2_t); return __builtin_bit_cast(unsigned, b); }
__device__ __forceinline__ unsigned pk4_fp8(float a, float b, float c, float d) {
    a = fminf(fmaxf(a, -448.f), 448.f); b = fminf(fmaxf(b, -448.f), 448.f); c = fminf(fmaxf(c, -448.f), 448.f); d = fminf(fmaxf(d, -448.f), 448.f);
    int p = __builtin_amdgcn_cvt_pk_fp8_f32(a, b, 0, false); p = __builtin_amdgcn_cvt_pk_fp8_f32(c, d, p, true); return (unsigned)p;
}
__device__ __forceinline__ float bflo(unsigned u) { return __uint_as_float(u << 16); }
__device__ __forceinline__ float bfhi(unsigned u) { return __uint_as_float(u & 0xffff0000u); }
__device__ __forceinline__ float fsigmoid(float x) { return __builtin_amdgcn_rcpf(1.f + __expf(-x)); }
__device__ __forceinline__ float fsilu(float x) { return x * fsigmoid(x); }
__device__ __forceinline__ float ftanh(float x) { return 1.f - 2.f * __builtin_amdgcn_rcpf(1.f + __expf(2.f * x)); }
__device__ __forceinline__ float wave_sum(float v) {
#pragma unroll
    for (int o = 1; o < 64; o <<= 1) v += __shfl_xor(v, o);
    return v;
}
template <int CTRL> __device__ __forceinline__ float dpp_f(float v) { return __builtin_bit_cast(float, __builtin_amdgcn_update_dpp(0, __builtin_bit_cast(int, v), CTRL, 0xf, 0xf, true)); }
__device__ __forceinline__ float sum8(float v) { v += dpp_f<0xB1>(v); v += dpp_f<0x4E>(v); v += dpp_f<0x141>(v); return v; }
__device__ __forceinline__ float sum16(float v) { v = sum8(v); v += dpp_f<0x140>(v); return v; }

#define XB_TMO      128
#define XB_XCNT(j)  (256  + 64 * (j))
#define XB_XSUB(j)  (1280 + 64 * (j))
#define XB_XGEN(j)  (2304 + 64 * (j))
#define XB_TOP      3328
#define XB_TOPGEN   3392
#define XCD_BAR_WORDS 3456
#define XB_SPIN_CAP (1u << 18)
__device__ __forceinline__ unsigned xb_ld(unsigned* p)              { return __hip_atomic_load(p, __ATOMIC_RELAXED, __HIP_MEMORY_SCOPE_AGENT); }
__device__ __forceinline__ unsigned xb_add(unsigned* p, unsigned v) { return __hip_atomic_fetch_add(p, v, __ATOMIC_RELAXED, __HIP_MEMORY_SCOPE_AGENT); }
__device__ __forceinline__ unsigned xb_xcc_id() { return (unsigned)__builtin_amdgcn_s_getreg((3 << 11) | 20) & 0xFu; }
#define XB_SPIN(cond, bar) do { unsigned _sp = 0; while (cond) { __builtin_amdgcn_s_sleep(1); \
    if ((++_sp & 255u) == 0u) { if (xb_ld(&(bar)[XB_TMO])) break; if (_sp > XB_SPIN_CAP) { atomicAdd(&(bar)[XB_TMO], 1u); break; } } } } while (0)
struct XcdBarrier { unsigned* bar; unsigned x; volatile LAS unsigned* st; };
__device__ __forceinline__ XcdBarrier xcd_barrier_post(unsigned* bar, volatile LAS unsigned* st) {
    XcdBarrier b; b.bar = bar; b.x = xb_xcc_id(); b.st = st;
    if (threadIdx.x == 0) (void)xb_add(&bar[XB_XCNT(b.x)], 1u);
    return b;
}
__device__ __forceinline__ void xcd_barrier_complete(unsigned* bar, unsigned x, unsigned& nloc, unsigned& nx) {
    const unsigned G = gridDim.x * gridDim.y * gridDim.z;
    unsigned sum, cnt, mine, sp = 0u;
    for (;;) {
        sum = 0u; cnt = 0u; mine = 0u;
#pragma unroll
        for (unsigned j = 0; j < 16; ++j) { const unsigned c = xb_ld(&bar[XB_XCNT(j)]); sum += c; cnt += (c > 0u) ? 1u : 0u; mine = (j == x) ? c : mine; }
        if (sum == G) break;
        __builtin_amdgcn_s_sleep(1);
        if ((++sp & 255u) == 0u) { if (xb_ld(&bar[XB_TMO])) break; if (sp > XB_SPIN_CAP) { atomicAdd(&bar[XB_TMO], 1u); break; } }
    }
    nloc = mine > 0u ? mine : 1u; nx = cnt > 0u ? cnt : 1u;
}
__device__ __forceinline__ void xcd_barrier(const XcdBarrier& b) {
    asm volatile("s_waitcnt vmcnt(0)" ::: "memory");
    __syncthreads();
    if (threadIdx.x == 0) {
        unsigned* bar = b.bar;
        __builtin_amdgcn_s_waitcnt(0);
        unsigned nloc = b.st[0], nx = b.st[1];
        if (nloc == 0u) { xcd_barrier_complete(bar, b.x, nloc, nx); b.st[0] = nloc; b.st[1] = nx; }
        const unsigned old = xb_add(&bar[XB_XSUB(b.x)], 1u);
        const unsigned gen = old / nloc;
        if (old + 1u == (gen + 1u) * nloc) {
            __builtin_amdgcn_fence(__ATOMIC_RELEASE, "agent");
            asm volatile("s_waitcnt vmcnt(0)" ::: "memory");
            const unsigned og = xb_add(&bar[XB_TOP], 1u);
            const unsigned tg = og / nx;
            if (og + 1u == (tg + 1u) * nx) xb_add(&bar[XB_TOPGEN], 1u);
            else XB_SPIN(xb_ld(&bar[XB_TOPGEN]) == tg, bar);
            __builtin_amdgcn_fence(__ATOMIC_ACQUIRE, "agent");
            xb_add(&bar[XB_XGEN(b.x)], 1u);
            asm volatile("s_waitcnt vmcnt(0)" ::: "memory");
        } else {
            XB_SPIN(xb_ld(&bar[XB_XGEN(b.x)]) == gen, bar);
            __builtin_amdgcn_fence(__ATOMIC_ACQUIRE, "agent");
            asm volatile("s_waitcnt vmcnt(0)" ::: "memory");
        }
    }
    __syncthreads();
}

struct Args { const float* in[35]; float* out; unsigned char* ws; int ph_lo, ph_hi; };
enum InIdx { I_X = 0, I_C, I_CTX, I_CCTX, I_MODW, I_MODB, I_NMIX, I_NFFN, I_NFIN, I_RWIN, I_RWOUT, I_MU, I_W0, I_WUP, I_A0, I_AUP, I_GUP, I_KK, I_KA, I_RK, I_LNW, I_LNB,
             I_HLB, I_HNORM, I_FG, I_FU, I_FD, I_AWIN, I_AWOUT, I_SINK, I_ROUTER, I_ROUTERB, I_MG, I_MU2, I_MD };
struct Frame {
    LAS unsigned char* lds;
    int tid, lane, wave, G, bid;
    float* out; unsigned char* ws;
};

namespace epi {
using pg8::Unit; using pg8::f32x4; using pg8::u32x4; using pg8::u32x2; using pg8::bf16_t; using pg8::HALF; using pg8::BM;
__device__ __forceinline__ u32x4 pack8(const f32x4& v0, const f32x4& v1) { u32x4 w; w.x = pk2(v0[0], v0[1]); w.y = pk2(v0[2], v0[3]); w.z = pk2(v1[0], v1[1]); w.w = pk2(v1[2], v1[3]); return w; }

struct EpiP {
    static constexpr bool PERM = true;
    bf16_t* P0; bf16_t* P1;
    __device__ __forceinline__ void operator()(const f32x4 (&acc)[2][2][4][2], const Unit& u, int wr, int wc, int fr, int fq) const {
        const int row0 = u.pm * BM + wr * 64 + fr; int colt = u.pn * BM; bf16_t* base = P0; int ld = RW;
        if (u.pn >= RW / 256) { base = P1; ld = HG; colt -= RW; }
        const int col0 = colt + wc * 32 + 8 * fq;
#pragma unroll
        for (int ai = 0; ai < 2; ++ai)
#pragma unroll
            for (int m = 0; m < 4; ++m) { bf16_t* rowp = base + (size_t)(row0 + ai * HALF + m * 16) * ld + col0;
#pragma unroll
                for (int bj = 0; bj < 2; ++bj) *(u32x4*)(rowp + bj * HALF) = pack8(acc[ai][bj][m][0], acc[ai][bj][m][1]); }
    }
};

struct EpiLora {
    static constexpr bool PERM = true;
    const float* w0; const float* a0; const float* k_a;
    bf16_t* LWF; bf16_t* LWB; bf16_t* KS; const bf16_t* KK; bf16_t* BB; bf16_t* GG;
    __device__ __forceinline__ void operator()(const f32x4 (&acc)[2][2][4][2], const Unit& u, int wr, int wc, int fr, int fq) const {
        const int row0 = u.pm * BM + wr * 64 + fr; const int q = u.pn >> 1;
        const int cc0 = (u.pn & 1) * 256 + wc * 32 + 8 * fq;
#pragma unroll
        for (int bj = 0; bj < 2; ++bj) { const int cc = cc0 + bj * HALF;
            if (q < 2) {
                const f32x4 z0 = *(const f32x4*)(w0 + q * AW + cc), z1 = *(const f32x4*)(w0 + q * AW + cc + 4); bf16_t* O = q ? LWB : LWF;
#pragma unroll
                for (int ai = 0; ai < 2; ++ai)
#pragma unroll
                    for (int m = 0; m < 4; ++m) { f32x4 v0 = acc[ai][bj][m][0] + z0, v1 = acc[ai][bj][m][1] + z1;
#pragma unroll
                        for (int j = 0; j < 4; ++j) { v0[j] = -0.6065306597f * fsigmoid(v0[j]); v1[j] = -0.6065306597f * fsigmoid(v1[j]); }
                        *(u32x4*)(O + (size_t)(row0 + ai * HALF + m * 16) * AW + cc) = pack8(v0, v1); asm volatile("" ::: "memory"); }
            } else if (q == 2) {
                const f32x4 z0 = *(const f32x4*)(a0 + cc), z1 = *(const f32x4*)(a0 + cc + 4), ka0 = *(const f32x4*)(k_a + cc), ka1 = *(const f32x4*)(k_a + cc + 4);
#pragma unroll
                for (int ai = 0; ai < 2; ++ai)
#pragma unroll
                    for (int m = 0; m < 4; ++m) { const size_t off = (size_t)(row0 + ai * HALF + m * 16) * AW + cc;
                        f32x4 a_0 = acc[ai][bj][m][0] + z0, a_1 = acc[ai][bj][m][1] + z1;
                        const u32x4 kw = *(const u32x4*)(KS + off), kkw = *(const u32x4*)(KK + off);
                        f32x4 k0 = {bflo(kw.x), bfhi(kw.x), bflo(kw.y), bfhi(kw.y)}, k1 = {bflo(kw.z), bfhi(kw.z), bflo(kw.w), bfhi(kw.w)};
                        f32x4 q0 = {bflo(kkw.x), bfhi(kkw.x), bflo(kkw.y), bfhi(kkw.y)}, q1 = {bflo(kkw.z), bfhi(kkw.z), bflo(kkw.w), bfhi(kkw.w)};
#pragma unroll
                        for (int j = 0; j < 4; ++j) { const float s0 = fsigmoid(a_0[j]), s1 = fsigmoid(a_1[j]);
                            k0[j] = k0[j] * (1.f + (s0 - 1.f) * ka0[j]); k1[j] = k1[j] * (1.f + (s1 - 1.f) * ka1[j]); q0[j] *= s0; q1[j] *= s1; }
                        *(u32x4*)(KS + off) = pack8(k0, k1); *(u32x4*)(BB + off) = pack8(q0, q1); asm volatile("" ::: "memory"); }
            } else {
#pragma unroll
                for (int ai = 0; ai < 2; ++ai)
#pragma unroll
                    for (int m = 0; m < 4; ++m) *(u32x4*)(GG + (size_t)(row0 + ai * HALF + m * 16) * AW + cc) = pack8(acc[ai][bj][m][0], acc[ai][bj][m][1]);
            }
        }
    }
};

template <bool R16, bool O16>
struct EpiResT {
    static constexpr bool PERM = true;
    const void* resL; void* outL; const void* resC; void* outC; const float* gateBase; int ldo; float ys = 1.f;
    __device__ __forceinline__ void operator()(const f32x4 (&acc)[2][2][4][2], const Unit& u, int wr, int wc, int fr, int fq) const {
        const bool lat = u.pm < NL / 256; const int s = lat ? (u.pm >> 3) : NB;
        const void* res = lat ? resL : resC; void* out = lat ? outL : outC; const int prow = lat ? u.pm : u.pm - NL / 256;
        const int row0 = prow * BM + wr * 64 + fr, col0 = u.pn * BM + wc * 32 + 8 * fq;
        const float* gate = gateBase + (size_t)s * 6144 + col0;
        f32x4 gv[2][2];
#pragma unroll
        for (int bj = 0; bj < 2; ++bj)
#pragma unroll
            for (int n = 0; n < 2; ++n) gv[bj][n] = *(const f32x4*)(gate + bj * HALF + n * 4) * ys;
#pragma unroll
        for (int ai = 0; ai < 2; ++ai)
#pragma unroll
            for (int m = 0; m < 4; ++m) { const size_t off = (size_t)(row0 + ai * HALF + m * 16) * D + col0, offo = (size_t)(row0 + ai * HALF + m * 16) * ldo + col0;
#pragma unroll
                for (int bj = 0; bj < 2; ++bj) { f32x4 r0, r1;
                    if constexpr (R16) { const u32x4 w = *(const u32x4*)((const bf16_t*)res + off + bj * HALF); r0 = (f32x4){bflo(w.x), bfhi(w.x), bflo(w.y), bfhi(w.y)}; r1 = (f32x4){bflo(w.z), bfhi(w.z), bflo(w.w), bfhi(w.w)}; }
                    else { r0 = *(const f32x4*)((const float*)res + off + bj * HALF); r1 = *(const f32x4*)((const float*)res + off + bj * HALF + 4); }
                    const f32x4 v0 = r0 + gv[bj][0] * acc[ai][bj][m][0], v1 = r1 + gv[bj][1] * acc[ai][bj][m][1];
                    if constexpr (O16) *(u32x4*)((bf16_t*)out + offo + bj * HALF) = pack8(v0, v1);
                    else { *(f32x4*)((float*)out + offo + bj * HALF) = v0; *(f32x4*)((float*)out + offo + bj * HALF + 4) = v1; } }
                asm volatile("" ::: "memory"); }
    }
};

struct EpiResAtomic {
    static constexpr bool PERM = false;
    float* outC; const float* gate;
    __device__ __forceinline__ void operator()(const f32x4 (&acc)[2][2][4][2], const Unit& u, int wr, int wc, int fr, int fq) const {
        const int row0 = u.pm * BM + wr * 64 + fr, col0 = u.pn * BM + wc * 32 + 4 * fq;
#pragma unroll
        for (int bj = 0; bj < 2; ++bj)
#pragma unroll
            for (int n = 0; n < 2; ++n) { const f32x4 gv = *(const f32x4*)(gate + col0 + bj * HALF + n * 16);
#pragma unroll
                for (int ai = 0; ai < 2; ++ai)
#pragma unroll
                    for (int m = 0; m < 4; ++m) { float* p = outC + (size_t)(row0 + ai * HALF + m * 16) * D + col0 + bj * HALF + n * 16;
#pragma unroll
                        for (int j = 0; j < 4; ++j) __hip_atomic_fetch_add(p + j, gv[j] * acc[ai][bj][m][n][j], __ATOMIC_RELAXED, __HIP_MEMORY_SCOPE_AGENT); } }
    }
};
struct EpiPartY {
    static constexpr bool PERM = false;
    float* Yp;
    __device__ __forceinline__ void operator()(const f32x4 (&acc)[2][2][4][2], const Unit& u, int wr, int wc, int fr, int fq) const {
        const int row0 = u.pm * BM + wr * 64 + fr, col0 = u.pn * BM + wc * 32 + 4 * fq; float* base = Yp + (size_t)(u.ko >> 8) * ((size_t)(MAXPAN - 2 * CHUNK_PAN) * 256 * D);
#pragma unroll
        for (int ai = 0; ai < 2; ++ai)
#pragma unroll
            for (int m = 0; m < 4; ++m)
#pragma unroll
                for (int bj = 0; bj < 2; ++bj)
#pragma unroll
                    for (int n = 0; n < 2; ++n) *(f32x4*)(base + (size_t)(row0 + ai * HALF + m * 16) * D + col0 + bj * HALF + n * 16) = acc[ai][bj][m][n];
    }
};

struct EpiSwiGLU {
    static constexpr bool PERM = true;
    bf16_t* H;
    __device__ __forceinline__ void operator()(const f32x4 (&acc)[2][2][4][2], const Unit& u, int wr, int wc, int fr, int fq) const {
        const int row0 = u.pm * BM + wr * 64 + fr, col0 = u.pn * HALF + wc * 32 + 8 * fq;
#pragma unroll
        for (int ai = 0; ai < 2; ++ai)
#pragma unroll
            for (int m = 0; m < 4; ++m) { f32x4 v0, v1;
#pragma unroll
                for (int j = 0; j < 4; ++j) { v0[j] = fsilu(acc[ai][0][m][0][j]) * acc[ai][1][m][0][j]; v1[j] = fsilu(acc[ai][0][m][1][j]) * acc[ai][1][m][1][j]; }
                *(u32x4*)(H + (size_t)(row0 + ai * HALF + m * 16) * FF + col0) = pack8(v0, v1); }
    }
};

struct EpiSwiGLU8 {
    static constexpr bool PERM = true;
    unsigned char* H; float inv, hs;
    __device__ __forceinline__ void operator()(const f32x4 (&acc)[2][2][4][2], const Unit& u, int wr, int wc, int fr, int fq) const {
        const int row0 = u.pm * BM + wr * 64 + fr, col0 = u.pn * HALF + wc * 32 + 8 * fq;
#pragma unroll
        for (int ai = 0; ai < 2; ++ai)
#pragma unroll
            for (int m = 0; m < 4; ++m) { f32x4 v0, v1;
#pragma unroll
                for (int j = 0; j < 4; ++j) { v0[j] = fsilu(acc[ai][0][m][0][j] * inv) * (acc[ai][1][m][0][j] * inv) * hs; v1[j] = fsilu(acc[ai][0][m][1][j] * inv) * (acc[ai][1][m][1][j] * inv) * hs; }
                u32x2 w; w.x = pk4_fp8(v0[0], v0[1], v0[2], v0[3]); w.y = pk4_fp8(v1[0], v1[1], v1[2], v1[3]);
                *(u32x2*)(H + (size_t)(row0 + ai * HALF + m * 16) * FF + col0) = w; asm volatile("" ::: "memory"); }
    }
};
struct EpiSwiGLUQ {
    static constexpr bool PERM = true;
    unsigned char* H; const float* sA; const float* sW; float hs;
    __device__ __forceinline__ void operator()(const f32x4 (&acc)[2][2][4][2], const Unit& u, int wr, int wc, int fr, int fq) const {
        const int row0 = u.pm * BM + wr * 64 + fr, col0 = u.pn * HALF + wc * 32 + 8 * fq; const float* sw = sW + u.pn * BM + wc * 32 + 8 * fq;
        const f32x4 sg0 = *(const f32x4*)sw, sg1 = *(const f32x4*)(sw + 4), su0 = *(const f32x4*)(sw + HALF) * hs, su1 = *(const f32x4*)(sw + HALF + 4) * hs;
#pragma unroll
        for (int ai = 0; ai < 2; ++ai)
#pragma unroll
            for (int m = 0; m < 4; ++m) { f32x4 v0, v1; const float ra = sA[row0 + ai * HALF + m * 16];
#pragma unroll
                for (int j = 0; j < 4; ++j) { v0[j] = fsilu(acc[ai][0][m][0][j] * (ra * sg0[j])) * (acc[ai][1][m][0][j] * (ra * su0[j])); v1[j] = fsilu(acc[ai][0][m][1][j] * (ra * sg1[j])) * (acc[ai][1][m][1][j] * (ra * su1[j])); }
                u32x2 w; w.x = pk4_fp8(v0[0], v0[1], v0[2], v0[3]); w.y = pk4_fp8(v1[0], v1[1], v1[2], v1[3]);
                *(u32x2*)(H + (size_t)(row0 + ai * HALF + m * 16) * FF + col0) = w; asm volatile("" ::: "memory"); }
    }
};
struct EpiBf16S {
    static constexpr bool PERM = true;
    bf16_t* O; int ld; float s;
    __device__ __forceinline__ void operator()(const f32x4 (&acc)[2][2][4][2], const Unit& u, int wr, int wc, int fr, int fq) const {
        const int row0 = u.pm * BM + wr * 64 + fr, col0 = u.pn * BM + wc * 32 + 8 * fq;
#pragma unroll
        for (int ai = 0; ai < 2; ++ai)
#pragma unroll
            for (int m = 0; m < 4; ++m) { bf16_t* rowp = O + (size_t)(row0 + ai * HALF + m * 16) * ld + col0;
#pragma unroll
                for (int bj = 0; bj < 2; ++bj) *(u32x4*)(rowp + bj * HALF) = pack8(acc[ai][bj][m][0] * s, acc[ai][bj][m][1] * s); }
    }
};
struct EpiBf16 {
    static constexpr bool PERM = true;
    bf16_t* O; int ld;
    __device__ __forceinline__ void operator()(const f32x4 (&acc)[2][2][4][2], const Unit& u, int wr, int wc, int fr, int fq) const {
        const int row0 = u.pm * BM + wr * 64 + fr, col0 = u.pn * BM + wc * 32 + 8 * fq;
#pragma unroll
        for (int ai = 0; ai < 2; ++ai)
#pragma unroll
            for (int m = 0; m < 4; ++m) { bf16_t* rowp = O + (size_t)(row0 + ai * HALF + m * 16) * ld + col0;
#pragma unroll
                for (int bj = 0; bj < 2; ++bj) *(u32x4*)(rowp + bj * HALF) = pack8(acc[ai][bj][m][0], acc[ai][bj][m][1]); }
    }
};

struct EpiQKV {
    static constexpr bool PERM = true;
    bf16_t* O; const float* rope;
    __device__ __forceinline__ void operator()(const f32x4 (&acc)[2][2][4][2], const Unit& u, int wr, int wc, int fr, int fq) const {
        const int row0 = u.pm * BM + wr * 64 + fr, col0 = u.pn * BM + wc * 32 + 8 * fq;
        const bool lat = u.pm < NL / 256, isv = u.pn == 5, isq = u.pn < 4;
        const int axis = wc & 1;
        const float qs = isq ? 0.125f * LOG2E : 1.f;
#pragma unroll
        for (int ai = 0; ai < 2; ++ai)
#pragma unroll
            for (int m = 0; m < 4; ++m) { const int row = row0 + ai * HALF + m * 16; bf16_t* rowp = O + (size_t)row * QKVW + col0;
                f32x4 c0 = {1.f, 0.f, 1.f, 0.f}, c1 = {1.f, 0.f, 1.f, 0.f};
                if (lat && !isv) { const int t = row & (T - 1), pos = axis ? (t & 63) : (t >> 6); const float* rp = rope + (pos * 16 + 4 * fq) * 2; c0 = *(const f32x4*)rp; c1 = *(const f32x4*)(rp + 4); }
#pragma unroll
                for (int bj = 0; bj < 2; ++bj) { const f32x4 a = acc[ai][bj][m][0], b = acc[ai][bj][m][1]; f32x4 v0, v1;
                    v0[0] = (a[0] * c0[0] - a[1] * c0[1]) * qs; v0[1] = (a[1] * c0[0] + a[0] * c0[1]) * qs;
                    v0[2] = (a[2] * c0[2] - a[3] * c0[3]) * qs; v0[3] = (a[3] * c0[2] + a[2] * c0[3]) * qs;
                    v1[0] = (b[0] * c1[0] - b[1] * c1[1]) * qs; v1[1] = (b[1] * c1[0] + b[0] * c1[1]) * qs;
                    v1[2] = (b[2] * c1[2] - b[3] * c1[3]) * qs; v1[3] = (b[3] * c1[2] + b[2] * c1[3]) * qs;
                    *(u32x4*)(rowp + bj * HALF) = pack8(v0, v1); } }
    }
};
}

__device__ __forceinline__ void tr_item(const float* src, int ldS, int k0, int n0, bf16* dst, int ldD, int drow0, int dcol0, bool rperm, LAS float* scr, int lane) {
    const int c4 = (lane & 7) * 4, r0 = lane >> 3;
    f32x4 v[8];
#pragma unroll
    for (int i = 0; i < 8; ++i) v[i] = *(const f32x4*)(src + (size_t)(k0 + r0 + 8 * i) * ldS + n0 + c4);
#pragma unroll
    for (int i = 0; i < 8; ++i) { LAS float* d = scr + (r0 + 8 * i) * 33;
#pragma unroll
        for (int q = 0; q < 4; ++q) { const int nl = c4 + q, pn = rperm ? (((nl & 15) << 1) | (nl >> 4)) : nl; d[pn] = v[i][q]; } }
    LDS_WAIT(); asm volatile("" ::: "memory");
    const int c = lane & 7;
#pragma unroll
    for (int j = 0; j < 4; ++j) { const int n = (lane >> 3) + 8 * j; const LAS float* s = scr + (8 * c) * 33 + n;
        v4u o; o.x = pk2(s[0 * 33], s[1 * 33]); o.y = pk2(s[2 * 33], s[3 * 33]); o.z = pk2(s[4 * 33], s[5 * 33]); o.w = pk2(s[6 * 33], s[7 * 33]);
        *(v4u*)(dst + (size_t)(drow0 + n) * ldD + dcol0 + 8 * c) = o; }
    LDS_WAIT(); asm volatile("" ::: "memory");
}
__device__ __forceinline__ void tr_item8(const float* src, int ldS, int k0, int n0, unsigned char* dst, int ldD, int drow0, int dcol0, float scale, LAS float* scr, int lane) {
    const int c4 = (lane & 7) * 4, r0 = lane >> 3;
    f32x4 v[8];
#pragma unroll
    for (int i = 0; i < 8; ++i) v[i] = *(const f32x4*)(src + (size_t)(k0 + r0 + 8 * i) * ldS + n0 + c4);
#pragma unroll
    for (int i = 0; i < 8; ++i) { LAS float* d = scr + (r0 + 8 * i) * 33;
#pragma unroll
        for (int q = 0; q < 4; ++q) d[c4 + q] = v[i][q] * scale; }
    LDS_WAIT(); asm volatile("" ::: "memory");
    const int c = lane & 3;
#pragma unroll
    for (int j = 0; j < 2; ++j) { const int n = (lane >> 2) + 16 * j; const LAS float* s = scr + (16 * c) * 33 + n;
        v4u o; o.x = pk4_fp8(s[0 * 33], s[1 * 33], s[2 * 33], s[3 * 33]); o.y = pk4_fp8(s[4 * 33], s[5 * 33], s[6 * 33], s[7 * 33]);
        o.z = pk4_fp8(s[8 * 33], s[9 * 33], s[10 * 33], s[11 * 33]); o.w = pk4_fp8(s[12 * 33], s[13 * 33], s[14 * 33], s[15 * 33]);
        *(v4u*)(dst + (size_t)(drow0 + n) * ldD + dcol0 + 16 * c) = o; }
    LDS_WAIT(); asm volatile("" ::: "memory");
}
__device__ __forceinline__ void tr_gu_item8(const float* wg, const float* wu, unsigned char* dst, int it, float scale, LAS float* scr, int lane) {
    const int which = it / 1408, r = it % 1408, kb = r / 88, nb = r % 88, n0 = nb * 32;
    tr_item8(which ? wu : wg, FF, kb * 64, n0, dst, D, (n0 >> 7) * 256 + which * 128 + (n0 & 127), kb * 64, scale, scr, lane);
}
__device__ __forceinline__ void tr_plain_item8(const float* w, int K, int N, unsigned char* dst, int it, float scale, LAS float* scr, int lane) {
    const int nblk = N / 32, kb = it / nblk, nb = it % nblk;
    tr_item8(w, N, kb * 64, nb * 32, dst, K, nb * 32, kb * 64, scale, scr, lane);
}
__device__ __forceinline__ unsigned pk4_i8(float a, float b, float c, float d) {
    const int ia = (int)__builtin_rintf(__builtin_amdgcn_fmed3f(a, -127.f, 127.f)), ib = (int)__builtin_rintf(__builtin_amdgcn_fmed3f(b, -127.f, 127.f));
    const int ic = (int)__builtin_rintf(__builtin_amdgcn_fmed3f(c, -127.f, 127.f)), id = (int)__builtin_rintf(__builtin_amdgcn_fmed3f(d, -127.f, 127.f));
    return (unsigned)(ia & 255) | ((unsigned)(ib & 255) << 8) | ((unsigned)(ic & 255) << 16) | ((unsigned)id << 24);
}
__device__ __forceinline__ void tr_item_i8(const float* src, int ldS, int k0, int n0, unsigned char* dst, int ldD, int drow0, int dcol0, const f32x4 sc, LAS float* scr, int lane) {
    const int c4 = (lane & 7) * 4, r0 = lane >> 3;
    f32x4 v[8];
#pragma unroll
    for (int i = 0; i < 8; ++i) v[i] = *(const f32x4*)(src + (size_t)(k0 + r0 + 8 * i) * ldS + n0 + c4);
#pragma unroll
    for (int i = 0; i < 8; ++i) { LAS float* d = scr + (r0 + 8 * i) * 33;
#pragma unroll
        for (int q = 0; q < 4; ++q) d[c4 + q] = v[i][q] * sc[q]; }
    LDS_WAIT(); asm volatile("" ::: "memory");
    const int c = lane & 3;
#pragma unroll
    for (int j = 0; j < 2; ++j) { const int n = (lane >> 2) + 16 * j; const LAS float* s = scr + (16 * c) * 33 + n;
        v4u o; o.x = pk4_i8(s[0 * 33], s[1 * 33], s[2 * 33], s[3 * 33]); o.y = pk4_i8(s[4 * 33], s[5 * 33], s[6 * 33], s[7 * 33]);
        o.z = pk4_i8(s[8 * 33], s[9 * 33], s[10 * 33], s[11 * 33]); o.w = pk4_i8(s[12 * 33], s[13 * 33], s[14 * 33], s[15 * 33]);
        *(v4u*)(dst + (size_t)(drow0 + n) * ldD + dcol0 + 16 * c) = o; }
    LDS_WAIT(); asm volatile("" ::: "memory");
}
__device__ __forceinline__ void tr_gu_col_item_i8(const float* wg, const float* wu, unsigned char* dst, float* sW, int it, LAS float* scr, int lane) {
    const int which = it / 88, nb = it % 88, n0 = nb * 32; const float* src = which ? wu : wg;
    const int c4 = (lane & 7) * 4, r0 = lane >> 3;
    f32x4 mx = (f32x4){0.f, 0.f, 0.f, 0.f};
#pragma unroll 1
    for (int kb = 0; kb < D / 64; ++kb) {
#pragma unroll
        for (int i = 0; i < 8; ++i) { const f32x4 v = *(const f32x4*)(src + (size_t)(kb * 64 + r0 + 8 * i) * FF + n0 + c4);
#pragma unroll
            for (int q = 0; q < 4; ++q) mx[q] = fmaxf(mx[q], fabsf(v[q])); } }
    f32x4 sc;
#pragma unroll
    for (int q = 0; q < 4; ++q) { float m = mx[q]; m = fmaxf(m, __shfl_xor(m, 8)); m = fmaxf(m, __shfl_xor(m, 16)); m = fmaxf(m, __shfl_xor(m, 32)); mx[q] = m; sc[q] = m > 0.f ? 127.f / m : 0.f; }
    const int drow0 = (n0 >> 7) * 256 + which * 128 + (n0 & 127);
    if (lane < 8) *(f32x4*)(sW + drow0 + c4) = mx * (1.f / 127.f);
#pragma unroll 1
    for (int kb = 0; kb < D / 64; ++kb) tr_item_i8(src, FF, kb * 64, n0, dst, D, drow0, kb * 64, sc, scr, lane);
}
__device__ __forceinline__ void tr_gu_item(const float* wg, const float* wu, bf16* dst, int it, LAS float* scr, int lane) {
    const int which = it / 1408, r = it % 1408, kb = r / 88, nb = r % 88, n0 = nb * 32;
    tr_item(which ? wu : wg, FF, kb * 64, n0, dst, D, (n0 >> 7) * 256 + which * 128 + (n0 & 127), kb * 64, false, scr, lane);
}
__device__ __forceinline__ void tr_plain_item(const float* w, int K, int N, bf16* dst, int it, LAS float* scr, int lane) {
    const int nblk = N / 32, kb = it / nblk, nb = it % nblk;
    tr_item(w, N, kb * 64, nb * 32, dst, K, nb * 32, kb * 64, false, scr, lane);
}

constexpr int PW_IN = 16 * (RIN / 32), PW_SQ = 16 * 32, PW_GU = 2 * 88, PW_DN = 44 * 32, PW_AI = 16 * (QKVW / 32), PW_LORA = 16 + 16 + 16 + 32;
constexpr float FFN_SW = 64.f, FFN_SA = 8.f, FFN_SH = 8.f;
constexpr int PW_ITEMS = PW_IN + PW_SQ + PW_GU + PW_DN + PW_AI + PW_SQ + PW_LORA;
__device__ __forceinline__ void phase_layer_weights(const Frame& F, const Args& a, int lo, int hi, int first) {
    if (F.bid < first) return;
    LAS float* scr = (LAS float*)(F.lds + F.wave * 8704);
    const int gw = (F.bid - first) * NWAVES + F.wave, NGW = (F.G - first) * NWAVES;
    bf16* Win = (bf16*)(F.ws + WS_WIN); bf16* Wlora = (bf16*)(F.ws + WS_WLORA); bf16* Wout0 = (bf16*)(F.ws + WS_WOUT0); bf16* Wgu0 = (bf16*)(F.ws + WS_WGU0);
    bf16* Wd0 = (bf16*)(F.ws + WS_WD0); bf16* Wai = (bf16*)(F.ws + WS_WATTIN); bf16* Wao = (bf16*)(F.ws + WS_WATTOUT);
    for (int it = lo + gw; it < hi; it += NGW) {
        int r = it;
        if (r < PW_IN) { tr_plain_item(a.in[I_RWIN], D, RIN, Win, r, scr, F.lane); continue; } r -= PW_IN;
        if (r < PW_SQ) { tr_plain_item(a.in[I_RWOUT], D, D, Wout0, r, scr, F.lane); continue; } r -= PW_SQ;
        if (r < PW_GU) { tr_gu_col_item_i8(a.in[I_FG], a.in[I_FU], (unsigned char*)Wgu0, (float*)(F.ws + WS_SW), r, scr, F.lane); continue; } r -= PW_GU;
        if (r < PW_DN) { tr_plain_item8(a.in[I_FD], FF, D, (unsigned char*)Wd0, r, FFN_SW, scr, F.lane); continue; } r -= PW_DN;
        if (r < PW_AI) { const int kb = r / (QKVW / 32), nb = r % (QKVW / 32); tr_item(a.in[I_AWIN], QKVW, kb * 64, nb * 32, Wai, D, nb * 32, kb * 64, nb < 40, scr, F.lane); continue; } r -= PW_AI;
        if (r < PW_SQ) { tr_plain_item(a.in[I_AWOUT], D, D, Wao, r, scr, F.lane); continue; } r -= PW_SQ;
        if (r < 32) { const int d = r >> 4, nb = r & 15; tr_item(a.in[I_WUP] + (size_t)d * 64 * AW, AW, 0, nb * 32, Wlora, 256, d * AW + nb * 32, 0, false, scr, F.lane); continue; } r -= 32;
        if (r < 16) { tr_item(a.in[I_AUP], AW, 0, r * 32, Wlora, 256, 1024 + r * 32, 64, false, scr, F.lane); continue; } r -= 16;
        { const int kb = r >> 4, nb = r & 15; tr_item(a.in[I_GUP], AW, kb * 64, nb * 32, Wlora, 256, 1536 + nb * 32, 128 + kb * 64, false, scr, F.lane); }
    }
}
__device__ __forceinline__ void phase_prologue(const Frame& F, const Args& a) {
    bf16* Wlora = (bf16*)(F.ws + WS_WLORA);
    phase_layer_weights(F, a, 0, PW_IN, 0);
    for (int i = (F.bid * NTHR + F.tid); i < 2048 * 32; i += F.G * NTHR) { const int row = i >> 5, k = (i & 31) * 8;
        const bool nz = row < 1024 ? (k < 64) : (row < 1536 ? (k >= 64 && k < 128) : (k >= 128));
        if (!nz) *(v4u*)(Wlora + (size_t)row * 256 + k) = (v4u){0u, 0u, 0u, 0u}; }
    if (F.bid == 0) for (int i = F.tid; i < 1024; i += NTHR) { const int pos = i >> 4, ii = i & 15; const float inv = exp2f(-(float)ii * (13.287712379549449f / 16.f)); const float ang = (float)pos * inv;
        float* rp = (float*)(F.ws + WS_ROPE) + 2 * i; rp[0] = __cosf(ang); rp[1] = __sinf(ang); }
    __syncthreads();
    {
        LAS float* sc = (LAS float*)(F.lds + 36864);
        LAS float* red = (LAS float*)(F.lds);
        if (F.bid < 192) {
            for (int i = F.tid; i < 17 * 1024; i += NTHR) { const int s = i >> 10, k = i & 1023; const float v = s < NB ? a.in[I_C][s * D + k] : a.in[I_CCTX][k]; sc[i] = fsilu(v); }
            __syncthreads();
        }
        for (int u = F.bid; u < 192; u += F.G) {
            const int l = u / 96, col0 = (u % 96) * 64, c4 = F.tid & 15, kg = F.tid >> 4;
            f32x4 acc[17];
#pragma unroll
            for (int s = 0; s < 17; ++s) acc[s] = (f32x4){0.f, 0.f, 0.f, 0.f};
            const float* wp = a.in[I_MODW] + ((size_t)l * D + kg * 32) * 6144 + col0 + c4 * 4;
            for (int kk = 0; kk < 32; ++kk) { const f32x4 w = *(const f32x4*)(wp + (size_t)kk * 6144); const int k = kg * 32 + kk;
#pragma unroll
                for (int s = 0; s < 17; ++s) acc[s] += w * sc[s * 1024 + k]; }
#pragma unroll
            for (int s = 0; s < 17; ++s)
#pragma unroll
                for (int j = 0; j < 4; ++j) { float v = acc[s][j]; v += __shfl_xor(v, 16); v += __shfl_xor(v, 32); acc[s][j] = v; }
            if (F.lane < 16) {
#pragma unroll
                for (int s = 0; s < 17; ++s) *(LAS f32x4*)(red + (F.wave * 17 + s) * 64 + c4 * 4) = acc[s];
            }
            __syncthreads();
            for (int i = F.tid; i < 17 * 64; i += NTHR) { const int s = i >> 6, c = i & 63; float v = a.in[I_MODB][l * 6144 + col0 + c];
#pragma unroll
                for (int w = 0; w < 8; ++w) v += red[(w * 17 + s) * 64 + c];
                ((float*)(F.ws + WS_MODS))[((size_t)l * 17 + s) * 6144 + col0 + c] = v; }
            __syncthreads();
        }
    }
}

constexpr int MW_DOWN = NEXP * 1408, MW_ITEMS = MW_DOWN + NEXP * 2816;
constexpr float MOE_SW = 64.f, MOE_SA = 8.f, MOE_SH = 8.f;
__device__ __forceinline__ void phase_moe_weights(const Frame& F, const Args& a, int lo, int hi, int first) {
    if (F.bid < first) return;
    LAS float* scr = (LAS float*)(F.lds + F.wave * 8704);
    const int gw = (F.bid - first) * NWAVES + F.wave, NGW = (F.G - first) * NWAVES;
    unsigned char* Wgu = F.ws + WS_WMGU; unsigned char* Wd = F.ws + WS_WMD;
    for (int it = lo + gw; it < hi; it += NGW) {
        if (it < MW_DOWN) { const int e = it / 1408, r = it % 1408; tr_plain_item8(a.in[I_MD] + (size_t)e * FF * D, FF, D, Wd + (size_t)e * D * FF, r, MOE_SW, scr, F.lane); }
        else { const int i2 = it - MW_DOWN, e = NEXP - 1 - i2 / 2816, r = i2 % 2816; tr_gu_item8(a.in[I_MG] + (size_t)e * D * FF, a.in[I_MU2] + (size_t)e * D * FF, Wgu + (size_t)e * FF2 * D, r, MOE_SW, scr, F.lane); }
    }
}

__device__ __forceinline__ void load_row(const float* p, int lane, f32x4 (&v)[4]) {
#pragma unroll
    for (int j = 0; j < 4; ++j) v[j] = *(const f32x4*)(p + 256 * j + 4 * lane);
}
__device__ __forceinline__ void norm_mod(f32x4 (&v)[4], const float* gain, const float* shift, const float* scale, int lane) {
    float ss = 0.f;
#pragma unroll
    for (int j = 0; j < 4; ++j) ss += (v[j][0] * v[j][0] + v[j][1] * v[j][1]) + (v[j][2] * v[j][2] + v[j][3] * v[j][3]);
    const float r = __builtin_amdgcn_rsqf(wave_sum(ss) * (1.f / D) + NORM_EPS);
#pragma unroll
    for (int j = 0; j < 4; ++j) { const int c = 256 * j + 4 * lane; const f32x4 g = *(const f32x4*)(gain + c), sh = *(const f32x4*)(shift + c), sc = *(const f32x4*)(scale + c);
        v[j] = v[j] * r * g * (sc + 1.f) + sh; }
}
__device__ __forceinline__ void store_row_bf16(bf16* p, int lane, const f32x4 (&v)[4]) {
#pragma unroll
    for (int j = 0; j < 4; ++j) { v2u o; o.x = pk2(v[j][0], v[j][1]); o.y = pk2(v[j][2], v[j][3]); *(v2u*)(p + 256 * j + 4 * lane) = o; }
}
__device__ __forceinline__ void load_row16(const bf16* p, int lane, f32x4 (&v)[4]) {
#pragma unroll
    for (int j = 0; j < 4; ++j) { const v2u u = *(const v2u*)(p + 256 * j + 4 * lane); v[j] = (f32x4){bflo(u.x), bfhi(u.x), bflo(u.y), bfhi(u.y)}; }
}
__device__ __forceinline__ void store_row_i8(unsigned char* p, float* sa, int lane, const f32x4 (&v)[4]) {
    float m = 0.f;
#pragma unroll
    for (int j = 0; j < 4; ++j) m = fmaxf(fmaxf(m, fmaxf(fabsf(v[j][0]), fabsf(v[j][1]))), fmaxf(fabsf(v[j][2]), fabsf(v[j][3])));
#pragma unroll
    for (int o = 1; o < 64; o <<= 1) m = fmaxf(m, __shfl_xor(m, o));
    const float s = m > 0.f ? 127.f / m : 0.f;
#pragma unroll
    for (int j = 0; j < 4; ++j) *(unsigned*)(p + 256 * j + 4 * lane) = pk4_i8(v[j][0] * s, v[j][1] * s, v[j][2] * s, v[j][3] * s);
    if (lane == 0) *sa = m * (1.f / 127.f);
}
template <bool X16, bool O8 = false>
__device__ __forceinline__ void phase_norm_rows(const Frame& F, const void* xl, const void* xc, const float* gain, const float* modsL, int sh, bf16* out, int nrows, float* sA = nullptr) {
    const int gw = F.bid * NWAVES + F.wave, NGW = F.G * NWAVES;
    for (int m = 2 * gw; m < nrows; m += 2 * NGW) {
        const bool lat = m < NL; const int s = lat ? m / T : NB; const size_t ro = lat ? (size_t)m * D : (size_t)(m - NL) * D;
        f32x4 v[4], w[4];
        if constexpr (X16) { const bf16* xr = (const bf16*)(lat ? xl : xc) + ro; load_row16(xr, F.lane, v); load_row16(xr + D, F.lane, w); }
        else { const float* xr = (const float*)(lat ? xl : xc) + ro; load_row(xr, F.lane, v); load_row(xr + D, F.lane, w); }
        const float* shp = modsL + (size_t)s * 6144 + sh * 1024;
        norm_mod(v, gain, shp, shp + 1024, F.lane); norm_mod(w, gain, shp, shp + 1024, F.lane);
        if constexpr (O8) { store_row_i8((unsigned char*)out + (size_t)m * D, sA + m, F.lane, v); store_row_i8((unsigned char*)out + (size_t)(m + 1) * D, sA + m + 1, F.lane, w); }
        else { store_row_bf16(out + (size_t)m * D, F.lane, v); store_row_bf16(out + (size_t)(m + 1) * D, F.lane, w); }
    }
}

__device__ __forceinline__ void phase_rwkv_feat(const Frame& F, const Args& a) {
    const bf16* P = (const bf16*)((unsigned char*)F.out + DO_PRW);
    bf16* R = (bf16*)(F.ws + WS_R); bf16* KS = (bf16*)(F.ws + WS_KS); bf16* V = (bf16*)(F.ws + WS_V); bf16* KK = (bf16*)(F.ws + WS_KK); bf16* LB = (bf16*)(F.ws + WS_LB);
    const float* mu = a.in[I_MU]; const float* k_k = a.in[I_KK];
    const int gw = F.bid * NWAVES + F.wave, NGW = F.G * NWAVES, lane = F.lane;
    const int RPW = (NT + NGW - 1) / NGW, m0 = gw * RPW, m1 = m0 + RPW < NT ? m0 + RPW : NT;
    v2u rp[7], rc[7], rn[7];
#pragma unroll
    for (int j = 0; j < 7; ++j) { rp[j] = (v2u){0u, 0u}; rc[j] = (v2u){0u, 0u}; }
    if (m0 < m1) {
#pragma unroll
        for (int j = 0; j < 7; ++j) { rc[j] = *(const v2u*)(P + (size_t)m0 * RW + 4 * lane + 256 * j); if (m0 > 0) rp[j] = *(const v2u*)(P + (size_t)(m0 - 1) * RW + 4 * lane + 256 * j); } }
    for (int m = m0; m < m1; ++m) {
        const bool lat = m < NL; const int t = lat ? (m & (T - 1)) : ((m - NL) & (CT - 1)); const int tl = lat ? T : CT;
        const bool hp = t > 0, hn = t < tl - 1;
#pragma unroll
        for (int j = 0; j < 7; ++j) { rn[j] = (v2u){0u, 0u}; if (m + 1 < NT) rn[j] = *(const v2u*)(P + (size_t)(m + 1) * RW + 4 * lane + 256 * j); }
        f32x4 x[7];
#pragma unroll
        for (int j = 0; j < 7; ++j) { const v2u c = rc[j]; v2u p = rp[j], n = rn[j];
            if (!hp) p = (v2u){0u, 0u}; if (!hn) n = (v2u){0u, 0u};
            const f32x4 cv = {bflo(c.x), bfhi(c.x), bflo(c.y), bfhi(c.y)}, pv = {bflo(p.x), bfhi(p.x), bflo(p.y), bfhi(p.y)}, nv = {bflo(n.x), bfhi(n.x), bflo(n.y), bfhi(n.y)};
            const f32x4 mv = *(const f32x4*)(mu + 256 * j + 4 * lane);
            x[j] = cv + mv * ((pv + nv) * 0.5f - cv); rp[j] = rc[j]; rc[j] = rn[j]; }
#pragma unroll
        for (int jj = 0; jj < 2; ++jj) { const int c = 256 * jj + 4 * lane;
            v2u o; o.x = pk2(x[jj][0], x[jj][1]); o.y = pk2(x[jj][2], x[jj][3]); *(v2u*)(R + (size_t)m * AW + c) = o;
            o.x = pk2(x[2 + jj][0], x[2 + jj][1]); o.y = pk2(x[2 + jj][2], x[2 + jj][3]); *(v2u*)(KS + (size_t)m * AW + c) = o;
            o.x = pk2(x[4 + jj][0], x[4 + jj][1]); o.y = pk2(x[4 + jj][2], x[4 + jj][3]); *(v2u*)(V + (size_t)m * AW + c) = o;
            f32x4 kk = x[2 + jj] * *(const f32x4*)(k_k + c);
            const float ss = sum16((kk[0] * kk[0] + kk[1] * kk[1]) + (kk[2] * kk[2] + kk[3] * kk[3]));
            const float inv = 1.f / fmaxf(sqrtf(ss), 1e-12f);
            kk = kk * inv; o.x = pk2(kk[0], kk[1]); o.y = pk2(kk[2], kk[3]); *(v2u*)(KK + (size_t)m * AW + c) = o; }
        { f32x4 y = x[6];
#pragma unroll
          for (int i = 0; i < 4; ++i) { const float th = ftanh(y[i]), sg = fsigmoid(y[i]); y[i] = lane < 16 ? th : (lane < 32 ? y[i] : sg); }
          v2u o; o.x = pk2(y[0], y[1]); o.y = pk2(y[2], y[3]); *(v2u*)(LB + (size_t)m * 256 + 4 * lane) = o; }
    }
}

__device__ __forceinline__ void unpack8(const v4u& w, float (&f)[8]) { f[0] = bflo(w.x); f[1] = bfhi(w.x); f[2] = bflo(w.y); f[3] = bfhi(w.y); f[4] = bflo(w.z); f[5] = bfhi(w.z); f[6] = bflo(w.w); f[7] = bfhi(w.w); }
__device__ __forceinline__ v4u pack8f(const float (&f)[8]) { v4u w; w.x = pk2(f[0], f[1]); w.y = pk2(f[2], f[3]); w.z = pk2(f[4], f[5]); w.w = pk2(f[6], f[7]); return w; }
__device__ __forceinline__ void phase_rwkv_post(const Frame& F, const Args& a) {
    const bf16* OF = (const bf16*)(F.ws + WS_OF); const bf16* OB = (const bf16*)(F.ws + WS_OB); const bf16* R = (const bf16*)(F.ws + WS_R); const bf16* KS = (const bf16*)(F.ws + WS_KS);
    const bf16* V = (const bf16*)(F.ws + WS_V); const bf16* GG = (const bf16*)((unsigned char*)F.out + DO_GG); bf16* Y = (bf16*)(F.ws + WS_YMIX);
    const int gw = F.bid * NWAVES + F.wave, NGW = F.G * NWAVES, lane = F.lane, c = 8 * lane;
    float rk[8], lw[8], lb[8];
#pragma unroll
    for (int i = 0; i < 8; ++i) { rk[i] = a.in[I_RK][c + i]; lw[i] = a.in[I_LNW][c + i]; lb[i] = a.in[I_LNB][c + i]; }
    for (int m = gw; m < NT; m += NGW) { const size_t off = (size_t)m * AW + c;
        float of[8], ob[8], r[8], k[8], v[8], g[8];
        unpack8(*(const v4u*)(OF + off), of); unpack8(*(const v4u*)(OB + off), ob); unpack8(*(const v4u*)(R + off), r); unpack8(*(const v4u*)(KS + off), k);
        unpack8(*(const v4u*)(V + off), v); unpack8(*(const v4u*)(GG + off), g);
        float s = 0.f, bs = 0.f;
#pragma unroll
        for (int i = 0; i < 8; ++i) { of[i] += ob[i]; s += of[i]; bs += r[i] * k[i] * rk[i]; }
        const float mean = sum8(s) * (1.f / 64.f); bs = sum8(bs);
        float q = 0.f;
#pragma unroll
        for (int i = 0; i < 8; ++i) { of[i] -= mean; q += of[i] * of[i]; }
        const float rstd = __builtin_amdgcn_rsqf(sum8(q) * (1.f / 64.f) + GN_EPS);
        float y[8];
#pragma unroll
        for (int i = 0; i < 8; ++i) y[i] = (of[i] * rstd * lw[i] + lb[i] + bs * v[i]) * g[i];
        *(v4u*)(Y + (size_t)m * D + c) = pack8f(y);
    }
}
__device__ __forceinline__ void phase_hgrn_post(const Frame& F, const Args& a) {
    const bf16* OF = (const bf16*)((unsigned char*)F.out + DO_OHF); const bf16* OB = (const bf16*)((unsigned char*)F.out + DO_OHB); const bf16* PH = (const bf16*)(F.ws + WS_PHG); bf16* Y = (bf16*)(F.ws + WS_YMIX);
    const int gw = F.bid * NWAVES + F.wave, NGW = F.G * NWAVES, lane = F.lane, c = 8 * lane;
    float gn[8];
#pragma unroll
    for (int i = 0; i < 8; ++i) gn[i] = a.in[I_HNORM][(c & 127) + i];
    for (int m = gw; m < NT; m += NGW) { const size_t off = (size_t)m * AW + c;
        float of[8], ob[8], gt[8];
        unpack8(*(const v4u*)(OF + off), of); unpack8(*(const v4u*)(OB + off), ob); unpack8(*(const v4u*)(PH + (size_t)m * HG + 2048 + c), gt);
        float q = 0.f;
#pragma unroll
        for (int i = 0; i < 8; ++i) { of[i] += ob[i]; q += of[i] * of[i]; }
        const float rstd = __builtin_amdgcn_rsqf(sum16(q) * (1.f / 128.f) + NORM_EPS);
        float y[8];
#pragma unroll
        for (int i = 0; i < 8; ++i) y[i] = of[i] * rstd * gn[i] * fsilu(gt[i]);
        *(v4u*)(Y + (size_t)m * D + AW + c) = pack8f(y);
    }
}

constexpr int SC_CH = 32;
__device__ __forceinline__ int scan_row(int b, int dir, int c, int s) {
    if (c < CT / SC_CH) { const int tt = c * SC_CH + s; return NL + b * CT + (dir ? CT - 1 - tt : tt); }
    const int tt = (c - CT / SC_CH) * SC_CH + s; return b * T + (dir ? T - 1 - tt : tt);
}
__device__ __forceinline__ f32x4 bf4(const v2u& w) { return (f32x4){bflo(w.x), bfhi(w.x), bflo(w.y), bfhi(w.y)}; }
__device__ __forceinline__ void phase_rwkv_scan(const Frame& F) {
    const bf16* R = (const bf16*)(F.ws + WS_R); const bf16* KS = (const bf16*)(F.ws + WS_KS); const bf16* V = (const bf16*)(F.ws + WS_V); const bf16* KK = (const bf16*)(F.ws + WS_KK);
    const bf16* BB = (const bf16*)(F.ws + WS_BB);
    LAS float* inb = (LAS float*)F.lds;
    LAS float* outb = (LAS float*)(F.lds + 98304);
    constexpr int NCH = (CT + T) / SC_CH, ASZ = SC_CH * 64, BSZ = 6 * ASZ;
    const int tid = F.tid, rp = F.lane >> 4, kq = F.lane & 15, rowp = F.wave * 8 + 2 * rp, ls = tid >> 4, lc = (tid & 15) * 4;
    for (int task = F.bid; task < NB * 8 * 2; task += F.G) {
        const int b = task >> 4, h = (task >> 1) & 7, dir = task & 1;
        const bf16* LW = (const bf16*)((unsigned char*)F.out + (dir ? DO_LWB : DO_LWF)); bf16* O = (bf16*)(F.ws + (dir ? WS_OB : WS_OF));
        f32x4 Sa = {0.f, 0.f, 0.f, 0.f}, Sb = {0.f, 0.f, 0.f, 0.f};
        v2u g0, g1, g2, g3, g4, g5;
#define RW_LOAD(c) do { const size_t o_ = (size_t)scan_row(b, dir, (c), ls) * AW + h * 64 + lc; \
        g0 = *(const v2u*)(KK + o_); g1 = *(const v2u*)(LW + o_); g2 = *(const v2u*)(BB + o_); g3 = *(const v2u*)(KS + o_); g4 = *(const v2u*)(R + o_); g5 = *(const v2u*)(V + o_); } while (0)
#define RW_STORE(buf) do { LAS float* d_ = inb + (buf) * BSZ + ls * 64 + lc; f32x4 w_ = bf4(g1); w_[0] = __expf(w_[0]); w_[1] = __expf(w_[1]); w_[2] = __expf(w_[2]); w_[3] = __expf(w_[3]); \
        *(LAS f32x4*)(d_) = bf4(g0); *(LAS f32x4*)(d_ + ASZ) = w_; *(LAS f32x4*)(d_ + 2 * ASZ) = bf4(g2); *(LAS f32x4*)(d_ + 3 * ASZ) = bf4(g3); *(LAS f32x4*)(d_ + 4 * ASZ) = bf4(g4); *(LAS f32x4*)(d_ + 5 * ASZ) = bf4(g5); } while (0)
        RW_LOAD(0); RW_STORE(0);
        __syncthreads();
        for (int c = 0; c < NCH; ++c) {
            const int buf = c & 1;
            if (c + 1 < NCH) RW_LOAD(c + 1);
            const LAS float* ib = inb + buf * BSZ + 4 * kq; const LAS float* vb = inb + buf * BSZ + 5 * ASZ + rowp;
            for (int s16 = 0; s16 < SC_CH / 16; ++s16) {
                float oa = 0.f, ob2 = 0.f;
#pragma unroll
                for (int j = 0; j < 16; ++j) {
                    const LAS float* p = ib + (s16 * 16 + j) * 64;
                    const f32x4 kk = *(const LAS f32x4*)(p), w = *(const LAS f32x4*)(p + ASZ), bb = *(const LAS f32x4*)(p + 2 * ASZ), k = *(const LAS f32x4*)(p + 3 * ASZ), r = *(const LAS f32x4*)(p + 4 * ASZ);
                    const f32x2 vv = *(const LAS f32x2*)(vb + (s16 * 16 + j) * 64);
                    float sa = (Sa[0] * kk[0] + Sa[1] * kk[1]) + (Sa[2] * kk[2] + Sa[3] * kk[3]), sb = (Sb[0] * kk[0] + Sb[1] * kk[1]) + (Sb[2] * kk[2] + Sb[3] * kk[3]);
                    sa = sum16(sa); sb = sum16(sb);
                    Sa = Sa * w + (k * vv[0] - bb * sa); Sb = Sb * w + (k * vv[1] - bb * sb);
                    float o0 = (Sa[0] * r[0] + Sa[1] * r[1]) + (Sa[2] * r[2] + Sa[3] * r[3]), o1 = (Sb[0] * r[0] + Sb[1] * r[1]) + (Sb[2] * r[2] + Sb[3] * r[3]);
                    o0 = sum16(o0); o1 = sum16(o1);
                    oa = (kq == j) ? o0 : oa; ob2 = (kq == j) ? o1 : ob2;
                }
                *(LAS f32x2*)(outb + buf * ASZ + (s16 * 16 + kq) * 64 + rowp) = (f32x2){oa, ob2};
            }
            if (c + 1 < NCH) RW_STORE(buf ^ 1);
            __syncthreads();
            { const LAS float* q = outb + buf * ASZ + ls * 64 + lc; const f32x4 v = *(const LAS f32x4*)q; v2u w; w.x = pk2(v[0], v[1]); w.y = pk2(v[2], v[3]);
              *(v2u*)(O + (size_t)scan_row(b, dir, c, ls) * AW + h * 64 + lc) = w; }
        }
        __syncthreads();
#undef RW_LOAD
#undef RW_STORE
    }
}

__device__ __forceinline__ void phase_hgrn_scan(const Frame& F, const Args& a) {
    const bf16* PH = (const bf16*)(F.ws + WS_PHG);
    LAS float* inb = (LAS float*)F.lds;
    LAS float* outb = (LAS float*)(F.lds + 81920);
    constexpr int NCH = (CT + T) / SC_CH, FSZ = SC_CH * 128, BSZ = 2 * FSZ + SC_CH * 64, OSZ = SC_CH * 64;
    const int tid = F.tid, vc = tid >> 3, ks = tid & 7, ls = tid >> 4, l16 = tid & 15;
    for (int task = F.bid; task < NB * 4 * 2 * 2; task += F.G) {
        const int b = task >> 4, h = (task >> 2) & 3, dir = (task >> 1) & 1, half = task & 1;
        bf16* O = (bf16*)((unsigned char*)F.out + (dir ? DO_OHB : DO_OHF));
        float lbv[8];
#pragma unroll
        for (int i = 0; i < 8; ++i) { const int cidx = h * 128 + l16 * 8 + i; lbv[i] = fsigmoid(a.in[I_HLB][(dir * 2 + 0) * AW + cidx] - a.in[I_HLB][(dir * 2 + 1) * AW + cidx]); }
        float S[16];
#pragma unroll
        for (int i = 0; i < 16; ++i) S[i] = 0.f;
        v4u gq, gf; v2u gv;
#define HG_LOAD(c) do { const size_t o_ = (size_t)scan_row(b, dir, (c), ls) * HG + h * 128; \
        gq = *(const v4u*)(PH + o_ + l16 * 8); gf = *(const v4u*)(PH + o_ + 1024 + dir * AW + l16 * 8); gv = *(const v2u*)(PH + o_ + AW + half * 64 + l16 * 4); } while (0)
#define HG_STORE(buf) do { LAS float* d_ = inb + (buf) * BSZ + ls * 128 + l16 * 8; float q_[8], f_[8]; unpack8(gq, q_); unpack8(gf, f_); \
        _Pragma("unroll") for (int i = 0; i < 8; ++i) { q_[i] = fsilu(q_[i]); f_[i] = lbv[i] + (1.f - lbv[i]) * fsigmoid(f_[i]); } \
        *(LAS f32x4*)(d_) = (f32x4){f_[0], f_[1], f_[2], f_[3]}; *(LAS f32x4*)(d_ + 4) = (f32x4){f_[4], f_[5], f_[6], f_[7]}; \
        *(LAS f32x4*)(d_ + FSZ) = (f32x4){q_[0], q_[1], q_[2], q_[3]}; *(LAS f32x4*)(d_ + FSZ + 4) = (f32x4){q_[4], q_[5], q_[6], q_[7]}; \
        *(LAS f32x4*)(inb + (buf) * BSZ + 2 * FSZ + ls * 64 + l16 * 4) = bf4(gv); } while (0)
        HG_LOAD(0); HG_STORE(0);
        __syncthreads();
        for (int c = 0; c < NCH; ++c) {
            const int buf = c & 1;
            if (c + 1 < NCH) HG_LOAD(c + 1);
            const LAS float* ib = inb + buf * BSZ + 16 * ks; LAS float* ob = outb + buf * OSZ + vc;
#pragma unroll 2
            for (int s = 0; s < SC_CH; ++s) {
                const LAS float* p = ib + s * 128;
                const float vv = inb[buf * BSZ + 2 * FSZ + s * 64 + vc];
                float o0 = 0.f, o1 = 0.f;
#pragma unroll
                for (int j = 0; j < 4; ++j) { const f32x4 f = *(const LAS f32x4*)(p + 4 * j), q = *(const LAS f32x4*)(p + FSZ + 4 * j);
#pragma unroll
                    for (int i = 0; i < 4; ++i) { const float t = vv - f[i] * vv; S[4 * j + i] = S[4 * j + i] * f[i] + t; if (i & 1) o1 += q[i] * S[4 * j + i]; else o0 += q[i] * S[4 * j + i]; } }
                float o = sum8(o0 + o1);
                if (ks == 0) ob[s * 64] = o;
            }
            if (c + 1 < NCH) HG_STORE(buf ^ 1);
            __syncthreads();
            { const int fc = l16 * 4; const f32x4 v = *(const LAS f32x4*)(outb + buf * OSZ + ls * 64 + fc); v2u w; w.x = pk2(v[0], v[1]); w.y = pk2(v[2], v[3]);
              *(v2u*)(O + (size_t)scan_row(b, dir, c, ls) * AW + h * 128 + half * 64 + fc) = w; }
        }
        __syncthreads();
#undef HG_LOAD
#undef HG_STORE
    }
}

__device__ __forceinline__ int crow(int r, int hi) { return (r & 3) + 8 * (r >> 2) + 4 * hi; }
typedef short v4i16_t __attribute__((ext_vector_type(4)));
__device__ __forceinline__ s16x4 vtr(LAS const unsigned char* p) { return __builtin_bit_cast(s16x4, __builtin_amdgcn_ds_read_tr16_b64_v4i16((LAS v4i16_t*)p)); }
__device__ __forceinline__ void phase_attn(const Frame& F, const Args& a) {
    const bf16* QKV = (const bf16*)(F.ws + WS_QKV); bf16* OA = (bf16*)(F.ws + WS_OATT);
    constexpr int KPITCH = 144, KBYTES = 64 * KPITCH, VBYTES = 8192;
    constexpr int L_K = 0, L_V = 2 * KBYTES, L_WS = L_V + 2 * VBYTES, L_OST = L_WS + NWAVES * 256;
    const int tid = F.tid, lane = F.lane, wid = F.wave, r32 = lane & 31, hi = lane >> 5, g = wid >> 1, half = wid & 1;
    const int lkey = tid >> 3, lch = tid & 7;
    LAS float* wsf = (LAS float*)(F.lds + L_WS) + wid * 64;
    LAS bf16* stg = (LAS bf16*)(F.lds + L_OST + wid * 4096);
    const int kst = lkey * KPITCH + lch * 16, vst = ((lch >> 2) * 4 + (lkey >> 4)) * 1024 + (lkey & 15) * 64 + (lch & 3) * 16;
    const int vrd = ((lane >> 4) & 1) * 32 + (lane & 3) * 8 + (4 * hi + ((lane & 15) >> 2)) * 64;
    const int per = (NB * 4 * 32 + F.G - 1) / F.G;
    for (int ui = 0; ui < per; ++ui) {
        const int u = F.bid * per + ui; if (u >= NB * 4 * 32) break;
        const int b = u >> 7, kvh = (u >> 5) & 3, qb = u & 31, q0 = qb * 64, head = kvh * 4 + g;
        const int bt_lo = q0 >= 128 ? 0 : (128 - q0) / 64, bt_hi = (T + 64 - q0) / 64 > 4 ? 4 : (T + 64 - q0) / 64, nt = 4 + (bt_hi - bt_lo + 1);
        bf16x8 qr[4];
        { const bf16* qp = QKV + (size_t)(b * T + q0 + half * 32 + r32) * QKVW + head * 64 + hi * 8;
#pragma unroll
          for (int d0 = 0; d0 < 4; ++d0) qr[d0] = *(const bf16x8*)(qp + d0 * 16); }
        float m = a.in[I_SINK][head] * LOG2E, l = hi ? 0.f : 1.f;
        f32x16 o0, o1;
#pragma unroll
        for (int i = 0; i < 16; ++i) { o0[i] = 0.f; o1[i] = 0.f; }
        v4u kreg, vreg;
#define AT_ROWBASE(t) ((t) < 4 ? NL + b * CT + 64 * (t) : b * T + q0 - 128 + 64 * (bt_lo + (t) - 4))
#define AT_LOAD(t) do { const bf16* p_ = QKV + (size_t)(AT_ROWBASE(t) + lkey) * QKVW + 1024 + kvh * 64 + lch * 8; kreg = *(const v4u*)p_; vreg = *(const v4u*)(p_ + 256); } while (0)
        AT_LOAD(0);
        for (int t = 0; t < nt; ++t) {
            const int buf = t & 1;
            *(LAS v4u*)(F.lds + L_K + buf * KBYTES + kst) = kreg; *(LAS v4u*)(F.lds + L_V + buf * VBYTES + vst) = vreg;
            __syncthreads();
            if (t + 1 < nt) AT_LOAD(t + 1);
            const LAS unsigned char* Kb = F.lds + L_K + buf * KBYTES + r32 * KPITCH + hi * 16;
            f32x16 p0, p1;
            { const float nm = -m;
#pragma unroll
              for (int i = 0; i < 16; ++i) { p0[i] = nm; p1[i] = nm; } }
#pragma unroll
            for (int d0 = 0; d0 < 4; ++d0) {
                const bf16x8 ka = *(const LAS bf16x8*)(Kb + d0 * 32), kb2 = *(const LAS bf16x8*)(Kb + 32 * KPITCH + d0 * 32);
                p0 = __builtin_amdgcn_mfma_f32_32x32x16_bf16(ka, qr[d0], p0, 0, 0, 0);
                p1 = __builtin_amdgcn_mfma_f32_32x32x16_bf16(kb2, qr[d0], p1, 0, 0, 0);
            }
            const int bt = t < 4 ? -1 : bt_lo + t - 4; int qi = half * 32 + r32;
            asm volatile("" : "+v"(qi));
            if (bt == 0) {
#pragma unroll
                for (int r = 0; r < 16; ++r) { const int kj = crow(r, hi); if (kj < qi) p0[r] = -1e30f; if (kj + 32 < qi) p1[r] = -1e30f; }
            } else if (bt == 4) {
#pragma unroll
                for (int r = 0; r < 16; ++r) { const int kj = crow(r, hi); if (kj > qi) p0[r] = -1e30f; if (kj + 32 > qi) p1[r] = -1e30f; }
            }
            float tm = __builtin_fmaxf(__builtin_fmaxf(p0[0], p1[0]), p0[1]);
#pragma unroll
            for (int r = 1; r < 16; ++r) tm = __builtin_fmaxf(__builtin_fmaxf(tm, p1[r]), r + 1 < 16 ? p0[r + 1] : p1[r]);
            { auto rr = __builtin_amdgcn_permlane32_swap(__float_as_uint(tm), __float_as_uint(tm), false, false); tm = fmaxf(__uint_as_float(rr[0]), __uint_as_float(rr[1])); }
            if (__any(tm > 8.f)) {
                const float dl = tm > 8.f ? tm : 0.f, alpha = __builtin_amdgcn_exp2f(-dl);
                m += dl; l *= alpha;
#pragma unroll
                for (int r = 0; r < 16; ++r) { p0[r] -= dl; p1[r] -= dl; }
                if (hi == 0) wsf[r32] = alpha;
                LDS_WAIT();
#pragma unroll
                for (int r = 0; r < 16; ++r) { const float al = wsf[crow(r, hi)]; o0[r] *= al; o1[r] *= al; }
            }
            float ls = 0.f;
#pragma unroll
            for (int r = 0; r < 16; ++r) { p0[r] = __builtin_amdgcn_exp2f(p0[r]); p1[r] = __builtin_amdgcn_exp2f(p1[r]); ls += p0[r] + p1[r]; }
            l += ls;
            bf16x8 pk[4];
#pragma unroll
            for (int s = 0; s < 2; ++s) {
                v4u w0, w1;
                w0.x = pk2(p0[8 * s], p0[8 * s + 1]); w0.y = pk2(p0[8 * s + 2], p0[8 * s + 3]); w0.z = pk2(p0[8 * s + 4], p0[8 * s + 5]); w0.w = pk2(p0[8 * s + 6], p0[8 * s + 7]);
                w1.x = pk2(p1[8 * s], p1[8 * s + 1]); w1.y = pk2(p1[8 * s + 2], p1[8 * s + 3]); w1.z = pk2(p1[8 * s + 4], p1[8 * s + 5]); w1.w = pk2(p1[8 * s + 6], p1[8 * s + 7]);
                pk[s] = __builtin_bit_cast(bf16x8, w0); pk[2 + s] = __builtin_bit_cast(bf16x8, w1);
            }
            const LAS unsigned char* Vb = F.lds + L_V + buf * VBYTES + vrd;
#pragma unroll
            for (int k4 = 0; k4 < 4; ++k4) {
                const s16x4 lo0 = vtr(Vb + k4 * 1024), hi0 = vtr(Vb + k4 * 1024 + 512), lo1 = vtr(Vb + 4096 + k4 * 1024), hi1 = vtr(Vb + 4096 + k4 * 1024 + 512);
                const bf16x8 v0 = {lo0[0], lo0[1], lo0[2], lo0[3], hi0[0], hi0[1], hi0[2], hi0[3]}, v1 = {lo1[0], lo1[1], lo1[2], lo1[3], hi1[0], hi1[1], hi1[2], hi1[3]};
                o0 = __builtin_amdgcn_mfma_f32_32x32x16_bf16(pk[k4], v0, o0, 0, 0, 0);
                o1 = __builtin_amdgcn_mfma_f32_32x32x16_bf16(pk[k4], v1, o1, 0, 0, 0);
            }
        }
        l += __shfl_xor(l, 32);
        if (hi == 0) wsf[32 + r32] = 1.f / l;
        LDS_WAIT();
#pragma unroll
        for (int r = 0; r < 16; ++r) { const int orow = crow(r, hi); const float li = wsf[32 + orow];
            stg[orow * 64 + r32] = (bf16)(pk2(o0[r] * li, 0.f) & 0xffffu); stg[orow * 64 + 32 + r32] = (bf16)(pk2(o1[r] * li, 0.f) & 0xffffu); }
        LDS_WAIT();
        { bf16* op = OA + (size_t)(b * T + q0 + half * 32) * D + head * 64;
#pragma unroll
          for (int i = 0; i < 4; ++i) { const int rowi = i * 8 + (lane >> 3), ch = lane & 7; *(v4u*)(op + (size_t)rowi * D + ch * 8) = *(const LAS v4u*)(stg + rowi * 64 + ch * 8); } }
        __syncthreads();
#undef AT_ROWBASE
#undef AT_LOAD
    }
}


constexpr int HC_L = 64, HC_PQ = 272  , HC_PK = 144  ;
constexpr int HC_QT = 0, HC_KT = 17408, HC_QG = 34816, HC_KH = 52224, HC_VV = 70656, HC_SB = 78848, HC_SEG = 111616, HC_DEC = 113664, HC_OST = 114176, HC_END = 122368;
static_assert(HC_END <= RING_BYTES, "hgrn chunk LDS");
__device__ __forceinline__ int hc_row(int b, int dir, int c, int s) {
    if (c < CT / HC_L) { const int tt = c * HC_L + s; return NL + b * CT + (dir ? CT - 1 - tt : tt); }
    const int tt = (c - CT / HC_L) * HC_L + s; return b * T + (dir ? T - 1 - tt : tt);
}
__device__ __forceinline__ bf16x8 cat4(const s16x4 lo, const s16x4 hi) { return (bf16x8){lo[0], lo[1], lo[2], lo[3], hi[0], hi[1], hi[2], hi[3]}; }
__device__ __forceinline__ void phase_hgrn_chunk(const Frame& F, const Args& a) {
    const bf16* PH = (const bf16*)(F.ws + WS_PHG);
    constexpr int NCH = (CT + T) / HC_L;
    const int tid = F.tid, lane = F.lane, wid = F.wave, r32 = lane & 31, hi = lane >> 5;
    const int col = tid & 127, seg = tid >> 7;
    LAS unsigned char* L = F.lds;
    const int vrd = ((lane >> 4) & 1) * 32 + (lane & 3) * 8 + (4 * hi + ((lane & 15) >> 2)) * 64;
    for (int task = F.bid; task < NB * 4 * 2 * 2; task += F.G) {
        const int b = task >> 4, h = (task >> 2) & 3, dir = (task >> 1) & 1, half = task & 1;
        bf16* O = (bf16*)((unsigned char*)F.out + (dir ? DO_OHB : DO_OHF));
        const float lb = fsigmoid(a.in[I_HLB][(dir * 2 + 0) * AW + h * 128 + col] - a.in[I_HLB][(dir * 2 + 1) * AW + h * 128 + col]);
        f32x16 S0, S1;
#pragma unroll
        for (int i = 0; i < 16; ++i) { S0[i] = 0.f; S1[i] = 0.f; }
        for (int i = tid; i < 16384 / 16; i += NTHR) *(LAS v4u*)(L + HC_SB + i * 16) = (v4u){0u, 0u, 0u, 0u};
        v4u gq0, gq1, gf0, gf1, gv;
        const int qrow0 = tid >> 4, qc8 = tid & 15, vrow = tid >> 3, vc8 = tid & 7;
#define HC_LOAD(c) do { const size_t r0_ = (size_t)hc_row(b, dir, (c), qrow0) * HG + h * 128 + qc8 * 8, r1_ = (size_t)hc_row(b, dir, (c), qrow0 + 32) * HG + h * 128 + qc8 * 8; \
        gq0 = *(const v4u*)(PH + r0_); gq1 = *(const v4u*)(PH + r1_); gf0 = *(const v4u*)(PH + r0_ + 1024 + dir * AW); gf1 = *(const v4u*)(PH + r1_ + 1024 + dir * AW); \
        gv = *(const v4u*)(PH + (size_t)hc_row(b, dir, (c), vrow) * HG + AW + h * 128 + half * 64 + vc8 * 8); } while (0)
        HC_LOAD(0);
        __syncthreads();
        for (int c = 0; c < NCH; ++c) {
            const int sbuf = c & 1;
            *(LAS v4u*)(L + HC_QT + qrow0 * HC_PQ + qc8 * 16) = gq0; *(LAS v4u*)(L + HC_QT + (qrow0 + 32) * HC_PQ + qc8 * 16) = gq1;
            *(LAS v4u*)(L + HC_KT + qrow0 * HC_PQ + qc8 * 16) = gf0; *(LAS v4u*)(L + HC_KT + (qrow0 + 32) * HC_PQ + qc8 * 16) = gf1;
            *(LAS v4u*)(L + HC_VV + ((vc8 >> 2) * 4 + (vrow >> 4)) * 1024 + (vrow & 15) * 64 + (vc8 & 3) * 16) = gv;
            __syncthreads();
            if (c + 1 < NCH) HC_LOAD(c + 1);
            float Pl[16], kk[16], qv[16];
            { float run = 1.f;
#pragma unroll
              for (int i = 0; i < 16; ++i) { const int t = seg * 16 + i;
                  const float fr = __uint_as_float((unsigned)*(const LAS unsigned short*)(L + HC_KT + t * HC_PQ + col * 2) << 16), qr = __uint_as_float((unsigned)*(const LAS unsigned short*)(L + HC_QT + t * HC_PQ + col * 2) << 16);
                  const float f = lb + (1.f - lb) * fsigmoid(fr); run *= f; Pl[i] = run; kk[i] = 1.f - f; qv[i] = fsilu(qr); }
              *(LAS float*)(L + HC_SEG + (seg * 128 + col) * 4) = run; }
            __syncthreads();
            { const float s0 = *(const LAS float*)(L + HC_SEG + col * 4), s1 = *(const LAS float*)(L + HC_SEG + (128 + col) * 4), s2 = *(const LAS float*)(L + HC_SEG + (256 + col) * 4), s3 = *(const LAS float*)(L + HC_SEG + (384 + col) * 4);
              const float off = seg == 0 ? 1.f : (seg == 1 ? s0 : (seg == 2 ? s0 * s1 : s0 * s1 * s2)), pref = s0 * s1, pend = pref * s2 * s3;
              const float iref = __builtin_amdgcn_rcpf(pref), egref = pref, eend = s2 * s3, offr = off * iref;
              unsigned khw[8];
#pragma unroll
              for (int i = 0; i < 16; ++i) { const int t = seg * 16 + i; const float e = Pl[i] * offr, ri = __builtin_amdgcn_rcpf(e);
                  const float qt = qv[i] * e, kt = kk[i] * ri, qg = qt * egref, kh = kt * eend;
                  *(LAS unsigned short*)(L + HC_QT + t * HC_PQ + col * 2) = (unsigned short)(pk2(qt, 0.f) & 0xffffu);
                  *(LAS unsigned short*)(L + HC_KT + t * HC_PQ + col * 2) = (unsigned short)(pk2(kt, 0.f) & 0xffffu);
                  *(LAS unsigned short*)(L + HC_QG + t * HC_PQ + col * 2) = (unsigned short)(pk2(qg, 0.f) & 0xffffu);
                  if (i & 1) khw[i >> 1] = (khw[i >> 1] & 0xffffu) | (pk2(kh, 0.f) << 16); else khw[i >> 1] = pk2(kh, 0.f) & 0xffffu; }
              *(LAS v4u*)(L + HC_KH + col * HC_PK + seg * 32) = (v4u){khw[0], khw[1], khw[2], khw[3]}; *(LAS v4u*)(L + HC_KH + col * HC_PK + seg * 32 + 16) = (v4u){khw[4], khw[5], khw[6], khw[7]};
              if (seg == 0) *(LAS float*)(L + HC_DEC + col * 4) = pend; }
            __syncthreads();
            if (wid < 4) {
                const int tb = wid >> 1, vb = wid & 1;
                f32x16 o;
#pragma unroll
                for (int i = 0; i < 16; ++i) o[i] = 0.f;
                const LAS unsigned char* Vb = L + HC_VV + vb * 4096 + vrd;
                const LAS unsigned char* Qb = L + HC_QT + (32 * tb + r32) * HC_PQ + hi * 16;
#pragma unroll
                for (int sb = 0; sb < 2; ++sb) { if (sb <= tb) {
                    f32x16 p;
#pragma unroll
                    for (int i = 0; i < 16; ++i) p[i] = 0.f;
                    const LAS unsigned char* Kb = L + HC_KT + (32 * sb + r32) * HC_PQ + hi * 16;
#pragma unroll
                    for (int d0 = 0; d0 < 8; ++d0) p = __builtin_amdgcn_mfma_f32_32x32x16_bf16(*(const LAS bf16x8*)(Kb + d0 * 32), *(const LAS bf16x8*)(Qb + d0 * 32), p, 0, 0, 0);
                    if (sb == tb) {
#pragma unroll
                        for (int r = 0; r < 16; ++r) if (crow(r, hi) > r32) p[r] = 0.f;
                    }
#pragma unroll
                    for (int s2 = 0; s2 < 2; ++s2) { v4u w; w.x = pk2(p[8 * s2], p[8 * s2 + 1]); w.y = pk2(p[8 * s2 + 2], p[8 * s2 + 3]); w.z = pk2(p[8 * s2 + 4], p[8 * s2 + 5]); w.w = pk2(p[8 * s2 + 6], p[8 * s2 + 7]);
                        const int k4 = 2 * sb + s2;
                        o = __builtin_amdgcn_mfma_f32_32x32x16_bf16(__builtin_bit_cast(bf16x8, w), cat4(vtr(Vb + k4 * 1024), vtr(Vb + k4 * 1024 + 512)), o, 0, 0, 0); }
                } }
                const LAS unsigned char* Gb = L + HC_QG + (32 * tb + r32) * HC_PQ + hi * 8;
                const LAS unsigned char* Sb = L + HC_SB + sbuf * 16384 + vb * 4096 + vrd;
#pragma unroll
                for (int d0 = 0; d0 < 8; ++d0) { const s16x4 alo = *(const LAS s16x4*)(Gb + d0 * 32), ahi = *(const LAS s16x4*)(Gb + d0 * 32 + 16);
                    const LAS unsigned char* sp = Sb + (d0 >> 2) * 8192 + (d0 & 3) * 1024;
                    o = __builtin_amdgcn_mfma_f32_32x32x16_bf16(cat4(alo, ahi), cat4(vtr(sp), vtr(sp + 512)), o, 0, 0, 0); }
                LAS bf16* stg = (LAS bf16*)(L + HC_OST + wid * 2048);
#pragma unroll
                for (int r = 0; r < 16; ++r) stg[crow(r, hi) * 32 + r32] = (bf16)(pk2(o[r], 0.f) & 0xffffu);
                LDS_WAIT();
#pragma unroll
                for (int i = 0; i < 2; ++i) { const int rowi = i * 16 + (lane >> 2), ch = lane & 3;
                    *(v4u*)(O + (size_t)hc_row(b, dir, c, 32 * tb + rowi) * AW + h * 128 + half * 64 + 32 * vb + ch * 8) = *(const LAS v4u*)(stg + rowi * 32 + ch * 8); }
            } else {
                const int kb = wid - 4;
                const LAS unsigned char* Ab = L + HC_KH + (32 * kb + r32) * HC_PK + hi * 8;
                const LAS unsigned char* Vb = L + HC_VV + vrd;
#pragma unroll
                for (int r = 0; r < 16; ++r) { const float dc = *(const LAS float*)(L + HC_DEC + (32 * kb + crow(r, hi)) * 4); S0[r] *= dc; S1[r] *= dc; }
#pragma unroll
                for (int s4 = 0; s4 < 4; ++s4) { const bf16x8 af = cat4(*(const LAS s16x4*)(Ab + s4 * 32), *(const LAS s16x4*)(Ab + s4 * 32 + 16));
                    S0 = __builtin_amdgcn_mfma_f32_32x32x16_bf16(af, cat4(vtr(Vb + s4 * 1024), vtr(Vb + s4 * 1024 + 512)), S0, 0, 0, 0);
                    S1 = __builtin_amdgcn_mfma_f32_32x32x16_bf16(af, cat4(vtr(Vb + 4096 + s4 * 1024), vtr(Vb + 4096 + s4 * 1024 + 512)), S1, 0, 0, 0); }
                LAS unsigned char* Sn = L + HC_SB + (sbuf ^ 1) * 16384 + (kb >> 1) * 8192;
#pragma unroll
                for (int r = 0; r < 16; ++r) { const int rw = (kb & 1) * 32 + crow(r, hi); LAS unsigned char* p = Sn + (rw >> 4) * 1024 + (rw & 15) * 64 + r32 * 2;
                    *(LAS unsigned short*)(p) = (unsigned short)(pk2(S0[r], 0.f) & 0xffffu); *(LAS unsigned short*)(p + 4096) = (unsigned short)(pk2(S1[r], 0.f) & 0xffffu); }
            }
            __syncthreads();
        }
#undef HC_LOAD
    }
}


#ifndef RC_PROBE
#define RC_PROBE 1
#endif
constexpr int RC_L = 16, RC_NCH = (CT + T) / RC_L, RC_NSS = RC_NCH / 8;
constexpr int RS_A = 0, RS_RM = 2304, RS_KH = 4608, RS_BH = 6656, RS_VT = 8704, RS_A1 = 10752, RS_TT = 11264, RS_B1 = 11776, RS_B2 = 12288, RS_PL = 12800, RS_SLOT = 13056;
constexpr int RC_SCR = 8 * RS_SLOT, RC_SCRSZ = 4608, RC_END = RC_SCR + 8 * RC_SCRSZ;
static_assert(RC_END <= RING_BYTES, "rwkv chunk LDS");
__device__ __forceinline__ int rc_row(int b, int dir, int cc, int t) {
    if (cc < CT / RC_L) { const int tt = cc * RC_L + t; return NL + b * CT + (dir ? CT - 1 - tt : tt); }
    const int tt = (cc - CT / RC_L) * RC_L + t; return b * T + (dir ? T - 1 - tt : tt);
}
__device__ __forceinline__ s16x4 pack4(const f32x4& v) { v2u w; w.x = pk2(v[0], v[1]); w.y = pk2(v[2], v[3]); return __builtin_bit_cast(s16x4, w); }
__device__ __forceinline__ float bfu(unsigned short h) { return __uint_as_float((unsigned)h << 16); }
__device__ __forceinline__ unsigned short f2b(float f) { return (unsigned short)(pk2(f, 0.f) & 0xffffu); }
#define MF16(a, b, c) __builtin_amdgcn_mfma_f32_16x16x32_bf16((a), (b), (c), 0, 0, 0)
__device__ __forceinline__ void phase_rwkv_chunk(const Frame& F) {
    const bf16* R = (const bf16*)(F.ws + WS_R); const bf16* KS = (const bf16*)(F.ws + WS_KS); const bf16* V = (const bf16*)(F.ws + WS_V); const bf16* KK = (const bf16*)(F.ws + WS_KK);
    const bf16* BB = (const bf16*)(F.ws + WS_BB);
    LAS unsigned char* L = F.lds;
    const int lane = F.lane, wid = F.wave, c = lane & 15, g = lane >> 4;
    const s16x4 z4 = {0, 0, 0, 0};
    for (int task = F.bid; task < NB * 8 * 2; task += F.G) {
        const int b = task >> 4, h = (task >> 1) & 7, dir = task & 1;
        const bf16* LW = (const bf16*)((unsigned char*)F.out + (dir ? DO_LWB : DO_LWF)); bf16* O = (bf16*)(F.ws + (dir ? WS_OB : WS_OF));
        f32x4 Xt[4];
#pragma unroll
        for (int i = 0; i < 4; ++i) Xt[i] = (f32x4){0.f, 0.f, 0.f, 0.f};
        v4u pg[12];
        const int prow = lane >> 2, pcol = (lane & 3) * 16;
#define RC_LOAD(cc) do { const size_t o_ = (size_t)rc_row(b, dir, (cc), prow) * AW + h * 64 + pcol; \
        pg[0] = *(const v4u*)(KK + o_); pg[1] = *(const v4u*)(KK + o_ + 8); pg[2] = *(const v4u*)(LW + o_); pg[3] = *(const v4u*)(LW + o_ + 8); pg[4] = *(const v4u*)(BB + o_); pg[5] = *(const v4u*)(BB + o_ + 8); \
        pg[6] = *(const v4u*)(KS + o_); pg[7] = *(const v4u*)(KS + o_ + 8); pg[8] = *(const v4u*)(R + o_); pg[9] = *(const v4u*)(R + o_ + 8); pg[10] = *(const v4u*)(V + o_); pg[11] = *(const v4u*)(V + o_ + 8); } while (0)
        RC_LOAD(wid);
        for (int n = 0; n < RC_NSS; ++n) {
            {
                {
                    const int p = wid;
                    for (int rep_ = 0; rep_ < RC_PROBE; ++rep_) {
                    LAS unsigned char* S = L + p * RS_SLOT; LAS unsigned char* Q = L + RC_SCR + p * RC_SCRSZ;
                    *(LAS v4u*)(S + RS_A + prow * 144 + pcol * 2) = pg[0]; *(LAS v4u*)(S + RS_A + prow * 144 + pcol * 2 + 16) = pg[1];
                    *(LAS v4u*)(S + RS_KH + prow * 128 + pcol * 2) = pg[2]; *(LAS v4u*)(S + RS_KH + prow * 128 + pcol * 2 + 16) = pg[3];
                    *(LAS v4u*)(Q + prow * 144 + pcol * 2) = pg[4]; *(LAS v4u*)(Q + prow * 144 + pcol * 2 + 16) = pg[5];
                    *(LAS v4u*)(Q + 2304 + prow * 144 + pcol * 2) = pg[6]; *(LAS v4u*)(Q + 2304 + prow * 144 + pcol * 2 + 16) = pg[7];
                    *(LAS v4u*)(S + RS_RM + prow * 144 + pcol * 2) = pg[8]; *(LAS v4u*)(S + RS_RM + prow * 144 + pcol * 2 + 16) = pg[9];
                    *(LAS v4u*)(S + RS_VT + prow * 128 + pcol * 2) = pg[10]; *(LAS v4u*)(S + RS_VT + prow * 128 + pcol * 2 + 16) = pg[11];
                    if (n + 1 < RC_NSS && rep_ == RC_PROBE - 1) RC_LOAD(8 * (n + 1) + p);
                    LDS_WAIT();
                    { float cum[16], vk[16], vb[16], vkk[16], vr[16]; unsigned short vv[16];
                      float run = 0.f;
#pragma unroll
                      for (int t = 0; t < 16; ++t) { run += bfu(*(const LAS unsigned short*)(S + RS_KH + t * 128 + lane * 2)); cum[t] = run;
                          vkk[t] = bfu(*(const LAS unsigned short*)(S + RS_A + t * 144 + lane * 2)); vr[t] = bfu(*(const LAS unsigned short*)(S + RS_RM + t * 144 + lane * 2));
                          vb[t] = bfu(*(const LAS unsigned short*)(Q + t * 144 + lane * 2)); vk[t] = bfu(*(const LAS unsigned short*)(Q + 2304 + t * 144 + lane * 2));
                          vv[t] = *(const LAS unsigned short*)(S + RS_VT + t * 128 + lane * 2); }
                      LDS_WAIT();
                      const float eL = __expf(run);
                      unsigned kh[8], bh[8], vt[8];
                      float eprev = 1.f;
#pragma unroll
                      for (int t = 0; t < 16; ++t) { const float e = __expf(cum[t]), ei = __expf(-cum[t]), el = eL * ei;
                          *(LAS unsigned short*)(S + RS_A + t * 144 + lane * 2) = f2b(vkk[t] * eprev); *(LAS unsigned short*)(S + RS_RM + t * 144 + lane * 2) = f2b(vr[t] * e);
                          *(LAS unsigned short*)(Q + t * 144 + lane * 2) = f2b(vb[t] * ei); *(LAS unsigned short*)(Q + 2304 + t * 144 + lane * 2) = f2b(vk[t] * ei);
                          const unsigned khv = f2b(vk[t] * el), bhv = f2b(-vb[t] * el);
                          if (t & 1) { kh[t >> 1] |= khv << 16; bh[t >> 1] |= bhv << 16; vt[t >> 1] |= (unsigned)vv[t] << 16; } else { kh[t >> 1] = khv; bh[t >> 1] = bhv; vt[t >> 1] = vv[t]; }
                          eprev = e; }
                      *(LAS v4u*)(S + RS_KH + lane * 32) = (v4u){kh[0], kh[1], kh[2], kh[3]}; *(LAS v4u*)(S + RS_KH + lane * 32 + 16) = (v4u){kh[4], kh[5], kh[6], kh[7]};
                      *(LAS v4u*)(S + RS_BH + lane * 32) = (v4u){bh[0], bh[1], bh[2], bh[3]}; *(LAS v4u*)(S + RS_BH + lane * 32 + 16) = (v4u){bh[4], bh[5], bh[6], bh[7]};
                      *(LAS v4u*)(S + RS_VT + lane * 32) = (v4u){vt[0], vt[1], vt[2], vt[3]}; *(LAS v4u*)(S + RS_VT + lane * 32 + 16) = (v4u){vt[4], vt[5], vt[6], vt[7]};
                      *(LAS float*)(S + RS_PL + lane * 4) = eL; }
                    LDS_WAIT();
                    { f32x4 a2 = {0.f, 0.f, 0.f, 0.f}, a1 = a2, b2 = a2, b1 = a2; int a2i[4];
#pragma unroll
                      for (int s = 0; s < 2; ++s) { const int ko = (32 * s + 8 * g) * 2;
                          const bf16x8 fa = *(const LAS bf16x8*)(S + RS_A + c * 144 + ko), fr = *(const LAS bf16x8*)(S + RS_RM + c * 144 + ko), fb = *(const LAS bf16x8*)(Q + c * 144 + ko), fk = *(const LAS bf16x8*)(Q + 2304 + c * 144 + ko);
                          a2 = MF16(fa, fb, a2); a1 = MF16(fa, fk, a1); b2 = MF16(fr, fb, b2); b1 = MF16(fr, fk, b1); }
#pragma unroll
                      for (int r = 0; r < 4; ++r) { const int t = 4 * g + r;
                          const bool lo = c < t, le = c <= t;
                          a2i[r] = __builtin_bit_cast(int, lo ? a2[r] : 0.f);
                          *(LAS unsigned short*)(S + RS_A1 + t * 32 + c * 2) = f2b(lo ? a1[r] : 0.f);
                          *(LAS unsigned short*)(S + RS_B1 + t * 32 + c * 2) = f2b(le ? b1[r] : 0.f);
                          *(LAS unsigned short*)(S + RS_B2 + t * 32 + c * 2) = f2b(le ? -b2[r] : 0.f); }
                      float Tc[16];
#pragma unroll
                      for (int t = 0; t < 16; ++t) { float acc = (c == t) ? 1.f : 0.f;
#pragma unroll
                          for (int i = 0; i < 16; ++i) if (i < t) acc -= __builtin_bit_cast(float, __builtin_amdgcn_readlane(a2i[t & 3], (t >> 2) * 16 + i)) * Tc[i];
                          Tc[t] = acc; }
                      if (g == 0) {
#pragma unroll
                          for (int t = 0; t < 16; ++t) *(LAS unsigned short*)(S + RS_TT + t * 32 + c * 2) = f2b(Tc[t]); } }
                    LDS_WAIT();
                    }
                }
            }
            __syncthreads();
            if (wid < 4) {
                LAS bf16* stg = (LAS bf16*)(L + RC_SCR + wid * RC_SCRSZ);
#pragma unroll 1
                for (int q = 0; q < 8; ++q) {
                    const LAS unsigned char* S = L + q * RS_SLOT;
                    const bf16x8 bx0 = cat4(pack4(Xt[0]), pack4(Xt[1])), bx1 = cat4(pack4(Xt[2]), pack4(Xt[3]));
                    const LAS unsigned char* pa = S + RS_A + c * 144 + g * 8; const LAS unsigned char* pr = S + RS_RM + c * 144 + g * 8;
                    const s16x4 vtl = *(const LAS s16x4*)(S + RS_VT + (16 * wid + c) * 32 + g * 8);
                    f32x4 W = {0.f, 0.f, 0.f, 0.f};
                    W = MF16(cat4(*(const LAS s16x4*)(pa), *(const LAS s16x4*)(pa + 32)), bx0, W);
                    W = MF16(cat4(*(const LAS s16x4*)(pa + 64), *(const LAS s16x4*)(pa + 96)), bx1, W);
                    W = MF16(cat4(*(const LAS s16x4*)(S + RS_A1 + c * 32 + g * 8), z4), cat4(vtl, z4), W);
                    f32x4 U = {0.f, 0.f, 0.f, 0.f};
                    U = MF16(cat4(*(const LAS s16x4*)(S + RS_TT + c * 32 + g * 8), z4), cat4(pack4(W), z4), U);
                    const bf16x8 bvu = cat4(vtl, pack4(U));
                    f32x4 Ov = {0.f, 0.f, 0.f, 0.f};
                    Ov = MF16(cat4(*(const LAS s16x4*)(pr), *(const LAS s16x4*)(pr + 32)), bx0, Ov);
                    Ov = MF16(cat4(*(const LAS s16x4*)(pr + 64), *(const LAS s16x4*)(pr + 96)), bx1, Ov);
                    Ov = MF16(cat4(*(const LAS s16x4*)(S + RS_B1 + c * 32 + g * 8), *(const LAS s16x4*)(S + RS_B2 + c * 32 + g * 8)), bvu, Ov);
#pragma unroll
                    for (int kt = 0; kt < 4; ++kt) { const f32x4 pl = *(const LAS f32x4*)(S + RS_PL + (16 * kt + 4 * g) * 4);
                        Xt[kt] = MF16(cat4(*(const LAS s16x4*)(S + RS_KH + (16 * kt + c) * 32 + g * 8), *(const LAS s16x4*)(S + RS_BH + (16 * kt + c) * 32 + g * 8)), bvu, Xt[kt] * pl); }
#pragma unroll
                    for (int r = 0; r < 4; ++r) stg[(q * 16 + 4 * g + r) * 16 + c] = f2b(Ov[r]);
                }
                LDS_WAIT();
#pragma unroll
                for (int hf = 0; hf < 2; ++hf) { const int rw = hf * 64 + lane, q = rw >> 4, t = rw & 15; const v4u x0 = *(const LAS v4u*)(stg + rw * 16), x1 = *(const LAS v4u*)(stg + rw * 16 + 8);
                  bf16* op = O + (size_t)rc_row(b, dir, 8 * n + q, t) * AW + h * 64 + 16 * wid; *(v4u*)op = x0; *(v4u*)(op + 8) = x1; }
            }
            __syncthreads();
        }
#undef RC_LOAD
    }
}

__device__ __forceinline__ void phase_route1(const Frame& F, const Args& a) {
    LAS float* rw = (LAS float*)F.lds;
    LAS int* cnt = (LAS int*)(F.lds + 32768);
    const float* modsL = (const float*)(F.ws + WS_MODS) + (size_t)17 * 6144;
    unsigned char* FL = F.ws + WS_FLAT; int* tope = (int*)(F.ws + WS_TOPE); float* topw = (float*)(F.ws + WS_TOPW); int* rcnt = (int*)(F.ws + WS_RCNT);
    for (int i = F.tid; i < D * NEXP; i += NTHR) rw[(i & 7) * D + (i >> 3)] = a.in[I_ROUTER][i];
    const int nblk = NL / 128;
    for (int blk = F.bid; blk < nblk; blk += F.G) {
        if (F.tid < NEXP) cnt[F.tid] = 0;
        __syncthreads();
        for (int i = 0; i < 16; ++i) { const int m = blk * 128 + F.wave * 16 + i, s = m / T;
            f32x4 v[4]; load_row16((const bf16*)F.out + (size_t)m * (2 * D) + D, F.lane, v);
            norm_mod(v, a.in[I_NFFN] + D, modsL + (size_t)s * 6144 + 3 * 1024, modsL + (size_t)s * 6144 + 4 * 1024, F.lane);
#pragma unroll
            for (int j = 0; j < 4; ++j) *(unsigned*)(FL + (size_t)m * D + 256 * j + 4 * F.lane) = pk4_fp8(v[j][0] * MOE_SA, v[j][1] * MOE_SA, v[j][2] * MOE_SA, v[j][3] * MOE_SA);
            float lg[NEXP];
#pragma unroll
            for (int e = 0; e < NEXP; ++e) lg[e] = 0.f;
#pragma unroll
            for (int e = 0; e < NEXP; ++e)
#pragma unroll
                for (int j = 0; j < 4; ++j) { const f32x4 w = *(const LAS f32x4*)(rw + e * D + 256 * j + 4 * F.lane); lg[e] += (v[j][0] * w[0] + v[j][1] * w[1]) + (v[j][2] * w[2] + v[j][3] * w[3]); }
#pragma unroll
            for (int e = 0; e < NEXP; ++e) lg[e] = wave_sum(lg[e]) + a.in[I_ROUTERB][e];
            int e1 = 0; float l1 = lg[0];
#pragma unroll
            for (int e = 1; e < NEXP; ++e) if (lg[e] > l1) { l1 = lg[e]; e1 = e; }
            int e2 = -1; float l2 = -3.0e38f;
#pragma unroll
            for (int e = 0; e < NEXP; ++e) if (e != e1 && lg[e] > l2) { l2 = lg[e]; e2 = e; }
            const float r = __expf(l2 - l1), w1 = 1.f / (1.f + r), w2 = r * w1;
            if (F.lane == 0) { tope[2 * m] = e1; tope[2 * m + 1] = e2; topw[2 * m] = w1; topw[2 * m + 1] = w2; __hip_atomic_fetch_add(&cnt[e1], 1, __ATOMIC_RELAXED, __HIP_MEMORY_SCOPE_WORKGROUP); __hip_atomic_fetch_add(&cnt[e2], 1, __ATOMIC_RELAXED, __HIP_MEMORY_SCOPE_WORKGROUP); }
        }
        __syncthreads();
        if (F.tid < NEXP) rcnt[blk * NEXP + F.tid] = cnt[F.tid];
        __syncthreads();
    }
}
__device__ __forceinline__ void phase_route2(const Frame& F) {
    LAS int* tot = (LAS int*)F.lds;
    LAS int* base = tot + 8;
    LAS int* mine = tot + 24;
    LAS int* wcnt = tot + 32;
    LAS int* slots = tot + 64;
    const int* rcnt = (const int*)(F.ws + WS_RCNT); const int* tope = (const int*)(F.ws + WS_TOPE); int* slot_g = (int*)(F.ws + WS_SLOT); int* pexp = (int*)(F.ws + WS_PEXP); int* npan = (int*)(F.ws + WS_NPAN);
    const unsigned char* FL = F.ws + WS_FLAT; unsigned char* AS = F.ws + WS_A8;
    const int nblk = NL / 128;
    for (int blk = F.bid; blk < nblk; blk += F.G) {
        { const int e = F.wave; int t = 0, before = 0;
          for (int k = F.lane; k < nblk; k += 64) { const int c = rcnt[k * NEXP + e]; t += c; if (k < blk) before += c; }
#pragma unroll
          for (int o = 1; o < 64; o <<= 1) { t += __shfl_xor(t, o); before += __shfl_xor(before, o); }
          if (F.lane == 0) { tot[e] = t; mine[e] = before; } }
        __syncthreads();
        if (F.tid == 0) { int s = 0; for (int e = 0; e < NEXP; ++e) { base[e] = s; s += (tot[e] + 255) & ~255; } base[8] = s; }
        __syncthreads();
        int ej = 0;
        if (F.tid < 256) { ej = tope[(blk * 128) * 2 + F.tid];
#pragma unroll
            for (int e = 0; e < NEXP; ++e) { const unsigned long long mk = __ballot(ej == e); if (F.lane == 0) wcnt[F.wave * 8 + e] = __popcll(mk); } }
        __syncthreads();
        if (F.tid < 256) {
            unsigned long long same = 0ull;
#pragma unroll
            for (int e = 0; e < NEXP; ++e) { const unsigned long long bm = __ballot(ej == e); if (ej == e) same = bm; }
            int rank = __popcll(same & ((1ull << F.lane) - 1ull));
            for (int w = 0; w < F.wave; ++w) rank += wcnt[w * 8 + ej];
            const int sl = base[ej] + mine[ej] + rank;
            slots[F.tid] = sl; slot_g[(blk * 128) * 2 + F.tid] = sl; }
        __syncthreads();
        for (int j = F.wave; j < 256; j += NWAVES) { const int tok = blk * 128 + (j >> 1); *((v4u*)(AS + (size_t)slots[j] * D) + F.lane) = *((const v4u*)(FL + (size_t)tok * D) + F.lane); }
        if (blk < NEXP) { const int r0 = base[blk] + tot[blk], r1 = base[blk] + ((tot[blk] + 255) & ~255);
            for (int r = r0 + F.wave; r < r1; r += NWAVES) *((v4u*)(AS + (size_t)r * D) + F.lane) = (v4u){0u, 0u, 0u, 0u}; }
        if (blk == NEXP) { const int np = base[8] >> 8;
            for (int p = F.tid; p < MAXPAN; p += NTHR) { int e = 0;
#pragma unroll
                for (int q = 1; q < NEXP; ++q) if (p * 256 >= base[q]) e = q;
                pexp[p] = p < np ? e : 0; }
            if (F.tid == 0) npan[0] = np; }
        __syncthreads();
    }
}
__device__ __forceinline__ void phase_final(const Frame& F, const Args& a) {
    const float* modsL = (const float*)(F.ws + WS_MODS) + (size_t)17 * 6144;
    const bf16* Y = (const bf16*)(F.ws + WS_ASORT); const int* slot_g = (const int*)(F.ws + WS_SLOT); const float* topw = (const float*)(F.ws + WS_TOPW);
    const int gw = F.bid * NWAVES + F.wave, NGW = F.G * NWAVES, lane = F.lane;
    for (int m = gw; m < NL; m += NGW) { const int s = m / T;
        f32x4 v[4]; load_row16((const bf16*)F.out + (size_t)m * (2 * D) + D, lane, v);
        const int s1 = slot_g[2 * m], s2 = slot_g[2 * m + 1]; const float w1 = topw[2 * m], w2 = topw[2 * m + 1];
        const float* gate = modsL + (size_t)s * 6144 + 5 * 1024;
        float ss = 0.f;
#pragma unroll
        for (int j = 0; j < 4; ++j) { const int c = 256 * j + 4 * lane; const f32x4 g = *(const f32x4*)(gate + c);
            const f32x4 y1 = bf4(*(const v2u*)(Y + (size_t)s1 * D + c)), y2 = bf4(*(const v2u*)(Y + (size_t)s2 * D + c));
            v[j] = v[j] + g * (y1 * w1 + y2 * w2); ss += (v[j][0] * v[j][0] + v[j][1] * v[j][1]) + (v[j][2] * v[j][2] + v[j][3] * v[j][3]); }
        const float r = __builtin_amdgcn_rsqf(wave_sum(ss) * (1.f / D) + NORM_EPS);
#pragma unroll
        for (int j = 0; j < 4; ++j) { const int c = 256 * j + 4 * lane; *(f32x4*)(F.out + (size_t)m * D + c) = v[j] * r * *(const f32x4*)(a.in[I_NFIN] + c); }
    }
}

constexpr int NPHASE = 23;
constexpr int MW_P8 = 6500, MW_P10 = 11264, MW_P11 = 28160;
static_assert(MW_P10 <= MW_DOWN && MW_P11 <= MW_DOWN + 6 * 2816, "items converted before phase 10 / during phase 11 must not touch the YMIX overlay (gate|up of experts 0, 1)");
#define GEMM_CALL(EPI, SCHED, g, S, E) pg8::gemm_phase<EPI, SCHED, true, true>(F.lds, g, S, E)
#define GEMM_CALL8(EPI, SCHED, g, S, E) pg8::gemm_phase<EPI, SCHED, true, true, true>(F.lds, g, S, E)
#define GEMM_CALLQ(EPI, SCHED, g, S, E) pg8::gemm_phase<EPI, SCHED, true, true, false, true>(F.lds, g, S, E)
__global__ void __launch_bounds__(NTHR, 2) mk_fwd(Args args) {
    extern __shared__ __attribute__((aligned(16))) unsigned char lds_raw[];
    Frame F;
    F.lds = (LAS unsigned char*)lds_raw;
    F.tid = threadIdx.x; F.lane = F.tid & 63; F.wave = __builtin_amdgcn_readfirstlane(F.tid >> 6);
    F.G = gridDim.x; F.bid = blockIdx.x; F.out = args.out; F.ws = args.ws;
    volatile LAS unsigned* MISC = (volatile LAS unsigned*)(F.lds + MISC_OFF);
    for (int u = F.tid; u < (LDS_BYTES - LDSCTL_OFF) / 4; u += NTHR) ((LAS unsigned*)(F.lds + LDSCTL_OFF))[u] = 0u;
    __syncthreads();
    XcdBarrier bar; bar.bar = (unsigned*)(F.ws + WS_CTL) + CW_BAR; bar.x = 0; bar.st = nullptr;
#if !MK_PER_PHASE
    bar = xcd_barrier_post((unsigned*)(F.ws + WS_CTL) + CW_BAR, MISC + 8);
#endif
    const int lo = args.ph_lo, hi = args.ph_hi;
#ifndef MK_MASK
#define MK_MASK 0x7fffff
#endif
#define IN(k) (((MK_MASK >> (k)) & 1) && lo <= (k) && (k) < hi)
#define SEAM(k) do { if (IN((k) + 1)) xcd_barrier(bar); } while (0)
#ifndef MK_DUP
#define MK_DUP 0
#endif
#define REP(k) for (int rep_ = 0; rep_ < (((MK_DUP >> (k)) & 1) ? 2 : 1); ++rep_)
#define RSYNC(k) do { if ((MK_DUP >> (k)) & 1) { if (MK_PER_PHASE) __syncthreads(); else xcd_barrier(bar); } } while (0)
    const float* mods0 = (const float*)(F.ws + WS_MODS); const float* mods1 = mods0 + (size_t)17 * 6144;
    unsigned char* dout = (unsigned char*)F.out;

    if (IN(0)) { REP(0) { phase_prologue(F, args); RSYNC(0); } SEAM(0); }
    if (IN(1)) { REP(1) { phase_norm_rows<false>(F, args.in[I_X], args.in[I_CTX], args.in[I_NMIX], mods0, 0, (bf16*)(F.ws + WS_H0), NT); RSYNC(1); } SEAM(1); }
    if (IN(2)) {
        pg8::Gemm g{(const bf16*)(F.ws + WS_H0), (const bf16*)(F.ws + WS_WIN), D, D}; pg8::StaticOrder S; S.init(NT / 256, RIN / 256, F.G, F.bid);
        epi::EpiP E{(bf16*)(dout + DO_PRW), (bf16*)(F.ws + WS_PHG)};
        REP(2) { GEMM_CALL(epi::EpiP, pg8::StaticOrder, g, S, E); RSYNC(2); }
        phase_layer_weights(F, args, PW_IN, PW_ITEMS, (NT / 256 * (RIN / 256)) % F.G);
        SEAM(2); }
    if (IN(3)) { REP(3) { phase_rwkv_feat(F, args); RSYNC(3); } SEAM(3); }
    if (IN(4)) {
        int klora = 256; asm volatile("" : "+s"(klora));
        pg8::Gemm g{(const bf16*)(F.ws + WS_LB), (const bf16*)(F.ws + WS_WLORA), klora, klora}; pg8::StaticOrder S; S.init(NT / 256, 2048 / 256, F.G, F.bid);
        epi::EpiLora E{args.in[I_W0], args.in[I_A0], args.in[I_KA], (bf16*)(dout + DO_LWF), (bf16*)(dout + DO_LWB), (bf16*)(F.ws + WS_KS), (const bf16*)(F.ws + WS_KK), (bf16*)(F.ws + WS_BB), (bf16*)(dout + DO_GG)};
        GEMM_CALL(epi::EpiLora, pg8::StaticOrder, g, S, E); SEAM(4); }
    if (IN(5)) { REP(5) { phase_rwkv_chunk(F); RSYNC(5); } SEAM(5); }
    if (IN(6)) { REP(6) { phase_rwkv_post(F, args); RSYNC(6); } REP(23) { phase_hgrn_chunk(F, args); RSYNC(23); } SEAM(6); }
    if (IN(7)) { REP(7) { phase_hgrn_post(F, args); RSYNC(7); }
        SEAM(7); }
    if (IN(8)) {
        pg8::Gemm g{(const bf16*)(F.ws + WS_YMIX), (const bf16*)(F.ws + WS_WOUT0), D, D}; pg8::StaticOrder S; S.init(NT / 256, D / 256, F.G, F.bid);
        using ER8 = epi::EpiResT<false, true>; ER8 E{args.in[I_X], F.out, args.in[I_CTX], F.ws + WS_X1C, mods0 + 2 * 1024, D};
        GEMM_CALL(ER8, pg8::StaticOrder, g, S, E);
        phase_moe_weights(F, args, 0, MW_P8, (NT / 256 * (D / 256)) % F.G);
        SEAM(8); }
    if (IN(9)) { REP(9) { phase_norm_rows<true, true>(F, F.out, F.ws + WS_X1C, args.in[I_NFFN], mods0, 3, (bf16*)(F.ws + WS_F), NT, (float*)(F.ws + WS_SA)); RSYNC(9); } SEAM(9); }
    if (IN(10)) {
        pg8::Gemm g{(const bf16*)(F.ws + WS_F), (const bf16*)(F.ws + WS_WGU0), D / 2, D / 2}; pg8::StaticOrder S; S.init(NT / 256, FF2 / 256, F.G, F.bid);
        epi::EpiSwiGLUQ E{F.ws + WS_HFF, (const float*)(F.ws + WS_SA), (const float*)(F.ws + WS_SW), FFN_SH};
        REP(10) { GEMM_CALLQ(epi::EpiSwiGLUQ, pg8::StaticOrder, g, S, E); RSYNC(10); }
        phase_moe_weights(F, args, MW_P8, MW_P10, (NT / 256 * (FF2 / 256)) % F.G);
        SEAM(10); }
    if (IN(11)) {
        pg8::Gemm g{(const bf16*)(F.ws + WS_HFF), (const bf16*)(F.ws + WS_WD0), FF / 2, FF / 2}; pg8::StaticOrder S; S.init(NT / 256, D / 256, F.G, F.bid);
        using ER11 = epi::EpiResT<true, true>; ER11 E{F.out, F.ws + WS_X2, F.ws + WS_X1C, F.ws + WS_X2C, mods0 + 5 * 1024, D, 1.f / (FFN_SH * FFN_SW)};
        GEMM_CALL8(ER11, pg8::StaticOrder, g, S, E);
        phase_moe_weights(F, args, MW_P10, MW_P11, (NT / 256 * (D / 256)) % F.G);
        SEAM(11); }
    if (IN(12)) { REP(12) { phase_norm_rows<true>(F, F.ws + WS_X2, F.ws + WS_X2C, args.in[I_NMIX] + D, mods1, 0, (bf16*)(F.ws + WS_H1), NT); RSYNC(12); }  SEAM(12); }
    if (IN(13)) {
        pg8::Gemm g{(const bf16*)(F.ws + WS_H1), (const bf16*)(F.ws + WS_WATTIN), D, D}; pg8::StaticOrder S; S.init(NT / 256, QKVW / 256, F.G, F.bid);
        epi::EpiQKV E{(bf16*)(F.ws + WS_QKV), (const float*)(F.ws + WS_ROPE)};
        REP(13) { GEMM_CALL(epi::EpiQKV, pg8::StaticOrder, g, S, E); RSYNC(13); }
        phase_moe_weights(F, args, MW_P11, MW_ITEMS, (NT / 256 * (QKVW / 256)) % F.G);
        SEAM(13); }
    if (IN(14)) { REP(14) { phase_attn(F, args); RSYNC(14); } SEAM(14); }
    if (IN(15)) {
        pg8::Gemm g{(const bf16*)(F.ws + WS_OATT), (const bf16*)(F.ws + WS_WATTOUT), D, D}; pg8::StaticOrder S; S.init(NL / 256, D / 256, F.G, F.bid);
        using ER15 = epi::EpiResT<true, true>; ER15 E{F.ws + WS_X2, (bf16*)F.out + D, F.ws + WS_X2, (bf16*)F.out + D, mods1 + 2 * 1024, 2 * D};
        GEMM_CALL(ER15, pg8::StaticOrder, g, S, E); SEAM(15); }
    if (IN(16)) { REP(16) { phase_route1(F, args); RSYNC(16); } SEAM(16); }
    if (IN(17)) { REP(17) { phase_route2(F); RSYNC(17); }
        SEAM(17); }
    if (IN(18)) {
        const int np = *(const int*)(F.ws + WS_NPAN), n = np > MAXPAN ? MAXPAN : np;
        pg8::Gemm g{(const bf16*)(F.ws + WS_A8), (const bf16*)(F.ws + WS_WMGU), D / 2, D / 2};
        pg8::MoeOrder S; S.so.init(n, FF2 / 256, F.G, F.bid); S.p0 = 0; S.pexp = (const int*)(F.ws + WS_PEXP);
        epi::EpiSwiGLU8 E{F.ws + WS_HMOE, 1.f / (MOE_SA * MOE_SW), MOE_SH};
        REP(18) { GEMM_CALL8(epi::EpiSwiGLU8, pg8::MoeOrder, g, S, E); RSYNC(18); } SEAM(18); }
    if (IN(19)) {
        const int np = *(const int*)(F.ws + WS_NPAN), n = np > MAXPAN ? MAXPAN : np;
        pg8::Gemm g{(const bf16*)(F.ws + WS_HMOE), (const bf16*)(F.ws + WS_WMD), FF / 2, FF / 2};
        pg8::MoeOrder S; S.so.init(n, D / 256, F.G, F.bid); S.p0 = 0; S.pexp = (const int*)(F.ws + WS_PEXP);
        epi::EpiBf16S E{(bf16*)(F.ws + WS_ASORT), D, 1.f / (MOE_SH * MOE_SW)};
        REP(19) { GEMM_CALL8(epi::EpiBf16S, pg8::MoeOrder, g, S, E); RSYNC(19); } SEAM(21); }
    if (IN(22)) { phase_final(F, args); }
#undef IN
#undef SEAM
}

extern "C" void kernel_launch(void* const* d_in, const int* in_sizes, int n_in, void* d_out, int out_size, void* d_ws, size_t ws_size, hipStream_t stream) {
    static int grid = 0;
    if (grid == 0) {
        if (n_in != 35 || out_size != NL * D || ws_size < WS_END) { fprintf(stderr, "kernel_launch: unexpected problem (n_in %d, out %d, ws %zu)\n", n_in, out_size, ws_size); grid = -1; return; }
        int dev = 0, cus = 0, per_cu = 0;
        if (hipGetDevice(&dev) != hipSuccess || hipDeviceGetAttribute(&cus, hipDeviceAttributeMultiprocessorCount, dev) != hipSuccess) { grid = -1; return; }
        if (hipFuncSetAttribute((const void*)mk_fwd, hipFuncAttributeMaxDynamicSharedMemorySize, LDS_BYTES) != hipSuccess) { fprintf(stderr, "kernel_launch: hipFuncSetAttribute failed\n"); grid = -1; return; }
        if (hipOccupancyMaxActiveBlocksPerMultiprocessor(&per_cu, (const void*)mk_fwd, NTHR, LDS_BYTES) != hipSuccess || per_cu < 1) fprintf(stderr, "kernel_launch: occupancy query reports %d\n", per_cu);
        (void)hipGetLastError();
        grid = cus;
    }
    if (grid < 0) return;
    (void)hipMemsetAsync((char*)d_ws + WS_CTL, 0, CTL_ZERO_BYTES, stream);
    Args a{};
    for (int i = 0; i < 35; ++i) a.in[i] = (const float*)d_in[i];
    a.out = (float*)d_out; a.ws = (unsigned char*)d_ws;
#if MK_PER_PHASE
    for (int p = 0; p < NPHASE; ++p) { a.ph_lo = p; a.ph_hi = p + 1; hipLaunchKernelGGL(mk_fwd, dim3(grid), dim3(NTHR), LDS_BYTES, stream, a); }
#else
    a.ph_lo = 0; a.ph_hi = NPHASE; hipLaunchKernelGGL(mk_fwd, dim3(grid), dim3(NTHR), LDS_BYTES, stream, a);
#endif
}
```

```cpp
#include <hip/hip_runtime.h>
#include <cstdio>
#include <cstdint>

#ifndef MK_PER_PHASE
#define MK_PER_PHASE 0
#endif

namespace pg8 {
#define PG8_LAS __attribute__((address_space(3)))
typedef unsigned short bf16_t;
typedef short bf16x8 __attribute__((ext_vector_type(8)));
typedef float f32x4 __attribute__((ext_vector_type(4)));
typedef float f32x2 __attribute__((ext_vector_type(2)));
typedef unsigned u32x4 __attribute__((ext_vector_type(4)));
typedef unsigned u32x2 __attribute__((ext_vector_type(2)));
constexpr int BM = 256, BK = 64, HALF = 128, HTB = HALF * BK * 2  , STAGE_BYTES = 8 * HTB, NXCD = 8, WGM = 8;

__host__ __device__ __forceinline__ int lds_byte(int r, int c) { const int st = (r >> 4) * 2 + (c >> 5), rr = r & 15, cc = c & 31, ob = rr * 64 + cc * 2; return st * 1024 + (ob ^ (((ob >> 9) & 1) << 5)); }
__host__ __device__ __forceinline__ void stage_rc(int b, int& R, int& C) { const int st = b / 1024, sb = b % 1024, swz = sb ^ (((sb >> 9) & 1) << 5); R = (st >> 1) * 16 + swz / 64; C = (st & 1) * 32 + (swz % 64) / 2; }
__host__ __device__ __forceinline__ int perm32(int rho) { const int n = rho >> 4, i = rho & 15; return 8 * (i >> 2) + 4 * n + (i & 3); }

struct Unit { int pm, pn, pb, ko; };
struct Gemm { const bf16_t* A; const bf16_t* Bt; int K; int ld; };

struct StaticOrder {
    int nM, nN, nwg, G, c;
    __device__ __forceinline__ void init(int nM_, int nN_, int G_, int c_) { nM = nM_; nN = nN_; nwg = nM * nN; G = G_; c = c_; }
    __device__ __forceinline__ bool next(int i, Unit& u) const {
        const long L = (long)i * G + c; if (L >= nwg) return false;
        int wgid = (int)L; { const int q = nwg / NXCD, r = nwg % NXCD, xcd = wgid % NXCD, off = wgid / NXCD; wgid = (xcd < r ? xcd * (q + 1) : r * (q + 1) + (xcd - r) * q) + off; }
        const int nig = WGM * nN, gid = wgid / nig, fm = gid * WGM, gsz = (nM - fm) < WGM ? (nM - fm) : WGM;
        u.pm = fm + ((wgid % nig) % gsz); u.pn = (wgid % nig) / gsz; u.pb = u.pn; u.ko = 0; return true;
    }
};
struct MoeOrder {
    StaticOrder so; int p0; const int* pexp;
    __device__ __forceinline__ bool next(int i, Unit& u) const {
        if (!so.next(i, u)) return false;
        u.pb = pexp[p0 + u.pm] * so.nN + u.pn; return true;
    }
};

struct LoraOrder {
    StaticOrder so;
    __device__ __forceinline__ bool next(int i, Unit& u) const {
        if (!so.next(i, u)) return false;
        u.ko = u.pn < 4 ? 0 : (u.pn < 6 ? 64 : 128); return true;
    }
};
struct SplitKOrder {
    int nM, nN, nS, KS, G, c, pm0, p0; const int* pexp;
    __device__ __forceinline__ bool next(int i, Unit& u) const {
        const long L = (long)i * G + c; if (L >= (long)nM * nN * nS) return false;
        const int l = (int)L, ks = l % nS, r = l / nS; u.pn = r % nN; u.pm = pm0 + r / nN; u.ko = ks * KS;
        u.pb = pexp ? pexp[p0 + u.pm] * nN + u.pn : u.pn; return true;
    }
};

__device__ __forceinline__ unsigned cvt_pk_bf16(float lo, float hi) { unsigned r; asm volatile("v_cvt_pk_bf16_f32 %0, %1, %2" : "=v"(r) : "v"(lo), "v"(hi)); return r; }

typedef int v8i32 __attribute__((ext_vector_type(8)));
template <class E, class = void> struct EpiScales { static constexpr bool value = false; };
template <class E> struct EpiScales<E, decltype((void)E::LDS_SCALES)> { static constexpr bool value = E::LDS_SCALES; };
constexpr int SCALE_OFF = 8 * HTB;
template <class Epi, class Sched, bool ALIGN_EPI = false, bool SP2 = false, bool FP8 = false, bool I8 = false>
__device__ __forceinline__ void gemm_phase(PG8_LAS unsigned char* lds, const Gemm g, const Sched& S, const Epi& E) {
    const int tid = threadIdx.x, wid = __builtin_amdgcn_readfirstlane(tid >> 6), lane = tid & 63, wr = wid >> 2, wc = wid & 3, fr = lane & 15, fq = lane >> 4;
    const int K = g.ld, nt = g.K / BK;
    unsigned voffA[2], voffB[2];
#pragma unroll
    for (int i = 0; i < 2; ++i) { int R, C; stage_rc(tid * 16 + i * 8192, R, C); const int Rb = Epi::PERM ? ((R & ~31) + perm32(R & 31)) : R;
        voffA[i] = (unsigned)(R * K + C) * 2u; voffB[i] = (unsigned)(Rb * K + C) * 2u; }
    const size_t kstep = (size_t)(BK * 2);
    const size_t hstep = (size_t)HALF * K * 2;
    const size_t tstep = 2 * hstep;
    const unsigned ldsw = (unsigned)wid * 1024u;
    const int aoff = lds_byte(wr * 64 + fr, fq * 8), boff = lds_byte(wc * 32 + fr, fq * 8);
#define PG8_SA(b, h) (((b) * 2 + (h)) * HTB)
#define PG8_SB(b, h) ((4 + (b) * 2 + (h)) * HTB)
#define PG8_STAGE(bufoff, gbase, voff) do { _Pragma("unroll") for (int _i = 0; _i < 2; ++_i) \
        __builtin_amdgcn_global_load_lds((const unsigned*)((const char*)(gbase) + (voff)[_i]), (PG8_LAS unsigned*)(lds + (bufoff) + ldsw + _i * 8192), 16, 0, 0); } while (0)
#define PG8_RD(off) (*(const PG8_LAS bf16x8*)(lds + (off)))
#define PG8_CAT2(x, y) __builtin_bit_cast(v8i32, __builtin_shufflevector((x), (y), 0, 1, 2, 3, 4, 5, 6, 7, 8, 9, 10, 11, 12, 13, 14, 15))
#define PG8_LDA(dst, b, h) do { _Pragma("unroll") for (int m = 0; m < 4; ++m) { if constexpr (FP8) dst##8[m] = PG8_CAT2(PG8_RD(PG8_SA(b, h) + aoff + m * 2048), PG8_RD(PG8_SA(b, h) + aoff + m * 2048 + 1024)); \
        else { _Pragma("unroll") for (int k = 0; k < 2; ++k) dst[m][k] = PG8_RD(PG8_SA(b, h) + aoff + m * 2048 + k * 1024); } } } while (0)
#define PG8_LDB(dst, b, h) do { _Pragma("unroll") for (int n = 0; n < 2; ++n) { if constexpr (FP8) dst##8[n] = PG8_CAT2(PG8_RD(PG8_SB(b, h) + boff + n * 2048), PG8_RD(PG8_SB(b, h) + boff + n * 2048 + 1024)); \
        else { _Pragma("unroll") for (int k = 0; k < 2; ++k) dst[n][k] = PG8_RD(PG8_SB(b, h) + boff + n * 2048 + k * 1024); } } } while (0)
#define PG8_MMA(ai, bj, At, Bt) do { __builtin_amdgcn_s_setprio(1); \
        if constexpr (I8) { _Pragma("unroll") for (int k = 0; k < 2; ++k) _Pragma("unroll") for (int m = 0; m < 4; ++m) _Pragma("unroll") for (int n = 0; n < 2; ++n) \
            asm volatile("v_mfma_i32_16x16x64_i8 %0, %1, %2, %0" : "+v"(acc[ai][bj][m][n]) : "v"(Bt[n][k]), "v"(At[m][k])); } \
        else _Pragma("unroll") for (int m = 0; m < 4; ++m) _Pragma("unroll") for (int n = 0; n < 2; ++n) { \
        if constexpr (FP8) asm volatile("v_mfma_scale_f32_16x16x128_f8f6f4 %0, %1, %2, %0, %3, %3 op_sel_hi:[0,0,0]" : "+v"(acc[ai][bj][m][n]) : "v"(Bt##8[n]), "v"(At##8[m]), "v"(fp8_one));   \
        else { _Pragma("unroll") for (int k = 0; k < 2; ++k) acc[ai][bj][m][n] = __builtin_amdgcn_mfma_f32_16x16x32_bf16(Bt[n][k], At[m][k], acc[ai][bj][m][n], 0, 0, 0); } } __builtin_amdgcn_s_setprio(0); } while (0)
#define PG8_WAIT_V(n) asm volatile("s_waitcnt vmcnt(" #n ")" ::: "memory")
#define PG8_WAIT_L(n) asm volatile("s_waitcnt lgkmcnt(" #n ")" ::: "memory")
#define PG8_BAR __builtin_amdgcn_s_barrier()
#define PG8_SCHED __builtin_amdgcn_sched_barrier(0)
    Unit cur, nxt; int ui = 0;
    if (!S.next(0, cur)) return;
#define PG8_SCALES(un, par) do { if constexpr (EpiScales<Epi>::value) {   \
        const float* sb_ = wid < 4 ? E.sA + (size_t)(un).pm * 256 + wid * 64 : E.sW + (size_t)(un).pb * 256 + (wid - 4) * 64; \
        const unsigned ln_ = __builtin_amdgcn_mbcnt_hi(~0u, __builtin_amdgcn_mbcnt_lo(~0u, 0u)); \
        __builtin_amdgcn_global_load_lds((const unsigned*)(sb_ + ln_), (PG8_LAS unsigned*)(lds + SCALE_OFF + (par) * 2048 + wid * 256), 4, 0, 0); } } while (0)
    PG8_SCALES(cur, 0);
    f32x4 acc[2][2][4][2];
#pragma unroll
    for (int a = 0; a < 2; ++a)
#pragma unroll
        for (int b = 0; b < 2; ++b)
#pragma unroll
            for (int m = 0; m < 4; ++m)
#pragma unroll
                for (int n = 0; n < 2; ++n) acc[a][b][m][n] = (f32x4){0.f, 0.f, 0.f, 0.f};
    const int fp8_one = 0x7f7f7f7f;
    bf16x8 At[4][2], B0[2][2], B1[2][2]; v8i32 At8[4], B08[2], B18[2];
    const char* cA = (const char*)g.A + (size_t)cur.pm * tstep + (size_t)cur.ko * 2; const char* cB = (const char*)g.Bt + (size_t)cur.pb * tstep + (size_t)cur.ko * 2;
    if constexpr (SP2) {
        PG8_STAGE(PG8_SB(0, 0), cB, voffB); PG8_STAGE(PG8_SB(0, 1), cB + hstep, voffB); PG8_STAGE(PG8_SA(0, 0), cA, voffA); PG8_STAGE(PG8_SA(0, 1), cA + hstep, voffA);
        if (wr == 1) PG8_BAR;
        PG8_WAIT_V(2); PG8_BAR;
        PG8_STAGE(PG8_SB(1, 0), cB + kstep, voffB); PG8_STAGE(PG8_SA(1, 0), cA + kstep, voffA); PG8_STAGE(PG8_SB(1, 1), cB + hstep + kstep, voffB);
        PG8_WAIT_V(6); PG8_BAR;
    } else {
        PG8_STAGE(PG8_SB(0, 0), cB, voffB); PG8_STAGE(PG8_SA(0, 0), cA, voffA); PG8_STAGE(PG8_SB(0, 1), cB + hstep, voffB); PG8_STAGE(PG8_SA(0, 1), cA + hstep, voffA);
        if (wr == 1) PG8_BAR;
        PG8_WAIT_V(4); PG8_BAR;
        PG8_STAGE(PG8_SB(1, 0), cB + kstep, voffB); PG8_STAGE(PG8_SA(1, 0), cA + kstep, voffA); PG8_STAGE(PG8_SB(1, 1), cB + hstep + kstep, voffB);
        PG8_WAIT_V(6); PG8_BAR;
    }
    for (;;) {
        const bool has_next = S.next(ui + 1, nxt);
        const char* nA = has_next ? (const char*)g.A + (size_t)nxt.pm * tstep + (size_t)nxt.ko * 2 : cA; const char* nB = has_next ? (const char*)g.Bt + (size_t)nxt.pb * tstep + (size_t)nxt.ko * 2 : cB;
        for (int t = 0; t < nt; t += 2) {
            const bool last = (t == nt - 2);
            const char* a1 = cA + (size_t)(t + 1) * kstep;
            const char* a2 = last ? nA : cA + (size_t)(t + 2) * kstep; const char* b2 = last ? nB : cB + (size_t)(t + 2) * kstep;
            const char* a3 = a2 + kstep; const char* b3 = b2 + kstep;
            if constexpr (SP2) {
            PG8_LDB(B0, 0, 0); PG8_LDB(B1, 0, 1); PG8_SCHED; PG8_LDA(At, 0, 0); PG8_STAGE(PG8_SA(1, 1), a1 + hstep, voffA);
            PG8_WAIT_V(8); PG8_WAIT_L(0); PG8_BAR; PG8_MMA(0, 0, At, B0); PG8_MMA(0, 1, At, B1); PG8_BAR; PG8_SCHED;
            PG8_LDA(At, 0, 1); PG8_STAGE(PG8_SB(0, 0), b2, voffB); PG8_STAGE(PG8_SB(0, 1), b2 + hstep, voffB); PG8_STAGE(PG8_SA(0, 0), a2, voffA);
            PG8_WAIT_V(8); PG8_WAIT_L(0); PG8_BAR; PG8_MMA(1, 0, At, B0); PG8_MMA(1, 1, At, B1); PG8_BAR; PG8_SCHED;
            PG8_LDB(B0, 1, 0); PG8_LDB(B1, 1, 1); PG8_SCHED; PG8_LDA(At, 1, 0); PG8_STAGE(PG8_SA(0, 1), a2 + hstep, voffA);
            PG8_WAIT_V(8); PG8_WAIT_L(0); PG8_BAR; PG8_MMA(0, 0, At, B0); PG8_MMA(0, 1, At, B1); PG8_BAR; PG8_SCHED;
            PG8_LDA(At, 1, 1); PG8_STAGE(PG8_SB(1, 0), b3, voffB); PG8_STAGE(PG8_SB(1, 1), b3 + hstep, voffB); PG8_STAGE(PG8_SA(1, 0), a3, voffA);
            PG8_WAIT_V(8); PG8_WAIT_L(0); PG8_BAR; PG8_MMA(1, 0, At, B0); PG8_MMA(1, 1, At, B1); PG8_BAR; PG8_SCHED;
            } else {
            PG8_LDB(B0, 0, 0); PG8_SCHED; PG8_LDA(At, 0, 0); PG8_STAGE(PG8_SA(1, 1), a1 + hstep, voffA);
            PG8_WAIT_L(8); PG8_BAR; PG8_WAIT_L(0); PG8_MMA(0, 0, At, B0); PG8_BAR; PG8_SCHED;
            PG8_LDB(B1, 0, 1); PG8_STAGE(PG8_SB(0, 0), b2, voffB);
            PG8_BAR; PG8_WAIT_L(0); PG8_MMA(0, 1, At, B1); PG8_BAR;
            PG8_LDA(At, 0, 1); PG8_STAGE(PG8_SA(0, 0), a2, voffA);
            PG8_BAR; PG8_WAIT_L(0); PG8_MMA(1, 0, At, B0); PG8_BAR; PG8_SCHED;
            PG8_STAGE(PG8_SB(0, 1), b2 + hstep, voffB);
            PG8_WAIT_V(6); PG8_BAR; PG8_MMA(1, 1, At, B1); PG8_BAR;
            PG8_LDB(B0, 1, 0); PG8_SCHED; PG8_LDA(At, 1, 0); PG8_STAGE(PG8_SA(0, 1), a2 + hstep, voffA);
            PG8_WAIT_L(8); PG8_BAR; PG8_WAIT_L(0); PG8_MMA(0, 0, At, B0); PG8_BAR; PG8_SCHED;
            PG8_LDB(B1, 1, 1); PG8_STAGE(PG8_SB(1, 0), b3, voffB);
            PG8_BAR; PG8_WAIT_L(0); PG8_MMA(0, 1, At, B1); PG8_BAR;
            PG8_LDA(At, 1, 1); PG8_STAGE(PG8_SA(1, 0), a3, voffA);
            PG8_BAR; PG8_WAIT_L(0); PG8_MMA(1, 0, At, B0); PG8_BAR; PG8_SCHED;
            PG8_STAGE(PG8_SB(1, 1), b3 + hstep, voffB);
            PG8_WAIT_V(6); PG8_BAR; PG8_MMA(1, 1, At, B1); PG8_BAR;
            }
        }
        if constexpr (ALIGN_EPI) { if (wr == 0) PG8_BAR; }
        if constexpr (FP8 || I8) asm volatile("s_nop 15\n\ts_nop 7" ::: "memory");
        if constexpr (I8) {
#pragma unroll
            for (int a = 0; a < 2; ++a)
#pragma unroll
                for (int b = 0; b < 2; ++b)
#pragma unroll
                    for (int m = 0; m < 4; ++m)
#pragma unroll
                        for (int n = 0; n < 2; ++n)
#pragma unroll
                            for (int j = 0; j < 4; ++j) { const float t = acc[a][b][m][n][j]; acc[a][b][m][n][j] = (float)__float_as_int(t); }
        }
        { Unit eu = cur; asm volatile("" : "+s"(eu.pm), "+s"(eu.pn));
          if constexpr (EpiScales<Epi>::value) E(acc, eu, wr, wc, fr, fq, (const PG8_LAS float*)(lds + SCALE_OFF + (ui & 1) * 2048));
          else E(acc, eu, wr, wc, fr, fq); }
        if (!has_next) break;
#pragma unroll
        for (int a = 0; a < 2; ++a)
#pragma unroll
            for (int b = 0; b < 2; ++b)
#pragma unroll
                for (int m = 0; m < 4; ++m)
#pragma unroll
                    for (int n = 0; n < 2; ++n) acc[a][b][m][n] = (f32x4){0.f, 0.f, 0.f, 0.f};
        cur = nxt; cA = nA; cB = nB; ++ui;
        PG8_SCALES(cur, ui & 1);
        if constexpr (ALIGN_EPI) { if (wr == 1) PG8_BAR; }
    }
    PG8_WAIT_V(0);
    if constexpr (!ALIGN_EPI) { if (wr == 0) PG8_BAR; }
    PG8_BAR;
#undef PG8_SCALES
#undef PG8_SA
#undef PG8_SB
#undef PG8_STAGE
#undef PG8_LDA
#undef PG8_LDB
#undef PG8_MMA
#undef PG8_CAT2
#undef PG8_RD
#undef PG8_WAIT_V
#undef PG8_WAIT_L
#undef PG8_BAR
#undef PG8_SCHED
}
}

constexpr int NWAVES = 8, NTHR = 512;
constexpr int D = 1024, NB = 16, T = 2048, CT = 256;
constexpr int NL = NB * T;
constexpr int NC = NB * CT;
constexpr int NT = NL + NC;
constexpr int RW = 1792, HG = 2560, RIN = RW + HG;
constexpr int AW = 512;
constexpr int FF = 2816, FF2 = 2 * FF;
constexpr int QKVW = 1536;
constexpr int NEXP = 8;
constexpr int MAXPAN = 264;
constexpr int CHUNK_PAN = 128;
constexpr float NORM_EPS = 1e-6f, GN_EPS = 64e-5f;
constexpr float LOG2E = 1.4426950408889634f;

constexpr size_t MiB = 1u << 20;
constexpr size_t WS_CTL = 0, CTL_ZERO_BYTES = 1 * MiB;
constexpr size_t WS_MODS = 1 * MiB;
constexpr size_t WS_MISC = 2 * MiB;
constexpr size_t WS_ROPE = WS_MISC;
constexpr size_t WS_RCNT = WS_MISC + 8192;
constexpr size_t WS_PEXP = WS_MISC + 16384;
constexpr size_t WS_NPAN = WS_MISC + 18432;
constexpr size_t WS_TOPE = WS_MISC + 32768;
constexpr size_t WS_TOPW = WS_TOPE + (size_t)NL * 8;
constexpr size_t WS_SLOT = WS_TOPW + (size_t)NL * 8;
constexpr size_t WS_SA = 3 * MiB;
constexpr size_t WS_SW = WS_SA + (size_t)NT * 4;
constexpr size_t WS_SWIN = WS_SW + (size_t)FF2 * 4;
constexpr size_t WS_SWAI = WS_SWIN + (size_t)RIN * 4;
constexpr size_t WS_AMAX = 256 * 1024;
constexpr int AMAX_GU = RIN, AMAX_AI = RIN + FF2;
static_assert(WS_SLOT + (size_t)NL * 8 <= WS_SA && WS_SWAI + (size_t)QKVW * 4 <= 4 * MiB && WS_AMAX + (size_t)(RIN + FF2 + QKVW) * 4 <= CTL_ZERO_BYTES, "misc");
constexpr size_t WS_WIN = 4 * MiB;
constexpr size_t WS_WLORA = WS_WIN + (size_t)RIN * D * 2;
constexpr size_t WS_WOUT0 = WS_WLORA + (size_t)2048 * 256 * 2;
constexpr size_t WS_WGU0 = WS_WOUT0 + (size_t)D * D * 2;
constexpr size_t WS_WD0 = WS_WGU0 + (size_t)FF2 * D * 2;
constexpr size_t WS_WATTIN = WS_WD0 + (size_t)D * FF * 2;
constexpr size_t WS_WATTOUT = WS_WATTIN + (size_t)QKVW * D * 2;
static_assert(WS_WATTOUT + (size_t)D * D * 2 <= 38 * MiB, "weights");
constexpr size_t WS_PHG = 38 * MiB;
constexpr size_t WS_H0 = 218 * MiB;
constexpr size_t WS_R = 218 * MiB, WS_KS = 254 * MiB, WS_V = 290 * MiB, WS_KK = 326 * MiB, WS_LB = 362 * MiB;
constexpr size_t WS_BB = 380 * MiB;
constexpr size_t WS_OF = 416 * MiB, WS_OB = 452 * MiB;
constexpr size_t WS_YMIX = 326 * MiB;
constexpr size_t WS_X1C = 308 * MiB;
constexpr size_t WS_X2 = 326 * MiB, WS_X2C = 390 * MiB;
constexpr size_t WS_F = 38 * MiB;
constexpr size_t WS_HFF = 110 * MiB;
constexpr size_t WS_H1 = 38 * MiB;
constexpr size_t WS_WMGU = 446 * MiB;
constexpr size_t WS_WMD = 490 * MiB;
constexpr size_t WS_QKV = 110 * MiB;
constexpr size_t WS_OATT = 218 * MiB;
constexpr size_t WS_FLAT = 170 * MiB;
constexpr size_t WS_ASORT = 38 * MiB;
constexpr size_t WS_A8 = 362 * MiB;
constexpr size_t WS_HMOE = 170 * MiB;
constexpr size_t WS_END = 512 * MiB;
static_assert(WS_WMD + (size_t)NEXP * D * FF <= WS_END && WS_WMGU + (size_t)NEXP * FF2 * D <= WS_WMD, "moe weights");
static_assert(WS_PHG + (size_t)NT * HG * 2 <= WS_H0 && WS_H0 + (size_t)NT * D * 2 <= WS_V, "layer0 a");
static_assert(WS_LB + (size_t)NT * 256 * 2 <= WS_BB && WS_BB + (size_t)NT * AW * 2 <= WS_OF && WS_OB + (size_t)NT * AW * 2 <= WS_END, "layer0 b");
static_assert(WS_HFF + (size_t)NT * FF * 2 <= WS_X1C && WS_X1C + (size_t)NC * D * 4 <= WS_YMIX, "layer0 c");
static_assert(WS_ASORT + (size_t)MAXPAN * 256 * D * 2 <= WS_HMOE && WS_HMOE + (size_t)MAXPAN * 256 * FF <= WS_A8 && WS_A8 + (size_t)MAXPAN * 256 * D <= WS_WMGU && WS_FLAT + (size_t)NL * D <= WS_A8, "moe bufs");
static_assert(WS_QKV + (size_t)NT * QKVW * 2 <= WS_OATT && WS_OATT + (size_t)NL * D * 2 <= WS_A8, "layer1");
constexpr size_t DO_PRW = 0, DO_LWF = 0, DO_LWB = 36 * MiB, DO_GG = 72 * MiB, DO_OHF = 0, DO_OHB = 36 * MiB;
static_assert((size_t)NT * RW * 2 <= 128 * MiB, "P_rwkv in d_out");

constexpr int CW_BAR = 4096;

constexpr int RING_BYTES = 147456;
constexpr int LDSCTL_OFF = RING_BYTES, MISC_OFF = LDSCTL_OFF + 320;
constexpr int LDS_BYTES = RING_BYTES + 1024;

#define GAS __attribute__((address_space(1)))
#define LAS __attribute__((address_space(3)))
typedef unsigned short bf16;
typedef unsigned v4u __attribute__((ext_vector_type(4)));
typedef unsigned v2u __attribute__((ext_vector_type(2)));
typedef float f32x4 __attribute__((ext_vector_type(4)));
typedef float f32x2 __attribute__((ext_vector_type(2)));
typedef float f32x16 __attribute__((ext_vector_type(16)));
typedef short bf16x8 __attribute__((ext_vector_type(8)));
typedef short s16x4 __attribute__((ext_vector_type(4)));
typedef __bf16 bf16x2_t __attribute__((ext_vector_type(2)));
#define LDS_WAIT() asm volatile("s_waitcnt lgkmcnt(0)" ::: "memory")
__device__ __forceinline__ unsigned pk2(float lo, float hi) { f32x2 v = {lo, hi}; bf16x2_t b = __builtin_convertvector(v, bf16x2_t); return __builtin_bit_cast(unsigned, b); }
__device__ __forceinline__ unsigned pk4_fp8(float a, float b, float c, float d) {
    a = fminf(fmaxf(a, -448.f), 448.f); b = fminf(fmaxf(b, -448.f), 448.f); c = fminf(fmaxf(c, -448.f), 448.f); d = fminf(fmaxf(d, -448.f), 448.f);
    int p = __builtin_amdgcn_cvt_pk_fp8_f32(a, b, 0, false); p = __builtin_amdgcn_cvt_pk_fp8_f32(c, d, p, true); return (unsigned)p;
}
__device__ __forceinline__ float bflo(unsigned u) { return __uint_as_float(u << 16); }
__device__ __forceinline__ float bfhi(unsigned u) { return __uint_as_float(u & 0xffff0000u); }
__device__ __forceinline__ float fsigmoid(float x) { return __builtin_amdgcn_rcpf(1.f + __expf(-x)); }
__device__ __forceinline__ float fsilu(float x) { return x * fsigmoid(x); }
__device__ __forceinline__ float ftanh(float x) { return 1.f - 2.f * __builtin_amdgcn_rcpf(1.f + __expf(2.f * x)); }
__device__ __forceinline__ float wave_sum(float v) {
#pragma unroll
    for (int o = 1; o < 64; o <<= 1) v += __shfl_xor(v, o);
    return v;
}
template <int CTRL> __device__ __forceinline__ float dpp_f(float v) { return __builtin_bit_cast(float, __builtin_amdgcn_update_dpp(0, __builtin_bit_cast(int, v), CTRL, 0xf, 0xf, true)); }
__device__ __forceinline__ float sum8(float v) { v += dpp_f<0xB1>(v); v += dpp_f<0x4E>(v); v += dpp_f<0x141>(v); return v; }
__device__ __forceinline__ float sum16(float v) { v = sum8(v); v += dpp_f<0x140>(v); return v; }

#define XB_TMO      128
#define XB_XCNT(j)  (256  + 64 * (j))
#define XB_XSUB(j)  (1280 + 64 * (j))
#define XB_XGEN(j)  (2304 + 64 * (j))
#define XB_TOP      3328
#define XB_TOPGEN   3392
#define XCD_BAR_WORDS 3456
#define XB_SPIN_CAP (1u << 18)
__device__ __forceinline__ unsigned xb_ld(unsigned* p)              { return __hip_atomic_load(p, __ATOMIC_RELAXED, __HIP_MEMORY_SCOPE_AGENT); }
__device__ __forceinline__ unsigned xb_add(unsigned* p, unsigned v) { return __hip_atomic_fetch_add(p, v, __ATOMIC_RELAXED, __HIP_MEMORY_SCOPE_AGENT); }
__device__ __forceinline__ unsigned xb_xcc_id() { return (unsigned)__builtin_amdgcn_s_getreg((3 << 11) | 20) & 0xFu; }
#define XB_SPIN(cond, bar) do { unsigned _sp = 0; while (cond) { __builtin_amdgcn_s_sleep(1); \
    if ((++_sp & 255u) == 0u) { if (xb_ld(&(bar)[XB_TMO])) break; if (_sp > XB_SPIN_CAP) { atomicAdd(&(bar)[XB_TMO], 1u); break; } } } } while (0)
struct XcdBarrier { unsigned* bar; unsigned x; volatile LAS unsigned* st; };
__device__ __forceinline__ XcdBarrier xcd_barrier_post(unsigned* bar, volatile LAS unsigned* st) {
    XcdBarrier b; b.bar = bar; b.x = xb_xcc_id(); b.st = st;
    if (threadIdx.x == 0) (void)xb_add(&bar[XB_XCNT(b.x)], 1u);
    return b;
}
__device__ __forceinline__ void xcd_barrier_complete(unsigned* bar, unsigned x, unsigned& nloc, unsigned& nx) {
    const unsigned G = gridDim.x * gridDim.y * gridDim.z;
    unsigned sum, cnt, mine, sp = 0u;
    for (;;) {
        sum = 0u; cnt = 0u; mine = 0u;
#pragma unroll
        for (unsigned j = 0; j < 16; ++j) { const unsigned c = xb_ld(&bar[XB_XCNT(j)]); sum += c; cnt += (c > 0u) ? 1u : 0u; mine = (j == x) ? c : mine; }
        if (sum == G) break;
        __builtin_amdgcn_s_sleep(1);
        if ((++sp & 255u) == 0u) { if (xb_ld(&bar[XB_TMO])) break; if (sp > XB_SPIN_CAP) { atomicAdd(&bar[XB_TMO], 1u); break; } }
    }
    nloc = mine > 0u ? mine : 1u; nx = cnt > 0u ? cnt : 1u;
}
__device__ __forceinline__ void xcd_barrier(const XcdBarrier& b) {
    asm volatile("s_waitcnt vmcnt(0)" ::: "memory");
    __syncthreads();
    if (threadIdx.x == 0) {
        unsigned* bar = b.bar;
        __builtin_amdgcn_s_waitcnt(0);
        unsigned nloc = b.st[0], nx = b.st[1];
        if (nloc == 0u) { xcd_barrier_complete(bar, b.x, nloc, nx); b.st[0] = nloc; b.st[1] = nx; }
        const unsigned old = xb_add(&bar[XB_XSUB(b.x)], 1u);
        const unsigned gen = old / nloc;
        if (old + 1u == (gen + 1u) * nloc) {
            __builtin_amdgcn_fence(__ATOMIC_RELEASE, "agent");
            asm volatile("s_waitcnt vmcnt(0)" ::: "memory");
            const unsigned og = xb_add(&bar[XB_TOP], 1u);
            const unsigned tg = og / nx;
            if (og + 1u == (tg + 1u) * nx) xb_add(&bar[XB_TOPGEN], 1u);
            else XB_SPIN(xb_ld(&bar[XB_TOPGEN]) == tg, bar);
            __builtin_amdgcn_fence(__ATOMIC_ACQUIRE, "agent");
            xb_add(&bar[XB_XGEN(b.x)], 1u);
            asm volatile("s_waitcnt vmcnt(0)" ::: "memory");
        } else {
            XB_SPIN(xb_ld(&bar[XB_XGEN(b.x)]) == gen, bar);
            __builtin_amdgcn_fence(__ATOMIC_ACQUIRE, "agent");
            asm volatile("s_waitcnt vmcnt(0)" ::: "memory");
        }
    }
    __syncthreads();
}

struct Args { const float* in[35]; float* out; unsigned char* ws; int ph_lo, ph_hi; };
enum InIdx { I_X = 0, I_C, I_CTX, I_CCTX, I_MODW, I_MODB, I_NMIX, I_NFFN, I_NFIN, I_RWIN, I_RWOUT, I_MU, I_W0, I_WUP, I_A0, I_AUP, I_GUP, I_KK, I_KA, I_RK, I_LNW, I_LNB,
             I_HLB, I_HNORM, I_FG, I_FU, I_FD, I_AWIN, I_AWOUT, I_SINK, I_ROUTER, I_ROUTERB, I_MG, I_MU2, I_MD };
struct Frame {
    LAS unsigned char* lds;
    int tid, lane, wave, G, bid;
    float* out; unsigned char* ws;
};

namespace epi {
using pg8::Unit; using pg8::f32x4; using pg8::u32x4; using pg8::u32x2; using pg8::bf16_t; using pg8::HALF; using pg8::BM;
__device__ __forceinline__ u32x4 pack8(const f32x4& v0, const f32x4& v1) { u32x4 w; w.x = pk2(v0[0], v0[1]); w.y = pk2(v0[2], v0[3]); w.z = pk2(v1[0], v1[1]); w.w = pk2(v1[2], v1[3]); return w; }

struct EpiP {
    static constexpr bool PERM = true;
    bf16_t* P0; bf16_t* P1;
    __device__ __forceinline__ void operator()(const f32x4 (&acc)[2][2][4][2], const Unit& u, int wr, int wc, int fr, int fq) const {
        const int row0 = u.pm * BM + wr * 64 + fr; int colt = u.pn * BM; bf16_t* base = P0; int ld = RW;
        if (u.pn >= RW / 256) { base = P1; ld = HG; colt -= RW; }
        const int col0 = colt + wc * 32 + 8 * fq;
#pragma unroll
        for (int ai = 0; ai < 2; ++ai)
#pragma unroll
            for (int m = 0; m < 4; ++m) { bf16_t* rowp = base + (size_t)(row0 + ai * HALF + m * 16) * ld + col0;
#pragma unroll
                for (int bj = 0; bj < 2; ++bj) *(u32x4*)(rowp + bj * HALF) = pack8(acc[ai][bj][m][0], acc[ai][bj][m][1]); }
    }
};

struct EpiPQ {
    static constexpr bool PERM = true;
    static constexpr bool LDS_SCALES = true;
    bf16_t* P0; bf16_t* P1; const float* sA; const float* sW;
    __device__ __forceinline__ void operator()(const f32x4 (&acc)[2][2][4][2], const Unit& u, int wr, int wc, int fr, int fq, const LAS float* sl) const {
        const int row0 = u.pm * BM + wr * 64 + fr; int colt = u.pn * BM; bf16_t* base = P0; int ld = RW;
        if (u.pn >= RW / 256) { base = P1; ld = HG; colt -= RW; }
        const int col0 = colt + wc * 32 + 8 * fq; const LAS float* sw = sl + 256 + wc * 32 + 8 * fq; const LAS float* sr = sl + wr * 64 + fr;
        f32x4 sv[2][2];
#pragma unroll
        for (int bj = 0; bj < 2; ++bj)
#pragma unroll
            for (int n = 0; n < 2; ++n) sv[bj][n] = *(const LAS f32x4*)(sw + bj * HALF + n * 4);
#pragma unroll
        for (int ai = 0; ai < 2; ++ai)
#pragma unroll
            for (int m = 0; m < 4; ++m) { bf16_t* rowp = base + (size_t)(row0 + ai * HALF + m * 16) * ld + col0; const float ra = sr[ai * HALF + m * 16];
#pragma unroll
                for (int bj = 0; bj < 2; ++bj) *(u32x4*)(rowp + bj * HALF) = pack8(acc[ai][bj][m][0] * (sv[bj][0] * ra), acc[ai][bj][m][1] * (sv[bj][1] * ra)); }
    }
};

struct EpiLora {
    static constexpr bool PERM = true;
    const float* w0; const float* a0; const float* k_a;
    bf16_t* LWF; bf16_t* LWB; bf16_t* KS; const bf16_t* KK; bf16_t* BB; bf16_t* GG;
    __device__ __forceinline__ void operator()(const f32x4 (&acc)[2][2][4][2], const Unit& u, int wr, int wc, int fr, int fq) const {
        const int row0 = u.pm * BM + wr * 64 + fr; const int q = u.pn >> 1;
        const int cc0 = (u.pn & 1) * 256 + wc * 32 + 8 * fq;
#pragma unroll
        for (int bj = 0; bj < 2; ++bj) { const int cc = cc0 + bj * HALF;
            if (q < 2) {
                const f32x4 z0 = *(const f32x4*)(w0 + q * AW + cc), z1 = *(const f32x4*)(w0 + q * AW + cc + 4); bf16_t* O = q ? LWB : LWF;
#pragma unroll
                for (int ai = 0; ai < 2; ++ai)
#pragma unroll
                    for (int m = 0; m < 4; ++m) { f32x4 v0 = acc[ai][bj][m][0] + z0, v1 = acc[ai][bj][m][1] + z1;
#pragma unroll
                        for (int j = 0; j < 4; ++j) { v0[j] = -0.6065306597f * fsigmoid(v0[j]); v1[j] = -0.6065306597f * fsigmoid(v1[j]); }
                        *(u32x4*)(O + (size_t)(row0 + ai * HALF + m * 16) * AW + cc) = pack8(v0, v1); asm volatile("" ::: "memory"); }
            } else if (q == 2) {
                const f32x4 z0 = *(const f32x4*)(a0 + cc), z1 = *(const f32x4*)(a0 + cc + 4), ka0 = *(const f32x4*)(k_a + cc), ka1 = *(const f32x4*)(k_a + cc + 4);
#pragma unroll
                for (int ai = 0; ai < 2; ++ai)
#pragma unroll
                    for (int m = 0; m < 4; ++m) { const size_t off = (size_t)(row0 + ai * HALF + m * 16) * AW + cc;
                        f32x4 a_0 = acc[ai][bj][m][0] + z0, a_1 = acc[ai][bj][m][1] + z1;
                        const u32x4 kw = *(const u32x4*)(KS + off), kkw = *(const u32x4*)(KK + off);
                        f32x4 k0 = {bflo(kw.x), bfhi(kw.x), bflo(kw.y), bfhi(kw.y)}, k1 = {bflo(kw.z), bfhi(kw.z), bflo(kw.w), bfhi(kw.w)};
                        f32x4 q0 = {bflo(kkw.x), bfhi(kkw.x), bflo(kkw.y), bfhi(kkw.y)}, q1 = {bflo(kkw.z), bfhi(kkw.z), bflo(kkw.w), bfhi(kkw.w)};
#pragma unroll
                        for (int j = 0; j < 4; ++j) { const float s0 = fsigmoid(a_0[j]), s1 = fsigmoid(a_1[j]);
                            k0[j] = k0[j] * (1.f + (s0 - 1.f) * ka0[j]); k1[j] = k1[j] * (1.f + (s1 - 1.f) * ka1[j]); q0[j] *= s0; q1[j] *= s1; }
                        *(u32x4*)(KS + off) = pack8(k0, k1); *(u32x4*)(BB + off) = pack8(q0, q1); asm volatile("" ::: "memory"); }
            } else {
#pragma unroll
                for (int ai = 0; ai < 2; ++ai)
#pragma unroll
                    for (int m = 0; m < 4; ++m) *(u32x4*)(GG + (size_t)(row0 + ai * HALF + m * 16) * AW + cc) = pack8(acc[ai][bj][m][0], acc[ai][bj][m][1]);
            }
        }
    }
};

template <bool R16, bool O16>
struct EpiResT {
    static constexpr bool PERM = true;
    const void* resL; void* outL; const void* resC; void* outC; const float* gateBase; int ldo; float ys = 1.f;
    __device__ __forceinline__ void operator()(const f32x4 (&acc)[2][2][4][2], const Unit& u, int wr, int wc, int fr, int fq) const {
        const bool lat = u.pm < NL / 256; const int s = lat ? (u.pm >> 3) : NB;
        const void* res = lat ? resL : resC; void* out = lat ? outL : outC; const int prow = lat ? u.pm : u.pm - NL / 256;
        const int row0 = prow * BM + wr * 64 + fr, col0 = u.pn * BM + wc * 32 + 8 * fq;
        const float* gate = gateBase + (size_t)s * 6144 + col0;
        f32x4 gv[2][2];
#pragma unroll
        for (int bj = 0; bj < 2; ++bj)
#pragma unroll
            for (int n = 0; n < 2; ++n) gv[bj][n] = *(const f32x4*)(gate + bj * HALF + n * 4) * ys;
#pragma unroll
        for (int ai = 0; ai < 2; ++ai)
#pragma unroll
            for (int m = 0; m < 4; ++m) { const size_t off = (size_t)(row0 + ai * HALF + m * 16) * D + col0, offo = (size_t)(row0 + ai * HALF + m * 16) * ldo + col0;
#pragma unroll
                for (int bj = 0; bj < 2; ++bj) { f32x4 r0, r1;
                    if constexpr (R16) { const u32x4 w = *(const u32x4*)((const bf16_t*)res + off + bj * HALF); r0 = (f32x4){bflo(w.x), bfhi(w.x), bflo(w.y), bfhi(w.y)}; r1 = (f32x4){bflo(w.z), bfhi(w.z), bflo(w.w), bfhi(w.w)}; }
                    else { r0 = __builtin_nontemporal_load((const f32x4*)((const float*)res + off + bj * HALF)); r1 = __builtin_nontemporal_load((const f32x4*)((const float*)res + off + bj * HALF + 4)); }
                    const f32x4 v0 = r0 + gv[bj][0] * acc[ai][bj][m][0], v1 = r1 + gv[bj][1] * acc[ai][bj][m][1];
                    if constexpr (O16) *(u32x4*)((bf16_t*)out + offo + bj * HALF) = pack8(v0, v1);
                    else { *(f32x4*)((float*)out + offo + bj * HALF) = v0; *(f32x4*)((float*)out + offo + bj * HALF + 4) = v1; } }
                asm volatile("" ::: "memory"); }
    }
};

struct EpiResAtomic {
    static constexpr bool PERM = false;
    float* outC; const float* gate;
    __device__ __forceinline__ void operator()(const f32x4 (&acc)[2][2][4][2], const Unit& u, int wr, int wc, int fr, int fq) const {
        const int row0 = u.pm * BM + wr * 64 + fr, col0 = u.pn * BM + wc * 32 + 4 * fq;
#pragma unroll
        for (int bj = 0; bj < 2; ++bj)
#pragma unroll
            for (int n = 0; n < 2; ++n) { const f32x4 gv = *(const f32x4*)(gate + col0 + bj * HALF + n * 16);
#pragma unroll
                for (int ai = 0; ai < 2; ++ai)
#pragma unroll
                    for (int m = 0; m < 4; ++m) { float* p = outC + (size_t)(row0 + ai * HALF + m * 16) * D + col0 + bj * HALF + n * 16;
#pragma unroll
                        for (int j = 0; j < 4; ++j) __hip_atomic_fetch_add(p + j, gv[j] * acc[ai][bj][m][n][j], __ATOMIC_RELAXED, __HIP_MEMORY_SCOPE_AGENT); } }
    }
};
struct EpiPartY {
    static constexpr bool PERM = false;
    float* Yp;
    __device__ __forceinline__ void operator()(const f32x4 (&acc)[2][2][4][2], const Unit& u, int wr, int wc, int fr, int fq) const {
        const int row0 = u.pm * BM + wr * 64 + fr, col0 = u.pn * BM + wc * 32 + 4 * fq; float* base = Yp + (size_t)(u.ko >> 8) * ((size_t)(MAXPAN - 2 * CHUNK_PAN) * 256 * D);
#pragma unroll
        for (int ai = 0; ai < 2; ++ai)
#pragma unroll
            for (int m = 0; m < 4; ++m)
#pragma unroll
                for (int bj = 0; bj < 2; ++bj)
#pragma unroll
                    for (int n = 0; n < 2; ++n) *(f32x4*)(base + (size_t)(row0 + ai * HALF + m * 16) * D + col0 + bj * HALF + n * 16) = acc[ai][bj][m][n];
    }
};

struct EpiSwiGLU {
    static constexpr bool PERM = true;
    bf16_t* H;
    __device__ __forceinline__ void operator()(const f32x4 (&acc)[2][2][4][2], const Unit& u, int wr, int wc, int fr, int fq) const {
        const int row0 = u.pm * BM + wr * 64 + fr, col0 = u.pn * HALF + wc * 32 + 8 * fq;
#pragma unroll
        for (int ai = 0; ai < 2; ++ai)
#pragma unroll
            for (int m = 0; m < 4; ++m) { f32x4 v0, v1;
#pragma unroll
                for (int j = 0; j < 4; ++j) { v0[j] = fsilu(acc[ai][0][m][0][j]) * acc[ai][1][m][0][j]; v1[j] = fsilu(acc[ai][0][m][1][j]) * acc[ai][1][m][1][j]; }
                *(u32x4*)(H + (size_t)(row0 + ai * HALF + m * 16) * FF + col0) = pack8(v0, v1); }
    }
};

__device__ __forceinline__ f32x4 swiglu4(const f32x4 ag, const f32x4 au, const f32x4 karg, const f32x4 kprod) {
    f32x4 e = ag * karg;
#pragma unroll
    for (int j = 0; j < 4; ++j) e[j] = __builtin_amdgcn_exp2f(e[j]);
    e = e + 1.f;
#pragma unroll
    for (int j = 0; j < 4; ++j) e[j] = __builtin_amdgcn_rcpf(e[j]);
    return (ag * au) * kprod * e;
}
struct EpiSwiGLU8 {
    static constexpr bool PERM = true;
    unsigned char* H; float inv, hs;
    __device__ __forceinline__ void operator()(const f32x4 (&acc)[2][2][4][2], const Unit& u, int wr, int wc, int fr, int fq) const {
        const int row0 = u.pm * BM + wr * 64 + fr, col0 = u.pn * HALF + wc * 32 + 8 * fq;
#pragma unroll
        for (int ai = 0; ai < 2; ++ai)
#pragma unroll
            for (int m = 0; m < 4; ++m) { const float ka = -LOG2E * inv, kp = inv * inv * hs;
                const f32x4 v0 = swiglu4(acc[ai][0][m][0], acc[ai][1][m][0], (f32x4){ka, ka, ka, ka}, (f32x4){kp, kp, kp, kp}), v1 = swiglu4(acc[ai][0][m][1], acc[ai][1][m][1], (f32x4){ka, ka, ka, ka}, (f32x4){kp, kp, kp, kp});
                u32x2 w; w.x = pk4_fp8(v0[0], v0[1], v0[2], v0[3]); w.y = pk4_fp8(v1[0], v1[1], v1[2], v1[3]);
                *(u32x2*)(H + (size_t)(row0 + ai * HALF + m * 16) * FF + col0) = w; asm volatile("" ::: "memory"); }
    }
};
struct EpiSwiGLUQ {
    static constexpr bool PERM = true;
    static constexpr bool LDS_SCALES = true;
    unsigned char* H; const float* sA; const float* sW; float hs;
    __device__ __forceinline__ void operator()(const f32x4 (&acc)[2][2][4][2], const Unit& u, int wr, int wc, int fr, int fq, const LAS float* sl) const {
        const int row0 = u.pm * BM + wr * 64 + fr, col0 = u.pn * HALF + wc * 32 + 8 * fq; const LAS float* sw = sl + 256 + wc * 32 + 8 * fq; const LAS float* sr = sl + wr * 64 + fr;
        const f32x4 sg0 = *(const LAS f32x4*)sw, sg1 = *(const LAS f32x4*)(sw + 4), su0 = *(const LAS f32x4*)(sw + HALF) * hs, su1 = *(const LAS f32x4*)(sw + HALF + 4) * hs;
        const f32x4 kg0 = sg0 * -LOG2E, kg1 = sg1 * -LOG2E, kp0 = sg0 * su0, kp1 = sg1 * su1;
#pragma unroll
        for (int ai = 0; ai < 2; ++ai)
#pragma unroll
            for (int m = 0; m < 4; ++m) { const float ra = sr[ai * HALF + m * 16], ra2 = ra * ra;
                const f32x4 v0 = swiglu4(acc[ai][0][m][0], acc[ai][1][m][0], kg0 * ra, kp0 * ra2), v1 = swiglu4(acc[ai][0][m][1], acc[ai][1][m][1], kg1 * ra, kp1 * ra2);
                u32x2 w; w.x = pk4_fp8(v0[0], v0[1], v0[2], v0[3]); w.y = pk4_fp8(v1[0], v1[1], v1[2], v1[3]);
                *(u32x2*)(H + (size_t)(row0 + ai * HALF + m * 16) * FF + col0) = w; asm volatile("" ::: "memory"); }
    }
};
struct EpiBf16S {
    static constexpr bool PERM = true;
    bf16_t* O; int ld; float s;
    __device__ __forceinline__ void operator()(const f32x4 (&acc)[2][2][4][2], const Unit& u, int wr, int wc, int fr, int fq) const {
        const int row0 = u.pm * BM + wr * 64 + fr, col0 = u.pn * BM + wc * 32 + 8 * fq;
#pragma unroll
        for (int ai = 0; ai < 2; ++ai)
#pragma unroll
            for (int m = 0; m < 4; ++m) { bf16_t* rowp = O + (size_t)(row0 + ai * HALF + m * 16) * ld + col0;
#pragma unroll
                for (int bj = 0; bj < 2; ++bj) *(u32x4*)(rowp + bj * HALF) = pack8(acc[ai][bj][m][0] * s, acc[ai][bj][m][1] * s); }
    }
};
struct EpiBf16 {
    static constexpr bool PERM = true;
    bf16_t* O; int ld;
    __device__ __forceinline__ void operator()(const f32x4 (&acc)[2][2][4][2], const Unit& u, int wr, int wc, int fr, int fq) const {
        const int row0 = u.pm * BM + wr * 64 + fr, col0 = u.pn * BM + wc * 32 + 8 * fq;
#pragma unroll
        for (int ai = 0; ai < 2; ++ai)
#pragma unroll
            for (int m = 0; m < 4; ++m) { bf16_t* rowp = O + (size_t)(row0 + ai * HALF + m * 16) * ld + col0;
#pragma unroll
                for (int bj = 0; bj < 2; ++bj) *(u32x4*)(rowp + bj * HALF) = pack8(acc[ai][bj][m][0], acc[ai][bj][m][1]); }
    }
};

template <bool QS>
struct EpiQKVT {
    static constexpr bool PERM = true;
    static constexpr bool LDS_SCALES = QS;
    bf16_t* O; const float* rope; const float* sA = nullptr; const float* sW = nullptr;
    __device__ __forceinline__ void operator()(const f32x4 (&acc)[2][2][4][2], const Unit& u, int wr, int wc, int fr, int fq, const LAS float* sl = nullptr) const {
        const int row0 = u.pm * BM + wr * 64 + fr, col0 = u.pn * BM + wc * 32 + 8 * fq;
        const bool lat = u.pm < NL / 256, isv = u.pn == 5, isq = u.pn < 4;
        const int axis = wc & 1;
        const float qs = isq ? 0.125f * LOG2E : 1.f;
        f32x4 sv[2][2];
        if constexpr (QS) {
#pragma unroll
            for (int bj = 0; bj < 2; ++bj)
#pragma unroll
                for (int n = 0; n < 2; ++n) sv[bj][n] = *(const LAS f32x4*)(sl + 256 + wc * 32 + 8 * fq + bj * HALF + n * 4);
        }
#pragma unroll
        for (int ai = 0; ai < 2; ++ai)
#pragma unroll
            for (int m = 0; m < 4; ++m) { const int row = row0 + ai * HALF + m * 16; bf16_t* rowp = O + (size_t)row * QKVW + col0; float ra = 1.f; if constexpr (QS) ra = sl[wr * 64 + fr + ai * HALF + m * 16];
                f32x4 c0 = {1.f, 0.f, 1.f, 0.f}, c1 = {1.f, 0.f, 1.f, 0.f};
                if (lat && !isv) { const int t = row & (T - 1), pos = axis ? (t & 63) : (t >> 6); const float* rp = rope + (pos * 16 + 4 * fq) * 2; c0 = *(const f32x4*)rp; c1 = *(const f32x4*)(rp + 4); }
#pragma unroll
                for (int bj = 0; bj < 2; ++bj) { f32x4 a = acc[ai][bj][m][0], b = acc[ai][bj][m][1], v0, v1; if constexpr (QS) { a = a * (sv[bj][0] * ra); b = b * (sv[bj][1] * ra); }
                    v0[0] = (a[0] * c0[0] - a[1] * c0[1]) * qs; v0[1] = (a[1] * c0[0] + a[0] * c0[1]) * qs;
                    v0[2] = (a[2] * c0[2] - a[3] * c0[3]) * qs; v0[3] = (a[3] * c0[2] + a[2] * c0[3]) * qs;
                    v1[0] = (b[0] * c1[0] - b[1] * c1[1]) * qs; v1[1] = (b[1] * c1[0] + b[0] * c1[1]) * qs;
                    v1[2] = (b[2] * c1[2] - b[3] * c1[3]) * qs; v1[3] = (b[3] * c1[2] + b[2] * c1[3]) * qs;
                    *(u32x4*)(rowp + bj * HALF) = pack8(v0, v1); } }
    }
};
using EpiQKV = EpiQKVT<false>; using EpiQKVQ = EpiQKVT<true>;
}

__device__ __forceinline__ void tr_item(const float* src, int ldS, int k0, int n0, bf16* dst, int ldD, int drow0, int dcol0, bool rperm, LAS float* scr, int lane) {
    const int c4 = (lane & 7) * 4, r0 = lane >> 3;
    f32x4 v[8];
#pragma unroll
    for (int i = 0; i < 8; ++i) v[i] = *(const f32x4*)(src + (size_t)(k0 + r0 + 8 * i) * ldS + n0 + c4);
#pragma unroll
    for (int i = 0; i < 8; ++i) { LAS float* d = scr + (r0 + 8 * i) * 33;
#pragma unroll
        for (int q = 0; q < 4; ++q) { const int nl = c4 + q, pn = rperm ? (((nl & 15) << 1) | (nl >> 4)) : nl; d[pn] = v[i][q]; } }
    LDS_WAIT(); asm volatile("" ::: "memory");
    const int c = lane & 7;
#pragma unroll
    for (int j = 0; j < 4; ++j) { const int n = (lane >> 3) + 8 * j; const LAS float* s = scr + (8 * c) * 33 + n;
        v4u o; o.x = pk2(s[0 * 33], s[1 * 33]); o.y = pk2(s[2 * 33], s[3 * 33]); o.z = pk2(s[4 * 33], s[5 * 33]); o.w = pk2(s[6 * 33], s[7 * 33]);
        *(v4u*)(dst + (size_t)(drow0 + n) * ldD + dcol0 + 8 * c) = o; }
    LDS_WAIT(); asm volatile("" ::: "memory");
}
__device__ __forceinline__ void tr_item8(const float* src, int ldS, int k0, int n0, unsigned char* dst, int ldD, int drow0, int dcol0, float scale, LAS float* scr, int lane) {
    const int c4 = (lane & 7) * 4, r0 = lane >> 3;
    f32x4 v[8];
#pragma unroll
    for (int i = 0; i < 8; ++i) v[i] = __builtin_nontemporal_load((const f32x4*)(src + (size_t)(k0 + r0 + 8 * i) * ldS + n0 + c4));
#pragma unroll
    for (int i = 0; i < 8; ++i) { LAS float* d = scr + (r0 + 8 * i) * 33;
#pragma unroll
        for (int q = 0; q < 4; ++q) d[c4 + q] = v[i][q] * scale; }
    LDS_WAIT(); asm volatile("" ::: "memory");
    const int c = lane & 3;
#pragma unroll
    for (int j = 0; j < 2; ++j) { const int n = (lane >> 2) + 16 * j; const LAS float* s = scr + (16 * c) * 33 + n;
        v4u o; o.x = pk4_fp8(s[0 * 33], s[1 * 33], s[2 * 33], s[3 * 33]); o.y = pk4_fp8(s[4 * 33], s[5 * 33], s[6 * 33], s[7 * 33]);
        o.z = pk4_fp8(s[8 * 33], s[9 * 33], s[10 * 33], s[11 * 33]); o.w = pk4_fp8(s[12 * 33], s[13 * 33], s[14 * 33], s[15 * 33]);
        *(v4u*)(dst + (size_t)(drow0 + n) * ldD + dcol0 + 16 * c) = o; }
    LDS_WAIT(); asm volatile("" ::: "memory");
}
__device__ __forceinline__ void tr_gu_item8(const float* wg, const float* wu, unsigned char* dst, int it, float scale, LAS float* scr, int lane) {
    const int which = it / 1408, r = it % 1408, kb = r / 88, nb = r % 88, n0 = nb * 32;
    tr_item8(which ? wu : wg, FF, kb * 64, n0, dst, D, (n0 >> 7) * 256 + which * 128 + (n0 & 127), kb * 64, scale, scr, lane);
}
__device__ __forceinline__ void tr_plain_item8(const float* w, int K, int N, unsigned char* dst, int it, float scale, LAS float* scr, int lane) {
    const int nblk = N / 32, kb = it / nblk, nb = it % nblk;
    tr_item8(w, N, kb * 64, nb * 32, dst, K, nb * 32, kb * 64, scale, scr, lane);
}
__device__ __forceinline__ unsigned pk4_i8(float a, float b, float c, float d) {
    const int ia = (int)__builtin_rintf(__builtin_amdgcn_fmed3f(a, -127.f, 127.f)), ib = (int)__builtin_rintf(__builtin_amdgcn_fmed3f(b, -127.f, 127.f));
    const int ic = (int)__builtin_rintf(__builtin_amdgcn_fmed3f(c, -127.f, 127.f)), id = (int)__builtin_rintf(__builtin_amdgcn_fmed3f(d, -127.f, 127.f));
    return (unsigned)(ia & 255) | ((unsigned)(ib & 255) << 8) | ((unsigned)(ic & 255) << 16) | ((unsigned)id << 24);
}
__device__ __forceinline__ void tr_item_i8(const float* src, int ldS, int k0, int n0, unsigned char* dst, int ldD, int drow0, int dcol0, const f32x4 sc, LAS float* scr, int lane) {
    const int c4 = (lane & 7) * 4, r0 = lane >> 3;
    f32x4 v[8];
#pragma unroll
    for (int i = 0; i < 8; ++i) v[i] = *(const f32x4*)(src + (size_t)(k0 + r0 + 8 * i) * ldS + n0 + c4);
#pragma unroll
    for (int i = 0; i < 8; ++i) { LAS float* d = scr + (r0 + 8 * i) * 33;
#pragma unroll
        for (int q = 0; q < 4; ++q) d[c4 + q] = v[i][q] * sc[q]; }
    LDS_WAIT(); asm volatile("" ::: "memory");
    const int c = lane & 3;
#pragma unroll
    for (int j = 0; j < 2; ++j) { const int n = (lane >> 2) + 16 * j; const LAS float* s = scr + (16 * c) * 33 + n;
        v4u o; o.x = pk4_i8(s[0 * 33], s[1 * 33], s[2 * 33], s[3 * 33]); o.y = pk4_i8(s[4 * 33], s[5 * 33], s[6 * 33], s[7 * 33]);
        o.z = pk4_i8(s[8 * 33], s[9 * 33], s[10 * 33], s[11 * 33]); o.w = pk4_i8(s[12 * 33], s[13 * 33], s[14 * 33], s[15 * 33]);
        *(v4u*)(dst + (size_t)(drow0 + n) * ldD + dcol0 + 16 * c) = o; }
    LDS_WAIT(); asm volatile("" ::: "memory");
}
__device__ __forceinline__ int rperm32(int nl) { return ((nl & 15) << 1) | (nl >> 4); }
__device__ __forceinline__ void amax_item(const float* src, int ldS, int k0, int n0, unsigned* amax, bool rperm, int lane) {
    const int c4 = (lane & 7) * 4, r0 = lane >> 3;
    f32x4 mx = (f32x4){0.f, 0.f, 0.f, 0.f};
#pragma unroll
    for (int i = 0; i < 8; ++i) { const f32x4 v = *(const f32x4*)(src + (size_t)(k0 + r0 + 8 * i) * ldS + n0 + c4);
#pragma unroll
        for (int q = 0; q < 4; ++q) mx[q] = fmaxf(mx[q], fabsf(v[q])); }
#pragma unroll
    for (int q = 0; q < 4; ++q) { float m = mx[q]; m = fmaxf(m, __shfl_xor(m, 8)); m = fmaxf(m, __shfl_xor(m, 16)); m = fmaxf(m, __shfl_xor(m, 32));
        if (lane < 8) __hip_atomic_fetch_max(amax + (rperm ? rperm32(c4 + q) : c4 + q), __float_as_uint(m), __ATOMIC_RELAXED, __HIP_MEMORY_SCOPE_AGENT); }
}
__device__ __forceinline__ void tr_item_q(const float* src, int ldS, int k0, int n0, unsigned char* dst, int ldD, int drow0, const unsigned* amax, float* sW, bool rperm, LAS float* scr, int lane) {
    const int c4 = (lane & 7) * 4, r0 = lane >> 3;
    f32x4 v[8], sc; int pn[4];
#pragma unroll
    for (int i = 0; i < 8; ++i) v[i] = *(const f32x4*)(src + (size_t)(k0 + r0 + 8 * i) * ldS + n0 + c4);
#pragma unroll
    for (int q = 0; q < 4; ++q) { pn[q] = rperm ? rperm32(c4 + q) : c4 + q; const float m = __uint_as_float(amax[pn[q]]); sc[q] = m > 0.f ? 127.f / m : 0.f;
        if (k0 == 0 && lane < 8) sW[pn[q]] = m * (1.f / 127.f); }
#pragma unroll
    for (int i = 0; i < 8; ++i) { LAS float* d = scr + (r0 + 8 * i) * 33;
#pragma unroll
        for (int q = 0; q < 4; ++q) d[pn[q]] = v[i][q] * sc[q]; }
    LDS_WAIT(); asm volatile("" ::: "memory");
    const int c = lane & 3;
#pragma unroll
    for (int j = 0; j < 2; ++j) { const int n = (lane >> 2) + 16 * j; const LAS float* s = scr + (16 * c) * 33 + n;
        v4u o; o.x = pk4_i8(s[0 * 33], s[1 * 33], s[2 * 33], s[3 * 33]); o.y = pk4_i8(s[4 * 33], s[5 * 33], s[6 * 33], s[7 * 33]);
        o.z = pk4_i8(s[8 * 33], s[9 * 33], s[10 * 33], s[11 * 33]); o.w = pk4_i8(s[12 * 33], s[13 * 33], s[14 * 33], s[15 * 33]);
        *(v4u*)(dst + (size_t)(drow0 + n) * ldD + k0 + 16 * c) = o; }
    LDS_WAIT(); asm volatile("" ::: "memory");
}
__device__ __forceinline__ void tr_gu_col_item_i8(const float* wg, const float* wu, unsigned char* dst, float* sW, int it, LAS float* scr, int lane) {
    const int which = it / 88, nb = it % 88, n0 = nb * 32; const float* src = which ? wu : wg;
    const int c4 = (lane & 7) * 4, r0 = lane >> 3;
    f32x4 mx = (f32x4){0.f, 0.f, 0.f, 0.f};
#pragma unroll 1
    for (int kb = 0; kb < D / 64; ++kb) {
#pragma unroll
        for (int i = 0; i < 8; ++i) { const f32x4 v = *(const f32x4*)(src + (size_t)(kb * 64 + r0 + 8 * i) * FF + n0 + c4);
#pragma unroll
            for (int q = 0; q < 4; ++q) mx[q] = fmaxf(mx[q], fabsf(v[q])); } }
    f32x4 sc;
#pragma unroll
    for (int q = 0; q < 4; ++q) { float m = mx[q]; m = fmaxf(m, __shfl_xor(m, 8)); m = fmaxf(m, __shfl_xor(m, 16)); m = fmaxf(m, __shfl_xor(m, 32)); mx[q] = m; sc[q] = m > 0.f ? 127.f / m : 0.f; }
    const int drow0 = (n0 >> 7) * 256 + which * 128 + (n0 & 127);
    if (lane < 8) *(f32x4*)(sW + drow0 + c4) = mx * (1.f / 127.f);
#pragma unroll 1
    for (int kb = 0; kb < D / 64; ++kb) tr_item_i8(src, FF, kb * 64, n0, dst, D, drow0, kb * 64, sc, scr, lane);
}
__device__ __forceinline__ void tr_gu_item(const float* wg, const float* wu, bf16* dst, int it, LAS float* scr, int lane) {
    const int which = it / 1408, r = it % 1408, kb = r / 88, nb = r % 88, n0 = nb * 32;
    tr_item(which ? wu : wg, FF, kb * 64, n0, dst, D, (n0 >> 7) * 256 + which * 128 + (n0 & 127), kb * 64, false, scr, lane);
}
__device__ __forceinline__ void tr_plain_item(const float* w, int K, int N, bf16* dst, int it, LAS float* scr, int lane) {
    const int nblk = N / 32, kb = it / nblk, nb = it % nblk;
    tr_item(w, N, kb * 64, nb * 32, dst, K, nb * 32, kb * 64, false, scr, lane);
}

constexpr int PW_IN = 16 * (RIN / 32), PW_SQ = 16 * 32, PW_GU = 2 * 1408, PW_DN = 44 * 32, PW_AI = 16 * (QKVW / 32), PW_LORA = 16 + 16 + 16 + 32;
constexpr float FFN_SW = 64.f, FFN_SA = 8.f, FFN_SH = 8.f;
constexpr int PW_ITEMS = PW_IN + PW_SQ + PW_GU + PW_DN + PW_AI + PW_SQ + PW_LORA;
__device__ __forceinline__ void phase_layer_weights(const Frame& F, const Args& a, int lo, int hi, int first) {
    if (F.bid < first) return;
    LAS float* scr = (LAS float*)(F.lds + F.wave * 8704);
    const int gw = (F.bid - first) * NWAVES + F.wave, NGW = (F.G - first) * NWAVES;
    bf16* Win = (bf16*)(F.ws + WS_WIN); bf16* Wlora = (bf16*)(F.ws + WS_WLORA); bf16* Wout0 = (bf16*)(F.ws + WS_WOUT0); bf16* Wgu0 = (bf16*)(F.ws + WS_WGU0);
    bf16* Wd0 = (bf16*)(F.ws + WS_WD0); bf16* Wai = (bf16*)(F.ws + WS_WATTIN); bf16* Wao = (bf16*)(F.ws + WS_WATTOUT);
    const unsigned* amax = (const unsigned*)(F.ws + WS_AMAX);
    for (int it = lo + gw; it < hi; it += NGW) {
        int r = it;
        if (r < PW_IN) { const int kb = r / (RIN / 32), nb = r % (RIN / 32);
            tr_item_q(a.in[I_RWIN], RIN, kb * 64, nb * 32, (unsigned char*)Win, D, nb * 32, amax + nb * 32, (float*)(F.ws + WS_SWIN) + nb * 32, false, scr, F.lane); continue; }
        r -= PW_IN;
        if (r < PW_SQ) { tr_plain_item(a.in[I_RWOUT], D, D, Wout0, r, scr, F.lane); continue; } r -= PW_SQ;
        if (r < PW_GU) { const int which = r / 1408, r2 = r % 1408, kb = r2 / 88, n0 = (r2 % 88) * 32, drow0 = (n0 >> 7) * 256 + which * 128 + (n0 & 127);
            tr_item_q(which ? a.in[I_FU] : a.in[I_FG], FF, kb * 64, n0, (unsigned char*)Wgu0, D, drow0, amax + AMAX_GU + drow0, (float*)(F.ws + WS_SW) + drow0, false, scr, F.lane); continue; }
        r -= PW_GU;
        if (r < PW_DN) { tr_plain_item8(a.in[I_FD], FF, D, (unsigned char*)Wd0, r, FFN_SW, scr, F.lane); continue; } r -= PW_DN;
        if (r < PW_AI) { const int kb = r / (QKVW / 32), nb = r % (QKVW / 32);
            tr_item_q(a.in[I_AWIN], QKVW, kb * 64, nb * 32, (unsigned char*)Wai, D, nb * 32, amax + AMAX_AI + nb * 32, (float*)(F.ws + WS_SWAI) + nb * 32, nb < 40, scr, F.lane); continue; }
        r -= PW_AI;
        if (r < PW_SQ) { tr_plain_item(a.in[I_AWOUT], D, D, Wao, r, scr, F.lane); continue; } r -= PW_SQ;
        if (r < 32) { const int d = r >> 4, nb = r & 15; tr_item(a.in[I_WUP] + (size_t)d * 64 * AW, AW, 0, nb * 32, Wlora, 256, d * AW + nb * 32, 0, false, scr, F.lane); continue; } r -= 32;
        if (r < 16) { tr_item(a.in[I_AUP], AW, 0, r * 32, Wlora, 256, 1024 + r * 32, 64, false, scr, F.lane); continue; } r -= 16;
        { const int kb = r >> 4, nb = r & 15; tr_item(a.in[I_GUP], AW, kb * 64, nb * 32, Wlora, 256, 1536 + nb * 32, 128 + kb * 64, false, scr, F.lane); }
    }
}
__device__ __forceinline__ void phase_prologue(const Frame& F, const Args& a) {
    bf16* Wlora = (bf16*)(F.ws + WS_WLORA);
    { const int gw = F.bid * NWAVES + F.wave, NGW = F.G * NWAVES; unsigned* amax = (unsigned*)(F.ws + WS_AMAX);
      for (int it = gw; it < PW_IN + PW_GU + PW_AI; it += NGW) { int r = it;
          if (r < PW_IN) { const int kb = r / (RIN / 32), nb = r % (RIN / 32); amax_item(a.in[I_RWIN], RIN, kb * 64, nb * 32, amax + nb * 32, false, F.lane); continue; } r -= PW_IN;
          if (r < PW_GU) { const int which = r / 1408, r2 = r % 1408, kb = r2 / 88, n0 = (r2 % 88) * 32, drow0 = (n0 >> 7) * 256 + which * 128 + (n0 & 127);
              amax_item(which ? a.in[I_FU] : a.in[I_FG], FF, kb * 64, n0, amax + AMAX_GU + drow0, false, F.lane); continue; } r -= PW_GU;
          { const int kb = r / (QKVW / 32), nb = r % (QKVW / 32); amax_item(a.in[I_AWIN], QKVW, kb * 64, nb * 32, amax + AMAX_AI + nb * 32, nb < 40, F.lane); } } }
    for (int i = (F.bid * NTHR + F.tid); i < 2048 * 32; i += F.G * NTHR) { const int row = i >> 5, k = (i & 31) * 8;
        const bool nz = row < 1024 ? (k < 64) : (row < 1536 ? (k >= 64 && k < 128) : (k >= 128));
        if (!nz) *(v4u*)(Wlora + (size_t)row * 256 + k) = (v4u){0u, 0u, 0u, 0u}; }
    if (F.bid == 0) for (int i = F.tid; i < 1024; i += NTHR) { const int pos = i >> 4, ii = i & 15; const float inv = exp2f(-(float)ii * (13.287712379549449f / 16.f)); const float ang = (float)pos * inv;
        float* rp = (float*)(F.ws + WS_ROPE) + 2 * i; rp[0] = __cosf(ang); rp[1] = __sinf(ang); }
    __syncthreads();
    {
        LAS float* sc = (LAS float*)(F.lds + 36864);
        LAS float* red = (LAS float*)(F.lds);
        if (F.bid < 192) {
            for (int i = F.tid; i < 17 * 1024; i += NTHR) { const int s = i >> 10, k = i & 1023; const float v = s < NB ? a.in[I_C][s * D + k] : a.in[I_CCTX][k]; sc[i] = fsilu(v); }
            __syncthreads();
        }
        for (int u = F.bid; u < 192; u += F.G) {
            const int l = u / 96, col0 = (u % 96) * 64, c4 = F.tid & 15, kg = F.tid >> 4;
            f32x4 acc[17];
#pragma unroll
            for (int s = 0; s < 17; ++s) acc[s] = (f32x4){0.f, 0.f, 0.f, 0.f};
            const float* wp = a.in[I_MODW] + ((size_t)l * D + kg * 32) * 6144 + col0 + c4 * 4;
            for (int kk = 0; kk < 32; ++kk) { const f32x4 w = *(const f32x4*)(wp + (size_t)kk * 6144); const int k = kg * 32 + kk;
#pragma unroll
                for (int s = 0; s < 17; ++s) acc[s] += w * sc[s * 1024 + k]; }
#pragma unroll
            for (int s = 0; s < 17; ++s)
#pragma unroll
                for (int j = 0; j < 4; ++j) { float v = acc[s][j]; v += __shfl_xor(v, 16); v += __shfl_xor(v, 32); acc[s][j] = v; }
            if (F.lane < 16) {
#pragma unroll
                for (int s = 0; s < 17; ++s) *(LAS f32x4*)(red + (F.wave * 17 + s) * 64 + c4 * 4) = acc[s];
            }
            __syncthreads();
            for (int i = F.tid; i < 17 * 64; i += NTHR) { const int s = i >> 6, c = i & 63; float v = a.in[I_MODB][l * 6144 + col0 + c];
#pragma unroll
                for (int w = 0; w < 8; ++w) v += red[(w * 17 + s) * 64 + c];
                ((float*)(F.ws + WS_MODS))[((size_t)l * 17 + s) * 6144 + col0 + c] = v; }
            __syncthreads();
        }
    }
}

constexpr int MW_DOWN = NEXP * 1408, MW_ITEMS = MW_DOWN + NEXP * 2816;
constexpr float MOE_SW = 64.f, MOE_SA = 8.f, MOE_SH = 8.f;
__device__ __forceinline__ void phase_moe_weights(const Frame& F, const Args& a, int lo, int hi, int first) {
    if (F.bid < first) return;
    LAS float* scr = (LAS float*)(F.lds + F.wave * 8704);
    const int gw = (F.bid - first) * NWAVES + F.wave, NGW = (F.G - first) * NWAVES;
    unsigned char* Wgu = F.ws + WS_WMGU; unsigned char* Wd = F.ws + WS_WMD;
    for (int it = lo + gw; it < hi; it += NGW) {
        if (it < MW_DOWN) { const int e = it / 1408, r = it % 1408; tr_plain_item8(a.in[I_MD] + (size_t)e * FF * D, FF, D, Wd + (size_t)e * D * FF, r, MOE_SW, scr, F.lane); }
        else { const int i2 = it - MW_DOWN, e = NEXP - 1 - i2 / 2816, r = i2 % 2816; tr_gu_item8(a.in[I_MG] + (size_t)e * D * FF, a.in[I_MU2] + (size_t)e * D * FF, Wgu + (size_t)e * FF2 * D, r, MOE_SW, scr, F.lane); }
    }
}

__device__ __forceinline__ void load_row(const float* p, int lane, f32x4 (&v)[4]) {
#pragma unroll
    for (int j = 0; j < 4; ++j) v[j] = __builtin_nontemporal_load((const f32x4*)(p + 256 * j + 4 * lane));
}
__device__ __forceinline__ void norm_mod(f32x4 (&v)[4], const float* gain, const float* shift, const float* scale, int lane) {
    float ss = 0.f;
#pragma unroll
    for (int j = 0; j < 4; ++j) ss += (v[j][0] * v[j][0] + v[j][1] * v[j][1]) + (v[j][2] * v[j][2] + v[j][3] * v[j][3]);
    const float r = __builtin_amdgcn_rsqf(wave_sum(ss) * (1.f / D) + NORM_EPS);
#pragma unroll
    for (int j = 0; j < 4; ++j) { const int c = 256 * j + 4 * lane; const f32x4 g = *(const f32x4*)(gain + c), sh = *(const f32x4*)(shift + c), sc = *(const f32x4*)(scale + c);
        v[j] = v[j] * r * g * (sc + 1.f) + sh; }
}
__device__ __forceinline__ void store_row_bf16(bf16* p, int lane, const f32x4 (&v)[4]) {
#pragma unroll
    for (int j = 0; j < 4; ++j) { v2u o; o.x = pk2(v[j][0], v[j][1]); o.y = pk2(v[j][2], v[j][3]); *(v2u*)(p + 256 * j + 4 * lane) = o; }
}
__device__ __forceinline__ void load_row16(const bf16* p, int lane, f32x4 (&v)[4]) {
#pragma unroll
    for (int j = 0; j < 4; ++j) { const v2u u = *(const v2u*)(p + 256 * j + 4 * lane); v[j] = (f32x4){bflo(u.x), bfhi(u.x), bflo(u.y), bfhi(u.y)}; }
}
__device__ __forceinline__ void store_row_i8(unsigned char* p, float* sa, int lane, const f32x4 (&v)[4]) {
    float m = 0.f;
#pragma unroll
    for (int j = 0; j < 4; ++j) m = fmaxf(fmaxf(m, fmaxf(fabsf(v[j][0]), fabsf(v[j][1]))), fmaxf(fabsf(v[j][2]), fabsf(v[j][3])));
#pragma unroll
    for (int o = 1; o < 64; o <<= 1) m = fmaxf(m, __shfl_xor(m, o));
    const float s = m > 0.f ? 127.f / m : 0.f;
#pragma unroll
    for (int j = 0; j < 4; ++j) *(unsigned*)(p + 256 * j + 4 * lane) = pk4_i8(v[j][0] * s, v[j][1] * s, v[j][2] * s, v[j][3] * s);
    if (lane == 0) *sa = m * (1.f / 127.f);
}
template <bool X16, bool O8 = false>
__device__ __forceinline__ void phase_norm_rows(const Frame& F, const void* xl, const void* xc, const float* gain, const float* modsL, int sh, bf16* out, int nrows, float* sA = nullptr) {
    const int gw = F.bid * NWAVES + F.wave, NGW = F.G * NWAVES;
    for (int m = 2 * gw; m < nrows; m += 2 * NGW) {
        const bool lat = m < NL; const int s = lat ? m / T : NB; const size_t ro = lat ? (size_t)m * D : (size_t)(m - NL) * D;
        f32x4 v[4], w[4];
        if constexpr (X16) { const bf16* xr = (const bf16*)(lat ? xl : xc) + ro; load_row16(xr, F.lane, v); load_row16(xr + D, F.lane, w); }
        else { const float* xr = (const float*)(lat ? xl : xc) + ro; load_row(xr, F.lane, v); load_row(xr + D, F.lane, w); }
        const float* shp = modsL + (size_t)s * 6144 + sh * 1024;
        norm_mod(v, gain, shp, shp + 1024, F.lane); norm_mod(w, gain, shp, shp + 1024, F.lane);
        if constexpr (O8) { store_row_i8((unsigned char*)out + (size_t)m * D, sA + m, F.lane, v); store_row_i8((unsigned char*)out + (size_t)(m + 1) * D, sA + m + 1, F.lane, w); }
        else { store_row_bf16(out + (size_t)m * D, F.lane, v); store_row_bf16(out + (size_t)(m + 1) * D, F.lane, w); }
    }
}

__device__ __forceinline__ void phase_rwkv_feat(const Frame& F, const Args& a) {
    const bf16* P = (const bf16*)((unsigned char*)F.out + DO_PRW);
    bf16* R = (bf16*)(F.ws + WS_R); bf16* KS = (bf16*)(F.ws + WS_KS); bf16* V = (bf16*)(F.ws + WS_V); bf16* KK = (bf16*)(F.ws + WS_KK); bf16* LB = (bf16*)(F.ws + WS_LB);
    const float* mu = a.in[I_MU]; const float* k_k = a.in[I_KK];
    const int gw = F.bid * NWAVES + F.wave, NGW = F.G * NWAVES, lane = F.lane;
    const int RPW = (NT + NGW - 1) / NGW, m0 = gw * RPW, m1 = m0 + RPW < NT ? m0 + RPW : NT;
    v2u rp[7], rc[7], rn[7];
#pragma unroll
    for (int j = 0; j < 7; ++j) { rp[j] = (v2u){0u, 0u}; rc[j] = (v2u){0u, 0u}; }
    if (m0 < m1) {
#pragma unroll
        for (int j = 0; j < 7; ++j) { rc[j] = *(const v2u*)(P + (size_t)m0 * RW + 4 * lane + 256 * j); if (m0 > 0) rp[j] = *(const v2u*)(P + (size_t)(m0 - 1) * RW + 4 * lane + 256 * j); } }
    for (int m = m0; m < m1; ++m) {
        const bool lat = m < NL; const int t = lat ? (m & (T - 1)) : ((m - NL) & (CT - 1)); const int tl = lat ? T : CT;
        const bool hp = t > 0, hn = t < tl - 1;
#pragma unroll
        for (int j = 0; j < 7; ++j) { rn[j] = (v2u){0u, 0u}; if (m + 1 < NT) rn[j] = *(const v2u*)(P + (size_t)(m + 1) * RW + 4 * lane + 256 * j); }
        f32x4 x[7];
#pragma unroll
        for (int j = 0; j < 7; ++j) { const v2u c = rc[j]; v2u p = rp[j], n = rn[j];
            if (!hp) p = (v2u){0u, 0u}; if (!hn) n = (v2u){0u, 0u};
            const f32x4 cv = {bflo(c.x), bfhi(c.x), bflo(c.y), bfhi(c.y)}, pv = {bflo(p.x), bfhi(p.x), bflo(p.y), bfhi(p.y)}, nv = {bflo(n.x), bfhi(n.x), bflo(n.y), bfhi(n.y)};
            const f32x4 mv = *(const f32x4*)(mu + 256 * j + 4 * lane);
            x[j] = cv + mv * ((pv + nv) * 0.5f - cv); rp[j] = rc[j]; rc[j] = rn[j]; }
#pragma unroll
        for (int jj = 0; jj < 2; ++jj) { const int c = 256 * jj + 4 * lane;
            v2u o; o.x = pk2(x[jj][0], x[jj][1]); o.y = pk2(x[jj][2], x[jj][3]); *(v2u*)(R + (size_t)m * AW + c) = o;
            o.x = pk2(x[2 + jj][0], x[2 + jj][1]); o.y = pk2(x[2 + jj][2], x[2 + jj][3]); *(v2u*)(KS + (size_t)m * AW + c) = o;
            o.x = pk2(x[4 + jj][0], x[4 + jj][1]); o.y = pk2(x[4 + jj][2], x[4 + jj][3]); *(v2u*)(V + (size_t)m * AW + c) = o;
            f32x4 kk = x[2 + jj] * *(const f32x4*)(k_k + c);
            const float ss = sum16((kk[0] * kk[0] + kk[1] * kk[1]) + (kk[2] * kk[2] + kk[3] * kk[3]));
            const float inv = 1.f / fmaxf(sqrtf(ss), 1e-12f);
            kk = kk * inv; o.x = pk2(kk[0], kk[1]); o.y = pk2(kk[2], kk[3]); *(v2u*)(KK + (size_t)m * AW + c) = o; }
        { f32x4 y = x[6];
#pragma unroll
          for (int i = 0; i < 4; ++i) { const float th = ftanh(y[i]), sg = fsigmoid(y[i]); y[i] = lane < 16 ? th : (lane < 32 ? y[i] : sg); }
          v2u o; o.x = pk2(y[0], y[1]); o.y = pk2(y[2], y[3]); *(v2u*)(LB + (size_t)m * 256 + 4 * lane) = o; }
    }
}

__device__ __forceinline__ void unpack8(const v4u& w, float (&f)[8]) { f[0] = bflo(w.x); f[1] = bfhi(w.x); f[2] = bflo(w.y); f[3] = bfhi(w.y); f[4] = bflo(w.z); f[5] = bfhi(w.z); f[6] = bflo(w.w); f[7] = bfhi(w.w); }
__device__ __forceinline__ v4u pack8f(const float (&f)[8]) { v4u w; w.x = pk2(f[0], f[1]); w.y = pk2(f[2], f[3]); w.z = pk2(f[4], f[5]); w.w = pk2(f[6], f[7]); return w; }
__device__ __forceinline__ void phase_rwkv_post(const Frame& F, const Args& a) {
    const bf16* OF = (const bf16*)(F.ws + WS_OF); const bf16* OB = (const bf16*)(F.ws + WS_OB); const bf16* R = (const bf16*)(F.ws + WS_R); const bf16* KS = (const bf16*)(F.ws + WS_KS);
    const bf16* V = (const bf16*)(F.ws + WS_V); const bf16* GG = (const bf16*)((unsigned char*)F.out + DO_GG); bf16* Y = (bf16*)(F.ws + WS_YMIX);
    const int gw = F.bid * NWAVES + F.wave, NGW = F.G * NWAVES, lane = F.lane, c = 8 * lane;
    float rk[8], lw[8], lb[8];
#pragma unroll
    for (int i = 0; i < 8; ++i) { rk[i] = a.in[I_RK][c + i]; lw[i] = a.in[I_LNW][c + i]; lb[i] = a.in[I_LNB][c + i]; }
    for (int m = gw; m < NT; m += NGW) { const size_t off = (size_t)m * AW + c;
        float of[8], ob[8], r[8], k[8], v[8], g[8];
        unpack8(*(const v4u*)(OF + off), of); unpack8(*(const v4u*)(OB + off), ob); unpack8(*(const v4u*)(R + off), r); unpack8(*(const v4u*)(KS + off), k);
        unpack8(*(const v4u*)(V + off), v); unpack8(*(const v4u*)(GG + off), g);
        float s = 0.f, bs = 0.f;
#pragma unroll
        for (int i = 0; i < 8; ++i) { of[i] += ob[i]; s += of[i]; bs += r[i] * k[i] * rk[i]; }
        const float mean = sum8(s) * (1.f / 64.f); bs = sum8(bs);
        float q = 0.f;
#pragma unroll
        for (int i = 0; i < 8; ++i) { of[i] -= mean; q += of[i] * of[i]; }
        const float rstd = __builtin_amdgcn_rsqf(sum8(q) * (1.f / 64.f) + GN_EPS);
        float y[8];
#pragma unroll
        for (int i = 0; i < 8; ++i) y[i] = (of[i] * rstd * lw[i] + lb[i] + bs * v[i]) * g[i];
        *(v4u*)(Y + (size_t)m * D + c) = pack8f(y);
    }
}
__device__ __forceinline__ void phase_hgrn_post(const Frame& F, const Args& a) {
    const bf16* OF = (const bf16*)((unsigned char*)F.out + DO_OHF); const bf16* OB = (const bf16*)((unsigned char*)F.out + DO_OHB); const bf16* PH = (const bf16*)(F.ws + WS_PHG); bf16* Y = (bf16*)(F.ws + WS_YMIX);
    const int gw = F.bid * NWAVES + F.wave, NGW = F.G * NWAVES, lane = F.lane, c = 8 * lane;
    float gn[8];
#pragma unroll
    for (int i = 0; i < 8; ++i) gn[i] = a.in[I_HNORM][(c & 127) + i];
    for (int m = gw; m < NT; m += NGW) { const size_t off = (size_t)m * AW + c;
        float of[8], ob[8], gt[8];
        unpack8(*(const v4u*)(OF + off), of); unpack8(*(const v4u*)(OB + off), ob); unpack8(*(const v4u*)(PH + (size_t)m * HG + 2048 + c), gt);
        float q = 0.f;
#pragma unroll
        for (int i = 0; i < 8; ++i) { of[i] += ob[i]; q += of[i] * of[i]; }
        const float rstd = __builtin_amdgcn_rsqf(sum16(q) * (1.f / 128.f) + NORM_EPS);
        float y[8];
#pragma unroll
        for (int i = 0; i < 8; ++i) y[i] = of[i] * rstd * gn[i] * fsilu(gt[i]);
        *(v4u*)(Y + (size_t)m * D + AW + c) = pack8f(y);
    }
}

constexpr int SC_CH = 32;
__device__ __forceinline__ int scan_row(int b, int dir, int c, int s) {
    if (c < CT / SC_CH) { const int tt = c * SC_CH + s; return NL + b * CT + (dir ? CT - 1 - tt : tt); }
    const int tt = (c - CT / SC_CH) * SC_CH + s; return b * T + (dir ? T - 1 - tt : tt);
}
__device__ __forceinline__ f32x4 bf4(const v2u& w) { return (f32x4){bflo(w.x), bfhi(w.x), bflo(w.y), bfhi(w.y)}; }
__device__ __forceinline__ void phase_rwkv_scan(const Frame& F) {
    const bf16* R = (const bf16*)(F.ws + WS_R); const bf16* KS = (const bf16*)(F.ws + WS_KS); const bf16* V = (const bf16*)(F.ws + WS_V); const bf16* KK = (const bf16*)(F.ws + WS_KK);
    const bf16* BB = (const bf16*)(F.ws + WS_BB);
    LAS float* inb = (LAS float*)F.lds;
    LAS float* outb = (LAS float*)(F.lds + 98304);
    constexpr int NCH = (CT + T) / SC_CH, ASZ = SC_CH * 64, BSZ = 6 * ASZ;
    const int tid = F.tid, rp = F.lane >> 4, kq = F.lane & 15, rowp = F.wave * 8 + 2 * rp, ls = tid >> 4, lc = (tid & 15) * 4;
    for (int task = F.bid; task < NB * 8 * 2; task += F.G) {
        const int b = task >> 4, h = (task >> 1) & 7, dir = task & 1;
        const bf16* LW = (const bf16*)((unsigned char*)F.out + (dir ? DO_LWB : DO_LWF)); bf16* O = (bf16*)(F.ws + (dir ? WS_OB : WS_OF));
        f32x4 Sa = {0.f, 0.f, 0.f, 0.f}, Sb = {0.f, 0.f, 0.f, 0.f};
        v2u g0, g1, g2, g3, g4, g5;
#define RW_LOAD(c) do { const size_t o_ = (size_t)scan_row(b, dir, (c), ls) * AW + h * 64 + lc; \
        g0 = *(const v2u*)(KK + o_); g1 = *(const v2u*)(LW + o_); g2 = *(const v2u*)(BB + o_); g3 = *(const v2u*)(KS + o_); g4 = *(const v2u*)(R + o_); g5 = *(const v2u*)(V + o_); } while (0)
#define RW_STORE(buf) do { LAS float* d_ = inb + (buf) * BSZ + ls * 64 + lc; f32x4 w_ = bf4(g1); w_[0] = __expf(w_[0]); w_[1] = __expf(w_[1]); w_[2] = __expf(w_[2]); w_[3] = __expf(w_[3]); \
        *(LAS f32x4*)(d_) = bf4(g0); *(LAS f32x4*)(d_ + ASZ) = w_; *(LAS f32x4*)(d_ + 2 * ASZ) = bf4(g2); *(LAS f32x4*)(d_ + 3 * ASZ) = bf4(g3); *(LAS f32x4*)(d_ + 4 * ASZ) = bf4(g4); *(LAS f32x4*)(d_ + 5 * ASZ) = bf4(g5); } while (0)
        RW_LOAD(0); RW_STORE(0);
        __syncthreads();
        for (int c = 0; c < NCH; ++c) {
            const int buf = c & 1;
            if (c + 1 < NCH) RW_LOAD(c + 1);
            const LAS float* ib = inb + buf * BSZ + 4 * kq; const LAS float* vb = inb + buf * BSZ + 5 * ASZ + rowp;
            for (int s16 = 0; s16 < SC_CH / 16; ++s16) {
                float oa = 0.f, ob2 = 0.f;
#pragma unroll
                for (int j = 0; j < 16; ++j) {
                    const LAS float* p = ib + (s16 * 16 + j) * 64;
                    const f32x4 kk = *(const LAS f32x4*)(p), w = *(const LAS f32x4*)(p + ASZ), bb = *(const LAS f32x4*)(p + 2 * ASZ), k = *(const LAS f32x4*)(p + 3 * ASZ), r = *(const LAS f32x4*)(p + 4 * ASZ);
                    const f32x2 vv = *(const LAS f32x2*)(vb + (s16 * 16 + j) * 64);
                    float sa = (Sa[0] * kk[0] + Sa[1] * kk[1]) + (Sa[2] * kk[2] + Sa[3] * kk[3]), sb = (Sb[0] * kk[0] + Sb[1] * kk[1]) + (Sb[2] * kk[2] + Sb[3] * kk[3]);
                    sa = sum16(sa); sb = sum16(sb);
                    Sa = Sa * w + (k * vv[0] - bb * sa); Sb = Sb * w + (k * vv[1] - bb * sb);
                    float o0 = (Sa[0] * r[0] + Sa[1] * r[1]) + (Sa[2] * r[2] + Sa[3] * r[3]), o1 = (Sb[0] * r[0] + Sb[1] * r[1]) + (Sb[2] * r[2] + Sb[3] * r[3]);
                    o0 = sum16(o0); o1 = sum16(o1);
                    oa = (kq == j) ? o0 : oa; ob2 = (kq == j) ? o1 : ob2;
                }
                *(LAS f32x2*)(outb + buf * ASZ + (s16 * 16 + kq) * 64 + rowp) = (f32x2){oa, ob2};
            }
            if (c + 1 < NCH) RW_STORE(buf ^ 1);
            __syncthreads();
            { const LAS float* q = outb + buf * ASZ + ls * 64 + lc; const f32x4 v = *(const LAS f32x4*)q; v2u w; w.x = pk2(v[0], v[1]); w.y = pk2(v[2], v[3]);
              *(v2u*)(O + (size_t)scan_row(b, dir, c, ls) * AW + h * 64 + lc) = w; }
        }
        __syncthreads();
#undef RW_LOAD
#undef RW_STORE
    }
}

__device__ __forceinline__ void phase_hgrn_scan(const Frame& F, const Args& a) {
    const bf16* PH = (const bf16*)(F.ws + WS_PHG);
    LAS float* inb = (LAS float*)F.lds;
    LAS float* outb = (LAS float*)(F.lds + 81920);
    constexpr int NCH = (CT + T) / SC_CH, FSZ = SC_CH * 128, BSZ = 2 * FSZ + SC_CH * 64, OSZ = SC_CH * 64;
    const int tid = F.tid, vc = tid >> 3, ks = tid & 7, ls = tid >> 4, l16 = tid & 15;
    for (int task = F.bid; task < NB * 4 * 2 * 2; task += F.G) {
        const int b = task >> 4, h = (task >> 2) & 3, dir = (task >> 1) & 1, half = task & 1;
        bf16* O = (bf16*)((unsigned char*)F.out + (dir ? DO_OHB : DO_OHF));
        float lbv[8];
#pragma unroll
        for (int i = 0; i < 8; ++i) { const int cidx = h * 128 + l16 * 8 + i; lbv[i] = fsigmoid(a.in[I_HLB][(dir * 2 + 0) * AW + cidx] - a.in[I_HLB][(dir * 2 + 1) * AW + cidx]); }
        float S[16];
#pragma unroll
        for (int i = 0; i < 16; ++i) S[i] = 0.f;
        v4u gq, gf; v2u gv;
#define HG_LOAD(c) do { const size_t o_ = (size_t)scan_row(b, dir, (c), ls) * HG + h * 128; \
        gq = *(const v4u*)(PH + o_ + l16 * 8); gf = *(const v4u*)(PH + o_ + 1024 + dir * AW + l16 * 8); gv = *(const v2u*)(PH + o_ + AW + half * 64 + l16 * 4); } while (0)
#define HG_STORE(buf) do { LAS float* d_ = inb + (buf) * BSZ + ls * 128 + l16 * 8; float q_[8], f_[8]; unpack8(gq, q_); unpack8(gf, f_); \
        _Pragma("unroll") for (int i = 0; i < 8; ++i) { q_[i] = fsilu(q_[i]); f_[i] = lbv[i] + (1.f - lbv[i]) * fsigmoid(f_[i]); } \
        *(LAS f32x4*)(d_) = (f32x4){f_[0], f_[1], f_[2], f_[3]}; *(LAS f32x4*)(d_ + 4) = (f32x4){f_[4], f_[5], f_[6], f_[7]}; \
        *(LAS f32x4*)(d_ + FSZ) = (f32x4){q_[0], q_[1], q_[2], q_[3]}; *(LAS f32x4*)(d_ + FSZ + 4) = (f32x4){q_[4], q_[5], q_[6], q_[7]}; \
        *(LAS f32x4*)(inb + (buf) * BSZ + 2 * FSZ + ls * 64 + l16 * 4) = bf4(gv); } while (0)
        HG_LOAD(0); HG_STORE(0);
        __syncthreads();
        for (int c = 0; c < NCH; ++c) {
            const int buf = c & 1;
            if (c + 1 < NCH) HG_LOAD(c + 1);
            const LAS float* ib = inb + buf * BSZ + 16 * ks; LAS float* ob = outb + buf * OSZ + vc;
#pragma unroll 2
            for (int s = 0; s < SC_CH; ++s) {
                const LAS float* p = ib + s * 128;
                const float vv = inb[buf * BSZ + 2 * FSZ + s * 64 + vc];
                float o0 = 0.f, o1 = 0.f;
#pragma unroll
                for (int j = 0; j < 4; ++j) { const f32x4 f = *(const LAS f32x4*)(p + 4 * j), q = *(const LAS f32x4*)(p + FSZ + 4 * j);
#pragma unroll
                    for (int i = 0; i < 4; ++i) { const float t = vv - f[i] * vv; S[4 * j + i] = S[4 * j + i] * f[i] + t; if (i & 1) o1 += q[i] * S[4 * j + i]; else o0 += q[i] * S[4 * j + i]; } }
                float o = sum8(o0 + o1);
                if (ks == 0) ob[s * 64] = o;
            }
            if (c + 1 < NCH) HG_STORE(buf ^ 1);
            __syncthreads();
            { const int fc = l16 * 4; const f32x4 v = *(const LAS f32x4*)(outb + buf * OSZ + ls * 64 + fc); v2u w; w.x = pk2(v[0], v[1]); w.y = pk2(v[2], v[3]);
              *(v2u*)(O + (size_t)scan_row(b, dir, c, ls) * AW + h * 128 + half * 64 + fc) = w; }
        }
        __syncthreads();
#undef HG_LOAD
#undef HG_STORE
    }
}

__device__ __forceinline__ int crow(int r, int hi) { return (r & 3) + 8 * (r >> 2) + 4 * hi; }
typedef short v4i16_t __attribute__((ext_vector_type(4)));
__device__ __forceinline__ s16x4 vtr(LAS const unsigned char* p) { return __builtin_bit_cast(s16x4, __builtin_amdgcn_ds_read_tr16_b64_v4i16((LAS v4i16_t*)p)); }
__device__ __forceinline__ void phase_attn(const Frame& F, const Args& a) {
    const bf16* QKV = (const bf16*)(F.ws + WS_QKV); bf16* OA = (bf16*)(F.ws + WS_OATT);
    constexpr int KPITCH = 144, KBYTES = 64 * KPITCH, VBYTES = 8192;
    constexpr int L_K = 0, L_V = 2 * KBYTES, L_WS = L_V + 2 * VBYTES, L_OST = L_WS + NWAVES * 256;
    const int tid = F.tid, lane = F.lane, wid = F.wave, r32 = lane & 31, hi = lane >> 5, g = wid >> 1, half = wid & 1;
    const int lkey = tid >> 3, lch = tid & 7;
    LAS float* wsf = (LAS float*)(F.lds + L_WS) + wid * 64;
    LAS bf16* stg = (LAS bf16*)(F.lds + L_OST + wid * 4096);
    const int kst = lkey * KPITCH + lch * 16, vst = ((lch >> 2) * 4 + (lkey >> 4)) * 1024 + (lkey & 15) * 64 + (lch & 3) * 16;
    const int vrd = ((lane >> 4) & 1) * 32 + (lane & 3) * 8 + (4 * hi + ((lane & 15) >> 2)) * 64;
    const int per = (NB * 4 * 32 + F.G - 1) / F.G;
    for (int ui = 0; ui < per; ++ui) {
        const int u = F.bid * per + ui; if (u >= NB * 4 * 32) break;
        const int b = u >> 7, kvh = (u >> 5) & 3, qb = u & 31, q0 = qb * 64, head = kvh * 4 + g;
        const int bt_lo = q0 >= 128 ? 0 : (128 - q0) / 64, bt_hi = (T + 64 - q0) / 64 > 4 ? 4 : (T + 64 - q0) / 64, nt = 4 + (bt_hi - bt_lo + 1);
        bf16x8 qr[4];
        { const bf16* qp = QKV + (size_t)(b * T + q0 + half * 32 + r32) * QKVW + head * 64 + hi * 8;
#pragma unroll
          for (int d0 = 0; d0 < 4; ++d0) qr[d0] = *(const bf16x8*)(qp + d0 * 16); }
        float m = a.in[I_SINK][head] * LOG2E, l = hi ? 0.f : 1.f;
        f32x16 o0, o1;
#pragma unroll
        for (int i = 0; i < 16; ++i) { o0[i] = 0.f; o1[i] = 0.f; }
        v4u kreg, vreg;
#define AT_ROWBASE(t) ((t) < 4 ? NL + b * CT + 64 * (t) : b * T + q0 - 128 + 64 * (bt_lo + (t) - 4))
#define AT_LOAD(t) do { const bf16* p_ = QKV + (size_t)(AT_ROWBASE(t) + lkey) * QKVW + 1024 + kvh * 64 + lch * 8; kreg = *(const v4u*)p_; vreg = *(const v4u*)(p_ + 256); } while (0)
        AT_LOAD(0);
        for (int t = 0; t < nt; ++t) {
            const int buf = t & 1;
            *(LAS v4u*)(F.lds + L_K + buf * KBYTES + kst) = kreg; *(LAS v4u*)(F.lds + L_V + buf * VBYTES + vst) = vreg;
            __syncthreads();
            if (t + 1 < nt) AT_LOAD(t + 1);
            const LAS unsigned char* Kb = F.lds + L_K + buf * KBYTES + r32 * KPITCH + hi * 16;
            f32x16 p0, p1;
            { const float nm = -m;
#pragma unroll
              for (int i = 0; i < 16; ++i) { p0[i] = nm; p1[i] = nm; } }
#pragma unroll
            for (int d0 = 0; d0 < 4; ++d0) {
                const bf16x8 ka = *(const LAS bf16x8*)(Kb + d0 * 32), kb2 = *(const LAS bf16x8*)(Kb + 32 * KPITCH + d0 * 32);
                p0 = __builtin_amdgcn_mfma_f32_32x32x16_bf16(ka, qr[d0], p0, 0, 0, 0);
                p1 = __builtin_amdgcn_mfma_f32_32x32x16_bf16(kb2, qr[d0], p1, 0, 0, 0);
            }
            const int bt = t < 4 ? -1 : bt_lo + t - 4; int qi = half * 32 + r32;
            asm volatile("" : "+v"(qi));
            if (bt == 0) {
#pragma unroll
                for (int r = 0; r < 16; ++r) { const int kj = crow(r, hi); if (kj < qi) p0[r] = -1e30f; if (kj + 32 < qi) p1[r] = -1e30f; }
            } else if (bt == 4) {
#pragma unroll
                for (int r = 0; r < 16; ++r) { const int kj = crow(r, hi); if (kj > qi) p0[r] = -1e30f; if (kj + 32 > qi) p1[r] = -1e30f; }
            }
            float tm = __builtin_fmaxf(__builtin_fmaxf(p0[0], p1[0]), p0[1]);
#pragma unroll
            for (int r = 1; r < 16; ++r) tm = __builtin_fmaxf(__builtin_fmaxf(tm, p1[r]), r + 1 < 16 ? p0[r + 1] : p1[r]);
            { auto rr = __builtin_amdgcn_permlane32_swap(__float_as_uint(tm), __float_as_uint(tm), false, false); tm = fmaxf(__uint_as_float(rr[0]), __uint_as_float(rr[1])); }
            if (__any(tm > 8.f)) {
                const float dl = tm > 8.f ? tm : 0.f, alpha = __builtin_amdgcn_exp2f(-dl);
                m += dl; l *= alpha;
#pragma unroll
                for (int r = 0; r < 16; ++r) { p0[r] -= dl; p1[r] -= dl; }
                if (hi == 0) wsf[r32] = alpha;
                LDS_WAIT();
#pragma unroll
                for (int r = 0; r < 16; ++r) { const float al = wsf[crow(r, hi)]; o0[r] *= al; o1[r] *= al; }
            }
            float ls = 0.f;
#pragma unroll
            for (int r = 0; r < 16; ++r) { p0[r] = __builtin_amdgcn_exp2f(p0[r]); p1[r] = __builtin_amdgcn_exp2f(p1[r]); ls += p0[r] + p1[r]; }
            l += ls;
            bf16x8 pk[4];
#pragma unroll
            for (int s = 0; s < 2; ++s) {
                v4u w0, w1;
                w0.x = pk2(p0[8 * s], p0[8 * s + 1]); w0.y = pk2(p0[8 * s + 2], p0[8 * s + 3]); w0.z = pk2(p0[8 * s + 4], p0[8 * s + 5]); w0.w = pk2(p0[8 * s + 6], p0[8 * s + 7]);
                w1.x = pk2(p1[8 * s], p1[8 * s + 1]); w1.y = pk2(p1[8 * s + 2], p1[8 * s + 3]); w1.z = pk2(p1[8 * s + 4], p1[8 * s + 5]); w1.w = pk2(p1[8 * s + 6], p1[8 * s + 7]);
                pk[s] = __builtin_bit_cast(bf16x8, w0); pk[2 + s] = __builtin_bit_cast(bf16x8, w1);
            }
            const LAS unsigned char* Vb = F.lds + L_V + buf * VBYTES + vrd;
#pragma unroll
            for (int k4 = 0; k4 < 4; ++k4) {
                const s16x4 lo0 = vtr(Vb + k4 * 1024), hi0 = vtr(Vb + k4 * 1024 + 512), lo1 = vtr(Vb + 4096 + k4 * 1024), hi1 = vtr(Vb + 4096 + k4 * 1024 + 512);
                const bf16x8 v0 = {lo0[0], lo0[1], lo0[2], lo0[3], hi0[0], hi0[1], hi0[2], hi0[3]}, v1 = {lo1[0], lo1[1], lo1[2], lo1[3], hi1[0], hi1[1], hi1[2], hi1[3]};
                o0 = __builtin_amdgcn_mfma_f32_32x32x16_bf16(pk[k4], v0, o0, 0, 0, 0);
                o1 = __builtin_amdgcn_mfma_f32_32x32x16_bf16(pk[k4], v1, o1, 0, 0, 0);
            }
        }
        l += __shfl_xor(l, 32);
        if (hi == 0) wsf[32 + r32] = 1.f / l;
        LDS_WAIT();
#pragma unroll
        for (int r = 0; r < 16; ++r) { const int orow = crow(r, hi); const float li = wsf[32 + orow];
            stg[orow * 64 + r32] = (bf16)(pk2(o0[r] * li, 0.f) & 0xffffu); stg[orow * 64 + 32 + r32] = (bf16)(pk2(o1[r] * li, 0.f) & 0xffffu); }
        LDS_WAIT();
        { bf16* op = OA + (size_t)(b * T + q0 + half * 32) * D + head * 64;
#pragma unroll
          for (int i = 0; i < 4; ++i) { const int rowi = i * 8 + (lane >> 3), ch = lane & 7; *(v4u*)(op + (size_t)rowi * D + ch * 8) = *(const LAS v4u*)(stg + rowi * 64 + ch * 8); } }
        __syncthreads();
#undef AT_ROWBASE
#undef AT_LOAD
    }
}


constexpr int HC_L = 64, HC_PQ = 272  , HC_PK = 144  ;
constexpr int HC_QT = 0, HC_KT = 17408, HC_QG = 34816, HC_KH = 52224, HC_VV = 70656, HC_SB = 78848, HC_SEG = 111616, HC_DEC = 113664, HC_OST = 114176, HC_END = 122368;
static_assert(HC_END <= RING_BYTES, "hgrn chunk LDS");
__device__ __forceinline__ int hc_row(int b, int dir, int c, int s) {
    if (c < CT / HC_L) { const int tt = c * HC_L + s; return NL + b * CT + (dir ? CT - 1 - tt : tt); }
    const int tt = (c - CT / HC_L) * HC_L + s; return b * T + (dir ? T - 1 - tt : tt);
}
__device__ __forceinline__ bf16x8 cat4(const s16x4 lo, const s16x4 hi) { return (bf16x8){lo[0], lo[1], lo[2], lo[3], hi[0], hi[1], hi[2], hi[3]}; }
__device__ __forceinline__ void phase_hgrn_chunk(const Frame& F, const Args& a) {
    const bf16* PH = (const bf16*)(F.ws + WS_PHG);
    constexpr int NCH = (CT + T) / HC_L;
    const int tid = F.tid, lane = F.lane, wid = F.wave, r32 = lane & 31, hi = lane >> 5;
    const int col = tid & 127, seg = tid >> 7;
    LAS unsigned char* L = F.lds;
    const int vrd = ((lane >> 4) & 1) * 32 + (lane & 3) * 8 + (4 * hi + ((lane & 15) >> 2)) * 64;
    for (int task = F.bid; task < NB * 4 * 2 * 2; task += F.G) {
        const int b = task >> 4, h = (task >> 2) & 3, dir = (task >> 1) & 1, half = task & 1;
        bf16* O = (bf16*)((unsigned char*)F.out + (dir ? DO_OHB : DO_OHF));
        const float lb = fsigmoid(a.in[I_HLB][(dir * 2 + 0) * AW + h * 128 + col] - a.in[I_HLB][(dir * 2 + 1) * AW + h * 128 + col]);
        f32x16 S0, S1;
#pragma unroll
        for (int i = 0; i < 16; ++i) { S0[i] = 0.f; S1[i] = 0.f; }
        for (int i = tid; i < 16384 / 16; i += NTHR) *(LAS v4u*)(L + HC_SB + i * 16) = (v4u){0u, 0u, 0u, 0u};
        v4u gq0, gq1, gf0, gf1, gv;
        const int qrow0 = tid >> 4, qc8 = tid & 15, vrow = tid >> 3, vc8 = tid & 7;
#define HC_LOAD(c) do { const size_t r0_ = (size_t)hc_row(b, dir, (c), qrow0) * HG + h * 128 + qc8 * 8, r1_ = (size_t)hc_row(b, dir, (c), qrow0 + 32) * HG + h * 128 + qc8 * 8; \
        gq0 = *(const v4u*)(PH + r0_); gq1 = *(const v4u*)(PH + r1_); gf0 = *(const v4u*)(PH + r0_ + 1024 + dir * AW); gf1 = *(const v4u*)(PH + r1_ + 1024 + dir * AW); \
        gv = *(const v4u*)(PH + (size_t)hc_row(b, dir, (c), vrow) * HG + AW + h * 128 + half * 64 + vc8 * 8); } while (0)
        HC_LOAD(0);
        __syncthreads();
        for (int c = 0; c < NCH; ++c) {
            const int sbuf = c & 1;
            *(LAS v4u*)(L + HC_QT + qrow0 * HC_PQ + qc8 * 16) = gq0; *(LAS v4u*)(L + HC_QT + (qrow0 + 32) * HC_PQ + qc8 * 16) = gq1;
            *(LAS v4u*)(L + HC_KT + qrow0 * HC_PQ + qc8 * 16) = gf0; *(LAS v4u*)(L + HC_KT + (qrow0 + 32) * HC_PQ + qc8 * 16) = gf1;
            *(LAS v4u*)(L + HC_VV + ((vc8 >> 2) * 4 + (vrow >> 4)) * 1024 + (vrow & 15) * 64 + (vc8 & 3) * 16) = gv;
            __syncthreads();
            if (c + 1 < NCH) HC_LOAD(c + 1);
            float Pl[16], kk[16], qv[16];
            { float run = 1.f;
#pragma unroll
              for (int i = 0; i < 16; ++i) { const int t = seg * 16 + i;
                  const float fr = __uint_as_float((unsigned)*(const LAS unsigned short*)(L + HC_KT + t * HC_PQ + col * 2) << 16), qr = __uint_as_float((unsigned)*(const LAS unsigned short*)(L + HC_QT + t * HC_PQ + col * 2) << 16);
                  const float f = lb + (1.f - lb) * fsigmoid(fr); run *= f; Pl[i] = run; kk[i] = 1.f - f; qv[i] = fsilu(qr); }
              *(LAS float*)(L + HC_SEG + (seg * 128 + col) * 4) = run; }
            __syncthreads();
            { const float s0 = *(const LAS float*)(L + HC_SEG + col * 4), s1 = *(const LAS float*)(L + HC_SEG + (128 + col) * 4), s2 = *(const LAS float*)(L + HC_SEG + (256 + col) * 4), s3 = *(const LAS float*)(L + HC_SEG + (384 + col) * 4);
              const float off = seg == 0 ? 1.f : (seg == 1 ? s0 : (seg == 2 ? s0 * s1 : s0 * s1 * s2)), pref = s0 * s1, pend = pref * s2 * s3;
              const float iref = __builtin_amdgcn_rcpf(pref), egref = pref, eend = s2 * s3, offr = off * iref;
              unsigned khw[8];
#pragma unroll
              for (int i = 0; i < 16; ++i) { const int t = seg * 16 + i; const float e = Pl[i] * offr, ri = __builtin_amdgcn_rcpf(e);
                  const float qt = qv[i] * e, kt = kk[i] * ri, qg = qt * egref, kh = kt * eend;
                  *(LAS unsigned short*)(L + HC_QT + t * HC_PQ + col * 2) = (unsigned short)(pk2(qt, 0.f) & 0xffffu);
                  *(LAS unsigned short*)(L + HC_KT + t * HC_PQ + col * 2) = (unsigned short)(pk2(kt, 0.f) & 0xffffu);
                  *(LAS unsigned short*)(L + HC_QG + t * HC_PQ + col * 2) = (unsigned short)(pk2(qg, 0.f) & 0xffffu);
                  if (i & 1) khw[i >> 1] = (khw[i >> 1] & 0xffffu) | (pk2(kh, 0.f) << 16); else khw[i >> 1] = pk2(kh, 0.f) & 0xffffu; }
              *(LAS v4u*)(L + HC_KH + col * HC_PK + seg * 32) = (v4u){khw[0], khw[1], khw[2], khw[3]}; *(LAS v4u*)(L + HC_KH + col * HC_PK + seg * 32 + 16) = (v4u){khw[4], khw[5], khw[6], khw[7]};
              if (seg == 0) *(LAS float*)(L + HC_DEC + col * 4) = pend; }
            __syncthreads();
            if (wid < 4) {
                const int tb = wid >> 1, vb = wid & 1;
                f32x16 o;
#pragma unroll
                for (int i = 0; i < 16; ++i) o[i] = 0.f;
                const LAS unsigned char* Vb = L + HC_VV + vb * 4096 + vrd;
                const LAS unsigned char* Qb = L + HC_QT + (32 * tb + r32) * HC_PQ + hi * 16;
#pragma unroll
                for (int sb = 0; sb < 2; ++sb) { if (sb <= tb) {
                    f32x16 p;
#pragma unroll
                    for (int i = 0; i < 16; ++i) p[i] = 0.f;
                    const LAS unsigned char* Kb = L + HC_KT + (32 * sb + r32) * HC_PQ + hi * 16;
#pragma unroll
                    for (int d0 = 0; d0 < 8; ++d0) p = __builtin_amdgcn_mfma_f32_32x32x16_bf16(*(const LAS bf16x8*)(Kb + d0 * 32), *(const LAS bf16x8*)(Qb + d0 * 32), p, 0, 0, 0);
                    if (sb == tb) {
#pragma unroll
                        for (int r = 0; r < 16; ++r) if (crow(r, hi) > r32) p[r] = 0.f;
                    }
#pragma unroll
                    for (int s2 = 0; s2 < 2; ++s2) { v4u w; w.x = pk2(p[8 * s2], p[8 * s2 + 1]); w.y = pk2(p[8 * s2 + 2], p[8 * s2 + 3]); w.z = pk2(p[8 * s2 + 4], p[8 * s2 + 5]); w.w = pk2(p[8 * s2 + 6], p[8 * s2 + 7]);
                        const int k4 = 2 * sb + s2;
                        o = __builtin_amdgcn_mfma_f32_32x32x16_bf16(__builtin_bit_cast(bf16x8, w), cat4(vtr(Vb + k4 * 1024), vtr(Vb + k4 * 1024 + 512)), o, 0, 0, 0); }
                } }
                const LAS unsigned char* Gb = L + HC_QG + (32 * tb + r32) * HC_PQ + hi * 8;
                const LAS unsigned char* Sb = L + HC_SB + sbuf * 16384 + vb * 4096 + vrd;
#pragma unroll
                for (int d0 = 0; d0 < 8; ++d0) { const s16x4 alo = *(const LAS s16x4*)(Gb + d0 * 32), ahi = *(const LAS s16x4*)(Gb + d0 * 32 + 16);
                    const LAS unsigned char* sp = Sb + (d0 >> 2) * 8192 + (d0 & 3) * 1024;
                    o = __builtin_amdgcn_mfma_f32_32x32x16_bf16(cat4(alo, ahi), cat4(vtr(sp), vtr(sp + 512)), o, 0, 0, 0); }
                LAS bf16* stg = (LAS bf16*)(L + HC_OST + wid * 2048);
#pragma unroll
                for (int r = 0; r < 16; ++r) stg[crow(r, hi) * 32 + r32] = (bf16)(pk2(o[r], 0.f) & 0xffffu);
                LDS_WAIT();
#pragma unroll
                for (int i = 0; i < 2; ++i) { const int rowi = i * 16 + (lane >> 2), ch = lane & 3;
                    *(v4u*)(O + (size_t)hc_row(b, dir, c, 32 * tb + rowi) * AW + h * 128 + half * 64 + 32 * vb + ch * 8) = *(const LAS v4u*)(stg + rowi * 32 + ch * 8); }
            } else {
                const int kb = wid - 4;
                const LAS unsigned char* Ab = L + HC_KH + (32 * kb + r32) * HC_PK + hi * 8;
                const LAS unsigned char* Vb = L + HC_VV + vrd;
#pragma unroll
                for (int r = 0; r < 16; ++r) { const float dc = *(const LAS float*)(L + HC_DEC + (32 * kb + crow(r, hi)) * 4); S0[r] *= dc; S1[r] *= dc; }
#pragma unroll
                for (int s4 = 0; s4 < 4; ++s4) { const bf16x8 af = cat4(*(const LAS s16x4*)(Ab + s4 * 32), *(const LAS s16x4*)(Ab + s4 * 32 + 16));
                    S0 = __builtin_amdgcn_mfma_f32_32x32x16_bf16(af, cat4(vtr(Vb + s4 * 1024), vtr(Vb + s4 * 1024 + 512)), S0, 0, 0, 0);
                    S1 = __builtin_amdgcn_mfma_f32_32x32x16_bf16(af, cat4(vtr(Vb + 4096 + s4 * 1024), vtr(Vb + 4096 + s4 * 1024 + 512)), S1, 0, 0, 0); }
                LAS unsigned char* Sn = L + HC_SB + (sbuf ^ 1) * 16384 + (kb >> 1) * 8192;
#pragma unroll
                for (int r = 0; r < 16; ++r) { const int rw = (kb & 1) * 32 + crow(r, hi); LAS unsigned char* p = Sn + (rw >> 4) * 1024 + (rw & 15) * 64 + r32 * 2;
                    *(LAS unsigned short*)(p) = (unsigned short)(pk2(S0[r], 0.f) & 0xffffu); *(LAS unsigned short*)(p + 4096) = (unsigned short)(pk2(S1[r], 0.f) & 0xffffu); }
            }
            __syncthreads();
        }
#undef HC_LOAD
    }
}


#ifndef RC_PROBE
#define RC_PROBE 1
#endif
constexpr int RC_L = 16, RC_NCH = (CT + T) / RC_L, RC_NSS = RC_NCH / 8;
constexpr int RS_A = 0, RS_RM = 2304, RS_KH = 4608, RS_BH = 6656, RS_VT = 8704, RS_A1 = 10752, RS_TT = 11264, RS_B1 = 11776, RS_B2 = 12288, RS_PL = 12800, RS_SLOT = 13056;
constexpr int RC_SCR = 8 * RS_SLOT, RC_SCRSZ = 4608, RC_END = RC_SCR + 8 * RC_SCRSZ;
static_assert(RC_END <= RING_BYTES, "rwkv chunk LDS");
__device__ __forceinline__ int rc_row(int b, int dir, int cc, int t) {
    if (cc < CT / RC_L) { const int tt = cc * RC_L + t; return NL + b * CT + (dir ? CT - 1 - tt : tt); }
    const int tt = (cc - CT / RC_L) * RC_L + t; return b * T + (dir ? T - 1 - tt : tt);
}
__device__ __forceinline__ s16x4 pack4(const f32x4& v) { v2u w; w.x = pk2(v[0], v[1]); w.y = pk2(v[2], v[3]); return __builtin_bit_cast(s16x4, w); }
__device__ __forceinline__ float bfu(unsigned short h) { return __uint_as_float((unsigned)h << 16); }
__device__ __forceinline__ unsigned short f2b(float f) { return (unsigned short)(pk2(f, 0.f) & 0xffffu); }
#define MF16(a, b, c) __builtin_amdgcn_mfma_f32_16x16x32_bf16((a), (b), (c), 0, 0, 0)
__device__ __forceinline__ void phase_rwkv_chunk(const Frame& F) {
    const bf16* R = (const bf16*)(F.ws + WS_R); const bf16* KS = (const bf16*)(F.ws + WS_KS); const bf16* V = (const bf16*)(F.ws + WS_V); const bf16* KK = (const bf16*)(F.ws + WS_KK);
    const bf16* BB = (const bf16*)(F.ws + WS_BB);
    LAS unsigned char* L = F.lds;
    const int lane = F.lane, wid = F.wave, c = lane & 15, g = lane >> 4;
    const s16x4 z4 = {0, 0, 0, 0};
    for (int task = F.bid; task < NB * 8 * 2; task += F.G) {
        const int b = task >> 4, h = (task >> 1) & 7, dir = task & 1;
        const bf16* LW = (const bf16*)((unsigned char*)F.out + (dir ? DO_LWB : DO_LWF)); bf16* O = (bf16*)(F.ws + (dir ? WS_OB : WS_OF));
        f32x4 Xt[4];
#pragma unroll
        for (int i = 0; i < 4; ++i) Xt[i] = (f32x4){0.f, 0.f, 0.f, 0.f};
        v4u pg[12];
        const int prow = lane >> 2, pcol = (lane & 3) * 16;
#define RC_LOAD(cc) do { const size_t o_ = (size_t)rc_row(b, dir, (cc), prow) * AW + h * 64 + pcol; \
        pg[0] = *(const v4u*)(KK + o_); pg[1] = *(const v4u*)(KK + o_ + 8); pg[2] = *(const v4u*)(LW + o_); pg[3] = *(const v4u*)(LW + o_ + 8); pg[4] = *(const v4u*)(BB + o_); pg[5] = *(const v4u*)(BB + o_ + 8); \
        pg[6] = *(const v4u*)(KS + o_); pg[7] = *(const v4u*)(KS + o_ + 8); pg[8] = *(const v4u*)(R + o_); pg[9] = *(const v4u*)(R + o_ + 8); pg[10] = *(const v4u*)(V + o_); pg[11] = *(const v4u*)(V + o_ + 8); } while (0)
        RC_LOAD(wid);
        for (int n = 0; n < RC_NSS; ++n) {
            {
                {
                    const int p = wid;
                    for (int rep_ = 0; rep_ < RC_PROBE; ++rep_) {
                    LAS unsigned char* S = L + p * RS_SLOT; LAS unsigned char* Q = L + RC_SCR + p * RC_SCRSZ;
                    *(LAS v4u*)(S + RS_A + prow * 144 + pcol * 2) = pg[0]; *(LAS v4u*)(S + RS_A + prow * 144 + pcol * 2 + 16) = pg[1];
                    *(LAS v4u*)(S + RS_KH + prow * 128 + pcol * 2) = pg[2]; *(LAS v4u*)(S + RS_KH + prow * 128 + pcol * 2 + 16) = pg[3];
                    *(LAS v4u*)(Q + prow * 144 + pcol * 2) = pg[4]; *(LAS v4u*)(Q + prow * 144 + pcol * 2 + 16) = pg[5];
                    *(LAS v4u*)(Q + 2304 + prow * 144 + pcol * 2) = pg[6]; *(LAS v4u*)(Q + 2304 + prow * 144 + pcol * 2 + 16) = pg[7];
                    *(LAS v4u*)(S + RS_RM + prow * 144 + pcol * 2) = pg[8]; *(LAS v4u*)(S + RS_RM + prow * 144 + pcol * 2 + 16) = pg[9];
                    *(LAS v4u*)(S + RS_VT + prow * 128 + pcol * 2) = pg[10]; *(LAS v4u*)(S + RS_VT + prow * 128 + pcol * 2 + 16) = pg[11];
                    if (n + 1 < RC_NSS && rep_ == RC_PROBE - 1) RC_LOAD(8 * (n + 1) + p);
                    LDS_WAIT();
                    { float cum[16], vk[16], vb[16], vkk[16], vr[16]; unsigned short vv[16];
                      float run = 0.f;
#pragma unroll
                      for (int t = 0; t < 16; ++t) { run += bfu(*(const LAS unsigned short*)(S + RS_KH + t * 128 + lane * 2)); cum[t] = run;
                          vkk[t] = bfu(*(const LAS unsigned short*)(S + RS_A + t * 144 + lane * 2)); vr[t] = bfu(*(const LAS unsigned short*)(S + RS_RM + t * 144 + lane * 2));
                          vb[t] = bfu(*(const LAS unsigned short*)(Q + t * 144 + lane * 2)); vk[t] = bfu(*(const LAS unsigned short*)(Q + 2304 + t * 144 + lane * 2));
                          vv[t] = *(const LAS unsigned short*)(S + RS_VT + t * 128 + lane * 2); }
                      LDS_WAIT();
                      const float eL = __expf(run);
                      unsigned kh[8], bh[8], vt[8];
                      float eprev = 1.f;
#pragma unroll
                      for (int t = 0; t < 16; ++t) { const float e = __expf(cum[t]), ei = __expf(-cum[t]), el = eL * ei;
                          *(LAS unsigned short*)(S + RS_A + t * 144 + lane * 2) = f2b(vkk[t] * eprev); *(LAS unsigned short*)(S + RS_RM + t * 144 + lane * 2) = f2b(vr[t] * e);
                          *(LAS unsigned short*)(Q + t * 144 + lane * 2) = f2b(vb[t] * ei); *(LAS unsigned short*)(Q + 2304 + t * 144 + lane * 2) = f2b(vk[t] * ei);
                          const unsigned khv = f2b(vk[t] * el), bhv = f2b(-vb[t] * el);
                          if (t & 1) { kh[t >> 1] |= khv << 16; bh[t >> 1] |= bhv << 16; vt[t >> 1] |= (unsigned)vv[t] << 16; } else { kh[t >> 1] = khv; bh[t >> 1] = bhv; vt[t >> 1] = vv[t]; }
                          eprev = e; }
                      *(LAS v4u*)(S + RS_KH + lane * 32) = (v4u){kh[0], kh[1], kh[2], kh[3]}; *(LAS v4u*)(S + RS_KH + lane * 32 + 16) = (v4u){kh[4], kh[5], kh[6], kh[7]};
                      *(LAS v4u*)(S + RS_BH + lane * 32) = (v4u){bh[0], bh[1], bh[2], bh[3]}; *(LAS v4u*)(S + RS_BH + lane * 32 + 16) = (v4u){bh[4], bh[5], bh[6], bh[7]};
                      *(LAS v4u*)(S + RS_VT + lane * 32) = (v4u){vt[0], vt[1], vt[2], vt[3]}; *(LAS v4u*)(S + RS_VT + lane * 32 + 16) = (v4u){vt[4], vt[5], vt[6], vt[7]};
                      *(LAS float*)(S + RS_PL + lane * 4) = eL; }
                    LDS_WAIT();
                    { f32x4 a2 = {0.f, 0.f, 0.f, 0.f}, a1 = a2, b2 = a2, b1 = a2; int a2i[4];
#pragma unroll
                      for (int s = 0; s < 2; ++s) { const int ko = (32 * s + 8 * g) * 2;
                          const bf16x8 fa = *(const LAS bf16x8*)(S + RS_A + c * 144 + ko), fr = *(const LAS bf16x8*)(S + RS_RM + c * 144 + ko), fb = *(const LAS bf16x8*)(Q + c * 144 + ko), fk = *(const LAS bf16x8*)(Q + 2304 + c * 144 + ko);
                          a2 = MF16(fa, fb, a2); a1 = MF16(fa, fk, a1); b2 = MF16(fr, fb, b2); b1 = MF16(fr, fk, b1); }
#pragma unroll
                      for (int r = 0; r < 4; ++r) { const int t = 4 * g + r;
                          const bool lo = c < t, le = c <= t;
                          a2i[r] = __builtin_bit_cast(int, lo ? a2[r] : 0.f);
                          *(LAS unsigned short*)(S + RS_A1 + t * 32 + c * 2) = f2b(lo ? a1[r] : 0.f);
                          *(LAS unsigned short*)(S + RS_B1 + t * 32 + c * 2) = f2b(le ? b1[r] : 0.f);
                          *(LAS unsigned short*)(S + RS_B2 + t * 32 + c * 2) = f2b(le ? -b2[r] : 0.f); }
                      float Tc[16];
#pragma unroll
                      for (int t = 0; t < 16; ++t) { float acc = (c == t) ? 1.f : 0.f;
#pragma unroll
                          for (int i = 0; i < 16; ++i) if (i < t) acc -= __builtin_bit_cast(float, __builtin_amdgcn_readlane(a2i[t & 3], (t >> 2) * 16 + i)) * Tc[i];
                          Tc[t] = acc; }
                      if (g == 0) {
#pragma unroll
                          for (int t = 0; t < 16; ++t) *(LAS unsigned short*)(S + RS_TT + t * 32 + c * 2) = f2b(Tc[t]); } }
                    LDS_WAIT();
                    }
                }
            }
            __syncthreads();
            if (wid < 4) {
                LAS bf16* stg = (LAS bf16*)(L + RC_SCR + wid * RC_SCRSZ);
#pragma unroll 1
                for (int q = 0; q < 8; ++q) {
                    const LAS unsigned char* S = L + q * RS_SLOT;
                    const bf16x8 bx0 = cat4(pack4(Xt[0]), pack4(Xt[1])), bx1 = cat4(pack4(Xt[2]), pack4(Xt[3]));
                    const LAS unsigned char* pa = S + RS_A + c * 144 + g * 8; const LAS unsigned char* pr = S + RS_RM + c * 144 + g * 8;
                    const s16x4 vtl = *(const LAS s16x4*)(S + RS_VT + (16 * wid + c) * 32 + g * 8);
                    f32x4 W = {0.f, 0.f, 0.f, 0.f};
                    W = MF16(cat4(*(const LAS s16x4*)(pa), *(const LAS s16x4*)(pa + 32)), bx0, W);
                    W = MF16(cat4(*(const LAS s16x4*)(pa + 64), *(const LAS s16x4*)(pa + 96)), bx1, W);
                    W = MF16(cat4(*(const LAS s16x4*)(S + RS_A1 + c * 32 + g * 8), z4), cat4(vtl, z4), W);
                    f32x4 U = {0.f, 0.f, 0.f, 0.f};
                    U = MF16(cat4(*(const LAS s16x4*)(S + RS_TT + c * 32 + g * 8), z4), cat4(pack4(W), z4), U);
                    const bf16x8 bvu = cat4(vtl, pack4(U));
                    f32x4 Ov = {0.f, 0.f, 0.f, 0.f};
                    Ov = MF16(cat4(*(const LAS s16x4*)(pr), *(const LAS s16x4*)(pr + 32)), bx0, Ov);
                    Ov = MF16(cat4(*(const LAS s16x4*)(pr + 64), *(const LAS s16x4*)(pr + 96)), bx1, Ov);
                    Ov = MF16(cat4(*(const LAS s16x4*)(S + RS_B1 + c * 32 + g * 8), *(const LAS s16x4*)(S + RS_B2 + c * 32 + g * 8)), bvu, Ov);
#pragma unroll
                    for (int kt = 0; kt < 4; ++kt) { const f32x4 pl = *(const LAS f32x4*)(S + RS_PL + (16 * kt + 4 * g) * 4);
                        Xt[kt] = MF16(cat4(*(const LAS s16x4*)(S + RS_KH + (16 * kt + c) * 32 + g * 8), *(const LAS s16x4*)(S + RS_BH + (16 * kt + c) * 32 + g * 8)), bvu, Xt[kt] * pl); }
#pragma unroll
                    for (int r = 0; r < 4; ++r) stg[(q * 16 + 4 * g + r) * 16 + c] = f2b(Ov[r]);
                }
                LDS_WAIT();
#pragma unroll
                for (int hf = 0; hf < 2; ++hf) { const int rw = hf * 64 + lane, q = rw >> 4, t = rw & 15; const v4u x0 = *(const LAS v4u*)(stg + rw * 16), x1 = *(const LAS v4u*)(stg + rw * 16 + 8);
                  bf16* op = O + (size_t)rc_row(b, dir, 8 * n + q, t) * AW + h * 64 + 16 * wid; *(v4u*)op = x0; *(v4u*)(op + 8) = x1; }
            }
            __syncthreads();
        }
#undef RC_LOAD
    }
}

__device__ __forceinline__ void phase_route1(const Frame& F, const Args& a) {
    LAS float* rw = (LAS float*)F.lds;
    LAS int* cnt = (LAS int*)(F.lds + 32768);
    const float* modsL = (const float*)(F.ws + WS_MODS) + (size_t)17 * 6144;
    unsigned char* FL = F.ws + WS_FLAT; int* tope = (int*)(F.ws + WS_TOPE); float* topw = (float*)(F.ws + WS_TOPW); int* rcnt = (int*)(F.ws + WS_RCNT);
    for (int i = F.tid; i < D * NEXP; i += NTHR) rw[(i & 7) * D + (i >> 3)] = a.in[I_ROUTER][i];
    const int nblk = NL / 128;
    for (int blk = F.bid; blk < nblk; blk += F.G) {
        if (F.tid < NEXP) cnt[F.tid] = 0;
        __syncthreads();
        for (int i = 0; i < 16; ++i) { const int m = blk * 128 + F.wave * 16 + i, s = m / T;
            f32x4 v[4]; load_row16((const bf16*)F.out + (size_t)m * (2 * D) + D, F.lane, v);
            norm_mod(v, a.in[I_NFFN] + D, modsL + (size_t)s * 6144 + 3 * 1024, modsL + (size_t)s * 6144 + 4 * 1024, F.lane);
#pragma unroll
            for (int j = 0; j < 4; ++j) *(unsigned*)(FL + (size_t)m * D + 256 * j + 4 * F.lane) = pk4_fp8(v[j][0] * MOE_SA, v[j][1] * MOE_SA, v[j][2] * MOE_SA, v[j][3] * MOE_SA);
            float lg[NEXP];
#pragma unroll
            for (int e = 0; e < NEXP; ++e) lg[e] = 0.f;
#pragma unroll
            for (int e = 0; e < NEXP; ++e)
#pragma unroll
                for (int j = 0; j < 4; ++j) { const f32x4 w = *(const LAS f32x4*)(rw + e * D + 256 * j + 4 * F.lane); lg[e] += (v[j][0] * w[0] + v[j][1] * w[1]) + (v[j][2] * w[2] + v[j][3] * w[3]); }
#pragma unroll
            for (int e = 0; e < NEXP; ++e) lg[e] = wave_sum(lg[e]) + a.in[I_ROUTERB][e];
            int e1 = 0; float l1 = lg[0];
#pragma unroll
            for (int e = 1; e < NEXP; ++e) if (lg[e] > l1) { l1 = lg[e]; e1 = e; }
            int e2 = -1; float l2 = -3.0e38f;
#pragma unroll
            for (int e = 0; e < NEXP; ++e) if (e != e1 && lg[e] > l2) { l2 = lg[e]; e2 = e; }
            const float r = __expf(l2 - l1), w1 = 1.f / (1.f + r), w2 = r * w1;
            if (F.lane == 0) { tope[2 * m] = e1; tope[2 * m + 1] = e2; topw[2 * m] = w1; topw[2 * m + 1] = w2; __hip_atomic_fetch_add(&cnt[e1], 1, __ATOMIC_RELAXED, __HIP_MEMORY_SCOPE_WORKGROUP); __hip_atomic_fetch_add(&cnt[e2], 1, __ATOMIC_RELAXED, __HIP_MEMORY_SCOPE_WORKGROUP); }
        }
        __syncthreads();
        if (F.tid < NEXP) rcnt[blk * NEXP + F.tid] = cnt[F.tid];
        __syncthreads();
    }
}
__device__ __forceinline__ void phase_route2(const Frame& F) {
    LAS int* tot = (LAS int*)F.lds;
    LAS int* base = tot + 8;
    LAS int* mine = tot + 24;
    LAS int* wcnt = tot + 32;
    LAS int* slots = tot + 64;
    const int* rcnt = (const int*)(F.ws + WS_RCNT); const int* tope = (const int*)(F.ws + WS_TOPE); int* slot_g = (int*)(F.ws + WS_SLOT); int* pexp = (int*)(F.ws + WS_PEXP); int* npan = (int*)(F.ws + WS_NPAN);
    const unsigned char* FL = F.ws + WS_FLAT; unsigned char* AS = F.ws + WS_A8;
    const int nblk = NL / 128;
    for (int blk = F.bid; blk < nblk; blk += F.G) {
        { const int e = F.wave; int t = 0, before = 0;
          for (int k = F.lane; k < nblk; k += 64) { const int c = rcnt[k * NEXP + e]; t += c; if (k < blk) before += c; }
#pragma unroll
          for (int o = 1; o < 64; o <<= 1) { t += __shfl_xor(t, o); before += __shfl_xor(before, o); }
          if (F.lane == 0) { tot[e] = t; mine[e] = before; } }
        __syncthreads();
        if (F.tid == 0) { int s = 0; for (int e = 0; e < NEXP; ++e) { base[e] = s; s += (tot[e] + 255) & ~255; } base[8] = s; }
        __syncthreads();
        int ej = 0;
        if (F.tid < 256) { ej = tope[(blk * 128) * 2 + F.tid];
#pragma unroll
            for (int e = 0; e < NEXP; ++e) { const unsigned long long mk = __ballot(ej == e); if (F.lane == 0) wcnt[F.wave * 8 + e] = __popcll(mk); } }
        __syncthreads();
        if (F.tid < 256) {
            unsigned long long same = 0ull;
#pragma unroll
            for (int e = 0; e < NEXP; ++e) { const unsigned long long bm = __ballot(ej == e); if (ej == e) same = bm; }
            int rank = __popcll(same & ((1ull << F.lane) - 1ull));
            for (int w = 0; w < F.wave; ++w) rank += wcnt[w * 8 + ej];
            const int sl = base[ej] + mine[ej] + rank;
            slots[F.tid] = sl; slot_g[(blk * 128) * 2 + F.tid] = sl; }
        __syncthreads();
        for (int j = F.wave; j < 256; j += NWAVES) { const int tok = blk * 128 + (j >> 1); *((v4u*)(AS + (size_t)slots[j] * D) + F.lane) = *((const v4u*)(FL + (size_t)tok * D) + F.lane); }
        if (blk < NEXP) { const int r0 = base[blk] + tot[blk], r1 = base[blk] + ((tot[blk] + 255) & ~255);
            for (int r = r0 + F.wave; r < r1; r += NWAVES) *((v4u*)(AS + (size_t)r * D) + F.lane) = (v4u){0u, 0u, 0u, 0u}; }
        if (blk == NEXP) { const int np = base[8] >> 8;
            for (int p = F.tid; p < MAXPAN; p += NTHR) { int e = 0;
#pragma unroll
                for (int q = 1; q < NEXP; ++q) if (p * 256 >= base[q]) e = q;
                pexp[p] = p < np ? e : 0; }
            if (F.tid == 0) npan[0] = np; }
        __syncthreads();
    }
}
__device__ __forceinline__ void phase_final(const Frame& F, const Args& a) {
    const float* modsL = (const float*)(F.ws + WS_MODS) + (size_t)17 * 6144;
    const bf16* Y = (const bf16*)(F.ws + WS_ASORT); const int* slot_g = (const int*)(F.ws + WS_SLOT); const float* topw = (const float*)(F.ws + WS_TOPW);
    const int gw = F.bid * NWAVES + F.wave, NGW = F.G * NWAVES, lane = F.lane;
    for (int m = gw; m < NL; m += NGW) { const int s = m / T;
        f32x4 v[4]; load_row16((const bf16*)F.out + (size_t)m * (2 * D) + D, lane, v);
        const int s1 = slot_g[2 * m], s2 = slot_g[2 * m + 1]; const float w1 = topw[2 * m], w2 = topw[2 * m + 1];
        const float* gate = modsL + (size_t)s * 6144 + 5 * 1024;
        float ss = 0.f;
#pragma unroll
        for (int j = 0; j < 4; ++j) { const int c = 256 * j + 4 * lane; const f32x4 g = *(const f32x4*)(gate + c);
            const f32x4 y1 = bf4(*(const v2u*)(Y + (size_t)s1 * D + c)), y2 = bf4(*(const v2u*)(Y + (size_t)s2 * D + c));
            v[j] = v[j] + g * (y1 * w1 + y2 * w2); ss += (v[j][0] * v[j][0] + v[j][1] * v[j][1]) + (v[j][2] * v[j][2] + v[j][3] * v[j][3]); }
        const float r = __builtin_amdgcn_rsqf(wave_sum(ss) * (1.f / D) + NORM_EPS);
#pragma unroll
        for (int j = 0; j < 4; ++j) { const int c = 256 * j + 4 * lane; *(f32x4*)(F.out + (size_t)m * D + c) = v[j] * r * *(const f32x4*)(a.in[I_NFIN] + c); }
    }
}

constexpr int NPHASE = 23;
constexpr int MW_P8 = 6500, MW_P10 = 11264, MW_P11 = 28160;
static_assert(MW_P10 <= MW_DOWN && MW_P11 <= MW_DOWN + 6 * 2816, "items converted before phase 10 / during phase 11 must not touch the YMIX overlay (gate|up of experts 0, 1)");
#define GEMM_CALL(EPI, SCHED, g, S, E) pg8::gemm_phase<EPI, SCHED, true, true>(F.lds, g, S, E)
#define GEMM_CALL8(EPI, SCHED, g, S, E) pg8::gemm_phase<EPI, SCHED, true, true, true>(F.lds, g, S, E)
#define GEMM_CALLQ(EPI, SCHED, g, S, E) pg8::gemm_phase<EPI, SCHED, true, true, false, true>(F.lds, g, S, E)
__global__ void __launch_bounds__(NTHR, 2) mk_fwd(Args args) {
    extern __shared__ __attribute__((aligned(16))) unsigned char lds_raw[];
    Frame F;
    F.lds = (LAS unsigned char*)lds_raw;
    F.tid = threadIdx.x; F.lane = F.tid & 63; F.wave = __builtin_amdgcn_readfirstlane(F.tid >> 6);
    F.G = gridDim.x; F.bid = blockIdx.x; F.out = args.out; F.ws = args.ws;
    volatile LAS unsigned* MISC = (volatile LAS unsigned*)(F.lds + MISC_OFF);
    for (int u = F.tid; u < (LDS_BYTES - LDSCTL_OFF) / 4; u += NTHR) ((LAS unsigned*)(F.lds + LDSCTL_OFF))[u] = 0u;
    __syncthreads();
    XcdBarrier bar; bar.bar = (unsigned*)(F.ws + WS_CTL) + CW_BAR; bar.x = 0; bar.st = nullptr;
#if !MK_PER_PHASE
    bar = xcd_barrier_post((unsigned*)(F.ws + WS_CTL) + CW_BAR, MISC + 8);
#endif
    const int lo = args.ph_lo, hi = args.ph_hi;
#ifndef MK_MASK
#define MK_MASK 0x7fffff
#endif
#define IN(k) (((MK_MASK >> (k)) & 1) && lo <= (k) && (k) < hi)
#define SEAM(k) do { if (IN((k) + 1)) xcd_barrier(bar); } while (0)
#ifndef MK_DUP
#define MK_DUP 0
#endif
#define REP(k) for (int rep_ = 0; rep_ < (((MK_DUP >> (k)) & 1) ? 2 : 1); ++rep_)
#define RSYNC(k) do { if ((MK_DUP >> (k)) & 1) { if (MK_PER_PHASE) __syncthreads(); else xcd_barrier(bar); } } while (0)
    const float* mods0 = (const float*)(F.ws + WS_MODS); const float* mods1 = mods0 + (size_t)17 * 6144;
    unsigned char* dout = (unsigned char*)F.out;

    if (IN(0)) { REP(0) { phase_prologue(F, args); RSYNC(0); } SEAM(0); }
    if (IN(1)) { REP(1) { phase_layer_weights(F, args, 0, PW_IN, 0); phase_norm_rows<false, true>(F, args.in[I_X], args.in[I_CTX], args.in[I_NMIX], mods0, 0, (bf16*)(F.ws + WS_H0), NT, (float*)(F.ws + WS_SA)); RSYNC(1); } SEAM(1); }
    if (IN(2)) {
        pg8::Gemm g{(const bf16*)(F.ws + WS_H0), (const bf16*)(F.ws + WS_WIN), D / 2, D / 2}; pg8::StaticOrder S; S.init(NT / 256, RIN / 256, F.G, F.bid);
        epi::EpiPQ E{(bf16*)(dout + DO_PRW), (bf16*)(F.ws + WS_PHG), (const float*)(F.ws + WS_SA), (const float*)(F.ws + WS_SWIN)};
        REP(2) { GEMM_CALLQ(epi::EpiPQ, pg8::StaticOrder, g, S, E); RSYNC(2); }
        phase_layer_weights(F, args, PW_IN, PW_ITEMS, (NT / 256 * (RIN / 256)) % F.G);
        SEAM(2); }
    if (IN(3)) { REP(3) { phase_rwkv_feat(F, args); RSYNC(3); } SEAM(3); }
    if (IN(4)) {
        int klora = 256; asm volatile("" : "+s"(klora));
        pg8::Gemm g{(const bf16*)(F.ws + WS_LB), (const bf16*)(F.ws + WS_WLORA), klora >> 1, klora}; pg8::LoraOrder S; S.so.init(NT / 256, 2048 / 256, F.G, F.bid);
        epi::EpiLora E{args.in[I_W0], args.in[I_A0], args.in[I_KA], (bf16*)(dout + DO_LWF), (bf16*)(dout + DO_LWB), (bf16*)(F.ws + WS_KS), (const bf16*)(F.ws + WS_KK), (bf16*)(F.ws + WS_BB), (bf16*)(dout + DO_GG)};
        GEMM_CALL(epi::EpiLora, pg8::LoraOrder, g, S, E); SEAM(4); }
    if (IN(5)) { REP(5) { phase_rwkv_chunk(F); RSYNC(5); } SEAM(5); }
    if (IN(6)) { REP(6) { phase_rwkv_post(F, args); RSYNC(6); } REP(23) { phase_hgrn_chunk(F, args); RSYNC(23); } SEAM(6); }
    if (IN(7)) { REP(7) { phase_hgrn_post(F, args); RSYNC(7); }
        SEAM(7); }
    if (IN(8)) {
        pg8::Gemm g{(const bf16*)(F.ws + WS_YMIX), (const bf16*)(F.ws + WS_WOUT0), D, D}; pg8::StaticOrder S; S.init(NT / 256, D / 256, F.G, F.bid);
        using ER8 = epi::EpiResT<false, true>; ER8 E{args.in[I_X], F.out, args.in[I_CTX], F.ws + WS_X1C, mods0 + 2 * 1024, D};
        GEMM_CALL(ER8, pg8::StaticOrder, g, S, E);
        phase_moe_weights(F, args, 0, MW_P8, (NT / 256 * (D / 256)) % F.G);
        SEAM(8); }
    if (IN(9)) { REP(9) { phase_norm_rows<true, true>(F, F.out, F.ws + WS_X1C, args.in[I_NFFN], mods0, 3, (bf16*)(F.ws + WS_F), NT, (float*)(F.ws + WS_SA)); RSYNC(9); } SEAM(9); }
    if (IN(10)) {
        pg8::Gemm g{(const bf16*)(F.ws + WS_F), (const bf16*)(F.ws + WS_WGU0), D / 2, D / 2}; pg8::StaticOrder S; S.init(NT / 256, FF2 / 256, F.G, F.bid);
        epi::EpiSwiGLUQ E{F.ws + WS_HFF, (const float*)(F.ws + WS_SA), (const float*)(F.ws + WS_SW), FFN_SH};
        REP(10) { GEMM_CALLQ(epi::EpiSwiGLUQ, pg8::StaticOrder, g, S, E); RSYNC(10); }
        phase_moe_weights(F, args, MW_P8, MW_P10, (NT / 256 * (FF2 / 256)) % F.G);
        SEAM(10); }
    if (IN(11)) {
        pg8::Gemm g{(const bf16*)(F.ws + WS_HFF), (const bf16*)(F.ws + WS_WD0), FF / 2, FF / 2}; pg8::StaticOrder S; S.init(NT / 256, D / 256, F.G, F.bid);
        using ER11 = epi::EpiResT<true, true>; ER11 E{F.out, F.ws + WS_X2, F.ws + WS_X1C, F.ws + WS_X2C, mods0 + 5 * 1024, D, 1.f / (FFN_SH * FFN_SW)};
        GEMM_CALL8(ER11, pg8::StaticOrder, g, S, E);
        phase_moe_weights(F, args, MW_P10, MW_P11, (NT / 256 * (D / 256)) % F.G);
        SEAM(11); }
    if (IN(12)) { REP(12) { phase_norm_rows<true, true>(F, F.ws + WS_X2, F.ws + WS_X2C, args.in[I_NMIX] + D, mods1, 0, (bf16*)(F.ws + WS_H1), NT, (float*)(F.ws + WS_SA)); RSYNC(12); }  SEAM(12); }
    if (IN(13)) {
        pg8::Gemm g{(const bf16*)(F.ws + WS_H1), (const bf16*)(F.ws + WS_WATTIN), D / 2, D / 2}; pg8::StaticOrder S; S.init(NT / 256, QKVW / 256, F.G, F.bid);
        epi::EpiQKVQ E{(bf16*)(F.ws + WS_QKV), (const float*)(F.ws + WS_ROPE), (const float*)(F.ws + WS_SA), (const float*)(F.ws + WS_SWAI)};
        REP(13) { GEMM_CALLQ(epi::EpiQKVQ, pg8::StaticOrder, g, S, E); RSYNC(13); }
        phase_moe_weights(F, args, MW_P11, MW_ITEMS, (NT / 256 * (QKVW / 256)) % F.G);
        SEAM(13); }
    if (IN(14)) { REP(14) { phase_attn(F, args); RSYNC(14); } SEAM(14); }
    if (IN(15)) {
        pg8::Gemm g{(const bf16*)(F.ws + WS_OATT), (const bf16*)(F.ws + WS_WATTOUT), D, D}; pg8::StaticOrder S; S.init(NL / 256, D / 256, F.G, F.bid);
        using ER15 = epi::EpiResT<true, true>; ER15 E{F.ws + WS_X2, (bf16*)F.out + D, F.ws + WS_X2, (bf16*)F.out + D, mods1 + 2 * 1024, 2 * D};
        GEMM_CALL(ER15, pg8::StaticOrder, g, S, E); SEAM(15); }
    if (IN(16)) { REP(16) { phase_route1(F, args); RSYNC(16); } SEAM(16); }
    if (IN(17)) { REP(17) { phase_route2(F); RSYNC(17); }
        SEAM(17); }
    if (IN(18)) {
        const int np = *(const int*)(F.ws + WS_NPAN), n = np > MAXPAN ? MAXPAN : np;
        pg8::Gemm g{(const bf16*)(F.ws + WS_A8), (const bf16*)(F.ws + WS_WMGU), D / 2, D / 2};
        pg8::MoeOrder S; S.so.init(n, FF2 / 256, F.G, F.bid); S.p0 = 0; S.pexp = (const int*)(F.ws + WS_PEXP);
        epi::EpiSwiGLU8 E{F.ws + WS_HMOE, 1.f / (MOE_SA * MOE_SW), MOE_SH};
        REP(18) { GEMM_CALL8(epi::EpiSwiGLU8, pg8::MoeOrder, g, S, E); RSYNC(18); } SEAM(18); }
    if (IN(19)) {
        const int np = *(const int*)(F.ws + WS_NPAN), n = np > MAXPAN ? MAXPAN : np;
        pg8::Gemm g{(const bf16*)(F.ws + WS_HMOE), (const bf16*)(F.ws + WS_WMD), FF / 2, FF / 2};
        pg8::MoeOrder S; S.so.init(n, D / 256, F.G, F.bid); S.p0 = 0; S.pexp = (const int*)(F.ws + WS_PEXP);
        epi::EpiBf16S E{(bf16*)(F.ws + WS_ASORT), D, 1.f / (MOE_SH * MOE_SW)};
        REP(19) { GEMM_CALL8(epi::EpiBf16S, pg8::MoeOrder, g, S, E); RSYNC(19); } SEAM(21); }
    if (IN(22)) { phase_final(F, args); }
#undef IN
#undef SEAM
}

extern "C" void kernel_launch(void* const* d_in, const int* in_sizes, int n_in, void* d_out, int out_size, void* d_ws, size_t ws_size, hipStream_t stream) {
    static int grid = 0;
    if (grid == 0) {
        if (n_in != 35 || out_size != NL * D || ws_size < WS_END) { fprintf(stderr, "kernel_launch: unexpected problem (n_in %d, out %d, ws %zu)\n", n_in, out_size, ws_size); grid = -1; return; }
        int dev = 0, cus = 0, per_cu = 0;
        if (hipGetDevice(&dev) != hipSuccess || hipDeviceGetAttribute(&cus, hipDeviceAttributeMultiprocessorCount, dev) != hipSuccess) { grid = -1; return; }
        if (hipFuncSetAttribute((const void*)mk_fwd, hipFuncAttributeMaxDynamicSharedMemorySize, LDS_BYTES) != hipSuccess) { fprintf(stderr, "kernel_launch: hipFuncSetAttribute failed\n"); grid = -1; return; }
        if (hipOccupancyMaxActiveBlocksPerMultiprocessor(&per_cu, (const void*)mk_fwd, NTHR, LDS_BYTES) != hipSuccess || per_cu < 1) fprintf(stderr, "kernel_launch: occupancy query reports %d\n", per_cu);
        (void)hipGetLastError();
        grid = cus;
    }
    if (grid < 0) return;
    (void)hipMemsetAsync((char*)d_ws + WS_CTL, 0, CTL_ZERO_BYTES, stream);
    Args a{};
    for (int i = 0; i < 35; ++i) a.in[i] = (const float*)d_in[i];
    a.out = (float*)d_out; a.ws = (unsigned char*)d_ws;
#if MK_PER_PHASE
    for (int p = 0; p < NPHASE; ++p) { a.ph_lo = p; a.ph_hi = p + 1; hipLaunchKernelGGL(mk_fwd, dim3(grid), dim3(NTHR), LDS_BYTES, stream, a); }
#else
    a.ph_lo = 0; a.ph_hi = NPHASE; hipLaunchKernelGGL(mk_fwd, dim3(grid), dim3(NTHR), LDS_BYTES, stream, a);
#endif
}
```
